# Optimizing an MI355X kernel written in HIP

```python
import math
import jax
import jax.numpy as jnp
from jax import lax
import numpy as np


D_MODEL = 1024
BATCH = 16
SEQ = 2048
DEPTH = 2

CHUNK = 64
D_PLE = 256
N_BRANCH = 4
D_BRANCH = D_MODEL // 4
D_FF = 4 * D_MODEL
EPS = 1e-6
NEG_INF = -1e30

HG_HEADS = 4
HG_DK = D_BRANCH // HG_HEADS
HG_DV = D_BRANCH // HG_HEADS

SSD_HEADS = 4
SSD_HEADDIM = D_BRANCH // SSD_HEADS
SSD_GROUPS = 2
SSD_DSTATE = 64
SSD_CONV = 4
SSD_INNER = D_BRANCH
SSD_XBC = SSD_INNER + 2 * SSD_GROUPS * SSD_DSTATE

S5_GROUP_CH = 16
S5_GROUPS = D_BRANCH // S5_GROUP_CH
S5_STATE = 64

ATT_HEADS = 4
ATT_HEADDIM = D_BRANCH // ATT_HEADS
ATT_LEFT_CHUNKS = 8
ATT_BAND = (ATT_LEFT_CHUNKS + 1) * CHUNK
ATT_MAX_REL = 128

SPLIT_SIZES = (
    4 * D_BRANCH,
    SSD_INNER + SSD_XBC + SSD_HEADS,
    D_BRANCH,
    3 * D_BRANCH,
    N_BRANCH * D_MODEL,
)
N_IN = sum(SPLIT_SIZES)

kernel_name = 'hybrid_gated_branch_streaming_encoder'


def rmsnorm(x, g):
    xf = x.astype(jnp.float32)
    y = xf * lax.rsqrt(jnp.mean(xf * xf, axis=-1, keepdims=True) + EPS)
    return (y * g.astype(jnp.float32)).astype(x.dtype)


def split_cols(t, sizes):
    offsets = np.cumsum(np.asarray(sizes))[:-1].tolist()
    return jnp.split(t, offsets, axis=-1)


def to_chunks(t, n_heads, d):
    b_, s_ = t.shape[:2]
    return t.reshape(b_, s_ // CHUNK, CHUNK, n_heads, d).transpose(0, 3, 1, 2, 4)


def hgrn2_mixer(q, f_logit, i_in, g, lb, o_gain):
    f32 = jnp.float32
    b_, s_ = q.shape[:2]
    z = f_logit.astype(f32)
    lbf = lb.astype(f32)
    log_f = jnp.logaddexp(jnp.log(lbf), jnp.log1p(-lbf) + jax.nn.log_sigmoid(z))
    k = (1.0 - lbf) * jax.nn.sigmoid(-z)

    def seq_major(t, d):
        return to_chunks(t.astype(f32), HG_HEADS, d).transpose(2, 0, 1, 3, 4)

    xs = (seq_major(q, HG_DK), seq_major(log_f, HG_DK), seq_major(k, HG_DK), seq_major(i_in, HG_DV))
    pos = jnp.arange(CHUNK)
    causal = (pos[:, None] >= pos[None, :])[:, :, None]

    def step(state, inp):
        q_c, lf_c, k_c, v_c = inp
        b = jnp.cumsum(lf_c, axis=2)
        diff = b[:, :, :, None, :] - b[:, :, None, :, :]
        decay = jnp.where(causal, jnp.exp(jnp.where(causal, diff, 0.0)), 0.0)
        scores = jnp.einsum('bhtk,bhjk,bhtjk->bhtj', q_c, k_c, decay)
        o_c = (jnp.einsum('bhtj,bhjv->bhtv', scores, v_c)
               + jnp.einsum('bhtk,bhkv->bhtv', q_c * jnp.exp(b), state))
        b_end = b[:, :, -1:, :]
        state = (jnp.exp(b_end[:, :, 0, :, None]) * state
                 + jnp.einsum('bhjk,bhjv->bhkv', k_c * jnp.exp(b_end - b), v_c))
        return state, o_c

    s0 = jnp.zeros((b_, HG_HEADS, HG_DK, HG_DV), f32)
    _, o = lax.scan(step, s0, xs)
    o = o.transpose(1, 0, 3, 2, 4).reshape(b_, s_, HG_HEADS, HG_DV)
    o = o * lax.rsqrt(jnp.mean(o * o, axis=-1, keepdims=True) + EPS) * o_gain.astype(f32).reshape(HG_HEADS, HG_DV)
    o = o.reshape(b_, s_, D_BRANCH) * jax.nn.silu(g.astype(f32))
    return o.astype(q.dtype)


def segsum(t):
    tc = jnp.cumsum(t, axis=-1)
    idx = jnp.arange(t.shape[-1])
    mask = idx[:, None] >= idx[None, :]
    return jnp.where(mask, tc[..., :, None] - tc[..., None, :], -jnp.inf)


def ssd_mixer(z, xbc, dt_raw, conv_w, conv_b, dt_bias, a_log, d_skip, norm_g):
    f32 = jnp.float32
    b_, s_ = z.shape[:2]
    nc = s_ // CHUNK
    xbc = xbc.astype(f32)
    xpad = jnp.pad(xbc, ((0, 0), (SSD_CONV - 1, 0), (0, 0)))
    conv = conv_b.astype(f32)
    for tap in range(SSD_CONV):
        conv = conv + xpad[:, tap:tap + s_, :] * conv_w[:, tap].astype(f32)
    xbc = jax.nn.silu(conv)
    xs, bm, cm = split_cols(xbc, (SSD_INNER, SSD_GROUPS * SSD_DSTATE, SSD_GROUPS * SSD_DSTATE))
    rep = SSD_HEADS // SSD_GROUPS
    xs = xs.reshape(b_, nc, CHUNK, SSD_HEADS, SSD_HEADDIM)
    bh = jnp.repeat(bm.reshape(b_, nc, CHUNK, SSD_GROUPS, SSD_DSTATE), rep, axis=3)
    ch = jnp.repeat(cm.reshape(b_, nc, CHUNK, SSD_GROUPS, SSD_DSTATE), rep, axis=3)
    dt = jax.nn.softplus(dt_raw.astype(f32) + dt_bias.astype(f32))
    a = -jnp.exp(a_log.astype(f32))
    a_dt = (dt * a).reshape(b_, nc, CHUNK, SSD_HEADS).transpose(0, 3, 1, 2)
    xdt = xs * dt.reshape(b_, nc, CHUNK, SSD_HEADS)[..., None]
    a_cum = jnp.cumsum(a_dt, axis=-1)
    l_mat = jnp.exp(segsum(a_dt))
    y_diag = jnp.einsum('bclhn,bcshn,bhcls,bcshp->bclhp', ch, bh, l_mat, xdt)
    decay_states = jnp.exp(a_cum[..., -1:] - a_cum)
    states = jnp.einsum('bclhn,bhcl,bclhp->bchpn', bh, decay_states, xdt)
    states = jnp.concatenate([jnp.zeros_like(states[:, :1]), states], axis=1)
    decay_chunk = jnp.exp(segsum(jnp.pad(a_cum[..., -1], ((0, 0), (0, 0), (1, 0)))))
    states = jnp.einsum('bhzc,bchpn->bzhpn', decay_chunk, states)[:, :-1]
    y_off = jnp.einsum('bclhn,bchpn,bhcl->bclhp', ch, states, jnp.exp(a_cum))
    y = (y_diag + y_off + d_skip.astype(f32)[:, None] * xs).reshape(b_, s_, SSD_INNER)
    y = y * jax.nn.silu(z.astype(f32))
    y = y.reshape(b_, s_, SSD_GROUPS, SSD_INNER // SSD_GROUPS)
    y = y * lax.rsqrt(jnp.mean(y * y, axis=-1, keepdims=True) + EPS)
    y = y.reshape(b_, s_, SSD_INNER) * norm_g.astype(f32)
    return y.astype(z.dtype)


def s5_combine(c1, c2):
    a1r, a1i, b1r, b1i = c1
    a2r, a2i, b2r, b2i = c2
    return (a2r * a1r - a2i * a1i,
            a2r * a1i + a2i * a1r,
            a2r * b1r - a2i * b1i + b2r,
            a2r * b1i + a2i * b1r + b2i)


def s5_mixer(u, a_re, a_im, b_re, b_im, c_re, c_im, d_skip, log_dt, w_glu):
    f32 = jnp.float32
    b_, s_ = u.shape[:2]
    a_re = a_re.astype(f32)
    a_im = a_im.astype(f32)
    step = jnp.exp(log_dt.astype(f32))[:, None]
    mag = jnp.exp(a_re * step)
    lam_re = mag * jnp.cos(a_im * step)
    lam_im = mag * jnp.sin(a_im * step)
    den = a_re * a_re + a_im * a_im
    num_re = lam_re - 1.0
    coef_re = (num_re * a_re + lam_im * a_im) / den
    coef_im = (lam_im * a_re - num_re * a_im) / den
    b_re = b_re.astype(f32)
    b_im = b_im.astype(f32)
    bb_re = coef_re[..., None] * b_re - coef_im[..., None] * b_im
    bb_im = coef_re[..., None] * b_im + coef_im[..., None] * b_re
    uf = u.astype(f32)
    ug = uf.reshape(b_, s_, S5_GROUPS, S5_GROUP_CH)
    bu_re = jnp.einsum('bsgi,gpi->bsgp', ug, bb_re)
    bu_im = jnp.einsum('bsgi,gpi->bsgp', ug, bb_im)
    lam_re_full = jnp.broadcast_to(lam_re, bu_re.shape)
    lam_im_full = jnp.broadcast_to(lam_im, bu_re.shape)
    _, _, h_re, h_im = lax.associative_scan(s5_combine, (lam_re_full, lam_im_full, bu_re, bu_im), axis=1)
    y = (jnp.einsum('bsgp,gip->bsgi', h_re, c_re.astype(f32))
         - jnp.einsum('bsgp,gip->bsgi', h_im, c_im.astype(f32)))
    y = y.reshape(b_, s_, D_BRANCH) + d_skip.astype(f32) * uf
    y = jax.nn.gelu(y)
    y = y * jax.nn.sigmoid(y @ w_glu.astype(f32))
    return y.astype(u.dtype)


def chunk_rel_attention(q, k, v, q_gain, k_gain, rel_bias):
    f32 = jnp.float32
    b_, s_ = q.shape[:2]
    nc = s_ // CHUNK
    q = rmsnorm(q.reshape(b_, s_, ATT_HEADS, ATT_HEADDIM), q_gain).reshape(b_, s_, D_BRANCH)
    k = rmsnorm(k.reshape(b_, s_, ATT_HEADS, ATT_HEADDIM), k_gain).reshape(b_, s_, D_BRANCH)
    qc = to_chunks(q, ATT_HEADS, ATT_HEADDIM)
    kc = to_chunks(k, ATT_HEADS, ATT_HEADDIM)
    vc = to_chunks(v, ATT_HEADS, ATT_HEADDIM)
    pad = ((0, 0), (0, 0), (ATT_LEFT_CHUNKS, 0), (0, 0), (0, 0))
    kp = jnp.pad(kc, pad)
    vp = jnp.pad(vc, pad)
    kband = jnp.concatenate([kp[:, :, j:j + nc] for j in range(ATT_LEFT_CHUNKS + 1)], axis=3)
    vband = jnp.concatenate([vp[:, :, j:j + nc] for j in range(ATT_LEFT_CHUNKS + 1)], axis=3)
    scores = jnp.einsum('bhcqd,bhckd->bhcqk', qc, kband).astype(f32) * (ATT_HEADDIM ** -0.5)
    qpos = jnp.arange(CHUNK)[:, None]
    kpos = jnp.arange(ATT_BAND)[None, :]
    rel = jnp.clip(qpos + ATT_LEFT_CHUNKS * CHUNK - kpos, -ATT_MAX_REL, ATT_MAX_REL) + ATT_MAX_REL
    bias = rel_bias.astype(f32)[:, rel]
    valid = (jnp.arange(nc)[:, None] - ATT_LEFT_CHUNKS + kpos // CHUNK) >= 0
    scores = jnp.where(valid[None, None, :, None, :], scores + bias[None, :, None], NEG_INF)
    probs = jax.nn.softmax(scores, axis=-1).astype(vband.dtype)
    out = jnp.einsum('bhcqk,bhckd->bhcqd', probs, vband)
    return out.transpose(0, 2, 3, 1, 4).reshape(b_, s_, D_BRANCH)


def setup_inputs(seed: int = 0) -> dict:
    key = jax.random.key(seed)
    keys = iter(jax.random.split(key, 40))
    f32 = jnp.float32
    L = DEPTH

    def normal(shape, scale):
        return jax.random.normal(next(keys), shape, f32) * scale

    def uniform(shape, lo, hi):
        return jax.random.uniform(next(keys), shape, f32, lo, hi)

    def gain(shape):
        return 1.0 + normal(shape, 0.02)

    ssd_dt = jnp.exp(uniform((L, SSD_HEADS), math.log(1e-3), math.log(1e-1)))
    s5_a_im = jnp.pi * jnp.arange(S5_STATE, dtype=f32)
    return {
        'x': normal((BATCH, SEQ, D_MODEL), 1.0),
        'p': normal((DEPTH, BATCH, SEQ, D_PLE), 1.0),
        'norm_mix': gain((L, D_MODEL)),
        'w_in': normal((L, D_MODEL, N_IN), D_MODEL ** -0.5),
        'hg_lb_logits': normal((L, HG_HEADS * HG_DK), 0.5),
        'hg_o_norm': gain((L, D_BRANCH)),
        'ssd_conv_w': normal((L, SSD_XBC, SSD_CONV), SSD_CONV ** -0.5),
        'ssd_conv_b': normal((L, SSD_XBC), 0.02),
        'ssd_dt_bias': ssd_dt + jnp.log(-jnp.expm1(-ssd_dt)),
        'ssd_A_log': jnp.log(uniform((L, SSD_HEADS), 1.0, 16.0)),
        'ssd_D': 1.0 + normal((L, SSD_HEADS), 0.1),
        'ssd_norm': gain((L, SSD_INNER)),
        's5_A_re': -0.5 + normal((L, S5_GROUPS, S5_STATE), 0.01),
        's5_A_im': s5_a_im + normal((L, S5_GROUPS, S5_STATE), 0.01),
        's5_B_re': normal((L, S5_GROUPS, S5_STATE, S5_GROUP_CH), (2 * S5_GROUP_CH) ** -0.5),
        's5_B_im': normal((L, S5_GROUPS, S5_STATE, S5_GROUP_CH), (2 * S5_GROUP_CH) ** -0.5),
        's5_C_re': normal((L, S5_GROUPS, S5_GROUP_CH, S5_STATE), (2 * S5_STATE) ** -0.5),
        's5_C_im': normal((L, S5_GROUPS, S5_GROUP_CH, S5_STATE), (2 * S5_STATE) ** -0.5),
        's5_D': normal((L, D_BRANCH), 0.5),
        's5_log_dt': uniform((L, S5_GROUPS), math.log(1e-3), math.log(1e-1)),
        's5_w_glu': normal((L, D_BRANCH, D_BRANCH), D_BRANCH ** -0.5),
        'att_q_norm': gain((L, ATT_HEADDIM)),
        'att_k_norm': gain((L, ATT_HEADDIM)),
        'att_rel_bias': normal((L, ATT_HEADS, 2 * ATT_MAX_REL + 1), 0.1),
        'w_branch': normal((L, N_BRANCH, D_BRANCH, D_MODEL), D_BRANCH ** -0.5),
        'w_out': normal((L, D_MODEL, D_MODEL), D_MODEL ** -0.5),
        'norm_ffn': gain((L, D_MODEL)),
        'w_ff1': normal((L, D_MODEL, D_FF), D_MODEL ** -0.5),
        'w_ff2': normal((L, D_FF, D_MODEL), D_FF ** -0.5),
        'w_ple': normal((L, D_PLE, D_MODEL), D_PLE ** -0.5),
        'norm_ple': gain((L, D_MODEL)),
        'w_ple_gate': normal((L, D_MODEL, D_MODEL), D_MODEL ** -0.5),
    }


def reference(x, p, norm_mix, w_in, hg_lb_logits, hg_o_norm, ssd_conv_w, ssd_conv_b, ssd_dt_bias,
              ssd_A_log, ssd_D, ssd_norm, s5_A_re, s5_A_im, s5_B_re, s5_B_im, s5_C_re, s5_C_im, s5_D,
              s5_log_dt, s5_w_glu, att_q_norm, att_k_norm, att_rel_bias, w_branch, w_out, norm_ffn,
              w_ff1, w_ff2, w_ple, norm_ple, w_ple_gate):
    b_, s_ = x.shape[:2]
    lb_all = jnp.cumsum(jax.nn.softmax(hg_lb_logits.astype(jnp.float32), axis=0), axis=0)
    lb_all = lb_all - lb_all[0:1]
    for i in range(DEPTH):
        h = rmsnorm(x, norm_mix[i])
        proj = h @ w_in[i]
        a_in, b_in, c_in, d_in, gate_in = split_cols(proj, SPLIT_SIZES)

        hq, hf, hi, hg = jnp.split(a_in, 4, axis=-1)
        y_a = hgrn2_mixer(hq, hf, hi, hg, lb_all[i], hg_o_norm[i])

        sz, sxbc, sdt = split_cols(b_in, (SSD_INNER, SSD_XBC, SSD_HEADS))
        y_b = ssd_mixer(sz, sxbc, sdt, ssd_conv_w[i], ssd_conv_b[i], ssd_dt_bias[i], ssd_A_log[i],
                        ssd_D[i], ssd_norm[i])

        y_c = s5_mixer(c_in, s5_A_re[i], s5_A_im[i], s5_B_re[i], s5_B_im[i], s5_C_re[i], s5_C_im[i],
                       s5_D[i], s5_log_dt[i], s5_w_glu[i])

        aq, ak, av = jnp.split(d_in, 3, axis=-1)
        y_d = chunk_rel_attention(aq, ak, av, att_q_norm[i], att_k_norm[i], att_rel_bias[i])

        gates = jax.nn.sigmoid(gate_in.reshape(b_, s_, N_BRANCH, D_MODEL))
        branches = (y_a, y_b, y_c, y_d)
        merged = gates[:, :, 0] * (branches[0] @ w_branch[i, 0])
        for m in range(1, N_BRANCH):
            merged = merged + gates[:, :, m] * (branches[m] @ w_branch[i, m])
        x = x + merged @ w_out[i]

        h2 = rmsnorm(x, norm_ffn[i])
        x = x + jnp.square(jax.nn.relu(h2 @ w_ff1[i])) @ w_ff2[i]

        ple_gate = jax.nn.sigmoid(rmsnorm(x, norm_ple[i]) @ w_ple_gate[i])
        x = x + (p[i] @ w_ple[i]) * ple_gate
    return x
```

```cpp
#include <hip/hip_runtime.h>
#include <hip/hip_cooperative_groups.h>
#include <cstdio>
namespace cg = cooperative_groups;

#define DEVI __device__ __forceinline__
#define LAS __attribute__((address_space(3)))
typedef unsigned short bf16_t;
typedef short bf16x8 __attribute__((ext_vector_type(8)));
typedef short bf16x4 __attribute__((ext_vector_type(4)));
typedef float f32x4 __attribute__((ext_vector_type(4)));
typedef unsigned u32x4 __attribute__((ext_vector_type(4)));
typedef unsigned u32x2 __attribute__((ext_vector_type(2)));

constexpr int T_TOK = 32768, DM = 1024, SEQ = 2048, NCH = 32;
constexpr int PW = 2560;
constexpr int UK = 1152;
constexpr float EPSF = 1e-6f;
constexpr size_t MiB = 1024ull * 1024ull;
constexpr size_t OFF_GATES = 0, OFF_HID = 0, OFF_Y = 128 * MiB, OFF_PROJ = 192 * MiB, OFF_MERGED = 192 * MiB, OFF_PLE = 256 * MiB,
                 OFF_PB = 320 * MiB, OFF_XB = 352 * MiB, OFF_TOEP = 352 * MiB, OFF_W = 416 * MiB, OFF_MINT = 456 * MiB, OFF_U = 464 * MiB,
                 OFF_SMALL = 483 * MiB, WS_NEED = 490 * MiB;
constexpr size_t W_IN = 0, W_BR = 14 * MiB, W_OUT = 16 * MiB, W_FF1 = 18 * MiB, W_FF2 = 26 * MiB, W_PLE = 34 * MiB, W_GLU = 34 * MiB + 512 * 1024,
                 W_PG = 35 * MiB  ;
constexpr size_t S_ROWSQ = 0, S_KT = 1 * MiB, S_LAM = 3 * MiB, S_BB = 3 * MiB + 1280 * 1024, S_DT = 5 * MiB, S_CTR = 5 * MiB + 512 * 1024;
constexpr int LDS_BYTES = 152 * 1024;

struct Params { const float* in[32]; float* out; unsigned char* ws; };

DEVI int ltid() { int t = threadIdx.x; asm volatile("" : "+v"(t)); return t; }
DEVI int lbid() { int b = blockIdx.x; asm volatile("" : "+s"(b)); return b; }
DEVI unsigned char* lptr(unsigned char* p) { asm volatile("" : "+s"(p)); return p; }
DEVI int lsg(int v) { asm volatile("" : "+s"(v)); return v; }
DEVI float bf2f(unsigned v) { return __uint_as_float(v << 16); }
DEVI bf16_t f2bf(float f) { unsigned u = __float_as_uint(f); u += 0x7FFFu + ((u >> 16) & 1u); return (bf16_t)(u >> 16); }
DEVI unsigned pk2(float lo, float hi) { unsigned r; asm volatile("v_cvt_pk_bf16_f32 %0, %1, %2" : "=v"(r) : "v"(lo), "v"(hi)); return r; }
DEVI void unpack8(u32x4 w, float* f) {
#pragma unroll
  for (int i = 0; i < 4; ++i) { f[2 * i] = __uint_as_float(w[i] << 16); f[2 * i + 1] = __uint_as_float(w[i] & 0xffff0000u); }
}
DEVI u32x4 pack8(const float* f) { u32x4 w; w[0] = pk2(f[0], f[1]); w[1] = pk2(f[2], f[3]); w[2] = pk2(f[4], f[5]); w[3] = pk2(f[6], f[7]); return w; }
DEVI float sigmoidf_(float x) { return 1.0f / (1.0f + __expf(-x)); }
DEVI float siluf_(float x) { return x / (1.0f + __expf(-x)); }
DEVI float gelu_tanh(float x) { float u = 0.7978845608f * (x + 0.044715f * x * x * x); float t = 1.0f - 2.0f / (1.0f + __expf(2.0f * u)); return 0.5f * x * (1.0f + t); }
DEVI f32x4 mfma16(bf16x8 a, bf16x8 b, f32x4 c) { return __builtin_amdgcn_mfma_f32_16x16x32_bf16(a, b, c, 0, 0, 0); }

namespace pg8 {
constexpr int BM = 256, BK = 64, HALF = 128, HTB = HALF * BK * 2, STAGE_BYTES = 8 * HTB, NXCD = 8, WGM = 8;
DEVI int lds_byte(int r, int c) { const int st = (r >> 4) * 2 + (c >> 5), rr = r & 15, cc = c & 31, ob = rr * 64 + cc * 2; return st * 1024 + (ob ^ (((ob >> 9) & 1) << 5)); }
DEVI void stage_rc(int b, int& R, int& C) { const int st = b / 1024, sb = b % 1024, swz = sb ^ (((sb >> 9) & 1) << 5); R = (st >> 1) * 16 + swz / 64; C = (st & 1) * 32 + (swz % 64) / 2; }
DEVI int perm32(int rho) { const int n = rho >> 4, i = rho & 15; return 8 * (i >> 2) + 4 * n + (i & 3); }
struct Unit { int pm, pn, grp; };
struct Gemm { const bf16_t* A; const bf16_t* Bt; int lda, ldb, K; size_t gsA, gsB; };
struct StaticOrder {
  int nM, nN, nwg, G, c;
  DEVI void init(int nM_, int nN_, int G_, int c_) { nM = nM_; nN = nN_; nwg = nM * nN; G = G_; c = c_; }
  DEVI bool next(int i, Unit& u) const {
    const long L = (long)i * G + c; if (L >= nwg) return false;
    int wgid = (int)L; { const int q = nwg / NXCD, r = nwg % NXCD, xcd = wgid % NXCD, off = wgid / NXCD; wgid = (xcd < r ? xcd * (q + 1) : r * (q + 1) + (xcd - r) * q) + off; }
    const int nig = WGM * nN, gid = wgid / nig, fm = gid * WGM, gsz = (nM - fm) < WGM ? (nM - fm) : WGM;
    u.pm = fm + ((wgid % nig) % gsz); u.pn = (wgid % nig) / gsz; u.grp = 0; return true;
  }
};
struct OneUnit { Unit u; DEVI bool next(int i, Unit& o) const { if (i != 0) return false; o = u; return true; } };

template <class Epi, class Sched>
DEVI void gemm_phase(LAS unsigned char* lds, const Gemm g, const Sched& S, const Epi& E) {
  int tid_ = threadIdx.x; asm volatile("" : "+v"(tid_));
  const int tid = tid_, wid = __builtin_amdgcn_readfirstlane(tid >> 6), lane = tid & 63, wr = wid >> 2, wc = wid & 3, fr = lane & 15, fq = lane >> 4;
  const int K = g.K, nt = K / BK;
  unsigned voffA[2], voffB[2];
#pragma unroll
  for (int i = 0; i < 2; ++i) { int R, C; stage_rc(tid * 16 + i * 8192, R, C); const int Rb = Epi::PERM ? ((R & ~31) + perm32(R & 31)) : R;
    voffA[i] = (unsigned)(R * g.lda + C) * 2u; voffB[i] = (unsigned)(Rb * g.ldb + C) * 2u; }
  const size_t kstep = (size_t)(BK * 2);
  const size_t hstepA = (size_t)HALF * g.lda * 2, hstepB = (size_t)HALF * g.ldb * 2;
  const unsigned ldsw = (unsigned)wid * 1024u;
  const int aoff = lds_byte(wr * 64 + fr, fq * 8), boff = lds_byte(wc * 32 + fr, fq * 8);
#define PG8_SA(b, h) (((b) * 2 + (h)) * HTB)
#define PG8_SB(b, h) ((4 + (b) * 2 + (h)) * HTB)
#define PG8_STAGE(bufoff, gbase, voff) do { _Pragma("unroll") for (int _i = 0; _i < 2; ++_i) \
    __builtin_amdgcn_global_load_lds((const unsigned*)((const char*)(gbase) + (voff)[_i]), (LAS unsigned*)(lds + (bufoff) + ldsw + _i * 8192), 16, 0, 0); } while (0)
#define PG8_LDA(dst, b, h) do { _Pragma("unroll") for (int m = 0; m < 4; ++m) _Pragma("unroll") for (int k = 0; k < 2; ++k) dst[m][k] = *(const LAS bf16x8*)(lds + PG8_SA(b, h) + aoff + m * 2048 + k * 1024); } while (0)
#define PG8_LDB(dst, b, h) do { _Pragma("unroll") for (int n = 0; n < 2; ++n) _Pragma("unroll") for (int k = 0; k < 2; ++k) dst[n][k] = *(const LAS bf16x8*)(lds + PG8_SB(b, h) + boff + n * 2048 + k * 1024); } while (0)
#define PG8_MMA(ai, bj, At, Bt) do { __builtin_amdgcn_s_setprio(1); _Pragma("unroll") for (int m = 0; m < 4; ++m) _Pragma("unroll") for (int n = 0; n < 2; ++n) _Pragma("unroll") for (int k = 0; k < 2; ++k) \
    acc[ai][bj][m][n] = __builtin_amdgcn_mfma_f32_16x16x32_bf16(Bt[n][k], At[m][k], acc[ai][bj][m][n], 0, 0, 0); __builtin_amdgcn_s_setprio(0); } while (0)
#define PG8_WAIT_V(n) asm volatile("s_waitcnt vmcnt(" #n ")" ::: "memory")
#define PG8_WAIT_L(n) asm volatile("s_waitcnt lgkmcnt(" #n ")" ::: "memory")
#define PG8_BAR __builtin_amdgcn_s_barrier()
#define PG8_SCHED __builtin_amdgcn_sched_barrier(0)
  Unit cur, nxt; int ui = 0;
  if (!S.next(0, cur)) return;
  f32x4 acc[2][2][4][2];
#pragma unroll
  for (int a = 0; a < 2; ++a)
#pragma unroll
    for (int b = 0; b < 2; ++b)
#pragma unroll
      for (int m = 0; m < 4; ++m)
#pragma unroll
        for (int n = 0; n < 2; ++n) acc[a][b][m][n] = (f32x4){0.f, 0.f, 0.f, 0.f};
  bf16x8 At[4][2], B0[2][2], B1[2][2];
  const char* cA = (const char*)g.A + (size_t)cur.grp * g.gsA + (size_t)cur.pm * 2 * hstepA;
  const char* cB = (const char*)g.Bt + (size_t)cur.grp * g.gsB + (size_t)cur.pn * 2 * hstepB;
  PG8_STAGE(PG8_SB(0, 0), cB, voffB); PG8_STAGE(PG8_SA(0, 0), cA, voffA); PG8_STAGE(PG8_SB(0, 1), cB + hstepB, voffB); PG8_STAGE(PG8_SA(0, 1), cA + hstepA, voffA);
  if (wr == 1) PG8_BAR;
  PG8_WAIT_V(4); PG8_BAR;
  PG8_STAGE(PG8_SB(1, 0), cB + kstep, voffB); PG8_STAGE(PG8_SA(1, 0), cA + kstep, voffA); PG8_STAGE(PG8_SB(1, 1), cB + hstepB + kstep, voffB);
  PG8_WAIT_V(6); PG8_BAR;
  for (;;) {
    const bool has_next = S.next(ui + 1, nxt);
    const char* nA = has_next ? (const char*)g.A + (size_t)nxt.grp * g.gsA + (size_t)nxt.pm * 2 * hstepA : cA;
    const char* nB = has_next ? (const char*)g.Bt + (size_t)nxt.grp * g.gsB + (size_t)nxt.pn * 2 * hstepB : cB;
    for (int t = 0; t < nt; t += 2) {
      const bool last = (t == nt - 2);
      const char* a1 = cA + (size_t)(t + 1) * kstep;
      const char* a2 = last ? nA : cA + (size_t)(t + 2) * kstep; const char* b2 = last ? nB : cB + (size_t)(t + 2) * kstep;
      const char* a3 = a2 + kstep; const char* b3 = b2 + kstep;
      PG8_LDB(B0, 0, 0); PG8_SCHED; PG8_LDA(At, 0, 0); PG8_STAGE(PG8_SA(1, 1), a1 + hstepA, voffA);
      PG8_WAIT_L(8); PG8_BAR; PG8_WAIT_L(0); PG8_MMA(0, 0, At, B0); PG8_BAR; PG8_SCHED;
      PG8_LDB(B1, 0, 1); PG8_STAGE(PG8_SB(0, 0), b2, voffB);
      PG8_BAR; PG8_WAIT_L(0); PG8_MMA(0, 1, At, B1); PG8_BAR;
      PG8_LDA(At, 0, 1); PG8_STAGE(PG8_SA(0, 0), a2, voffA);
      PG8_BAR; PG8_WAIT_L(0); PG8_MMA(1, 0, At, B0); PG8_BAR; PG8_SCHED;
      PG8_STAGE(PG8_SB(0, 1), b2 + hstepB, voffB);
      PG8_WAIT_V(6); PG8_BAR; PG8_MMA(1, 1, At, B1); PG8_BAR;
      PG8_LDB(B0, 1, 0); PG8_SCHED; PG8_LDA(At, 1, 0); PG8_STAGE(PG8_SA(0, 1), a2 + hstepA, voffA);
      PG8_WAIT_L(8); PG8_BAR; PG8_WAIT_L(0); PG8_MMA(0, 0, At, B0); PG8_BAR; PG8_SCHED;
      PG8_LDB(B1, 1, 1); PG8_STAGE(PG8_SB(1, 0), b3, voffB);
      PG8_BAR; PG8_WAIT_L(0); PG8_MMA(0, 1, At, B1); PG8_BAR;
      PG8_LDA(At, 1, 1); PG8_STAGE(PG8_SA(1, 0), a3, voffA);
      PG8_BAR; PG8_WAIT_L(0); PG8_MMA(1, 0, At, B0); PG8_BAR; PG8_SCHED;
      PG8_STAGE(PG8_SB(1, 1), b3 + hstepB, voffB);
      PG8_WAIT_V(6); PG8_BAR; PG8_MMA(1, 1, At, B1); PG8_BAR;
    }
    if constexpr (!Epi::AFTER_DRAIN) { E(acc, cur, wr, wc, fr, fq); }
    if (!has_next) break;
#pragma unroll
    for (int a = 0; a < 2; ++a)
#pragma unroll
      for (int b = 0; b < 2; ++b)
#pragma unroll
        for (int m = 0; m < 4; ++m)
#pragma unroll
          for (int n = 0; n < 2; ++n) acc[a][b][m][n] = (f32x4){0.f, 0.f, 0.f, 0.f};
    cur = nxt; cA = nA; cB = nB; ++ui;
  }
  PG8_WAIT_V(0);
  if (wr == 0) PG8_BAR;
  PG8_BAR;
  if constexpr (Epi::AFTER_DRAIN) { E.fused(acc, cur, wr, wc, fr, fq, lds, wid, lane); }
#undef PG8_SA
#undef PG8_SB
#undef PG8_STAGE
#undef PG8_LDA
#undef PG8_LDB
#undef PG8_MMA
#undef PG8_WAIT_V
#undef PG8_WAIT_L
#undef PG8_BAR
#undef PG8_SCHED
}
}
using pg8::Unit; using pg8::Gemm;
typedef f32x4 AccT[2][2][4][2];

struct EpiG1 {
  static constexpr bool PERM = true, AFTER_DRAIN = false;
  const float* rowsq; bf16_t* proj; bf16_t* U; float* dt; unsigned char* gates;
  DEVI void operator()(const AccT& acc, const Unit& u, int wr, int wc, int fr, int fq) const {
    const int pn = u.pn;
#pragma unroll
    for (int ai = 0; ai < 2; ++ai)
#pragma unroll
      for (int m = 0; m < 4; ++m) {
        const int row = u.pm * 256 + ai * 128 + wr * 64 + m * 16 + fr;
        const float rs = rsqrtf(rowsq[row] * (1.0f / 1024.0f) + EPSF);
#pragma unroll
        for (int bj = 0; bj < 2; ++bj) {
          const int cc = bj * 128 + wc * 32 + fq * 8;
          float v[8];
#pragma unroll
          for (int e = 0; e < 4; ++e) { v[e] = acc[ai][bj][m][0][e] * rs; v[4 + e] = acc[ai][bj][m][1][e] * rs; }
          if (pn >= 12) {
            unsigned q[8];
#pragma unroll
            for (int e = 0; e < 8; ++e) { q[e] = (unsigned)(sigmoidf_(v[e]) * 255.0f + 0.5f); q[e] = q[e] > 255u ? 255u : q[e]; }
            u32x2 w; w[0] = q[0] | (q[1] << 8) | (q[2] << 16) | (q[3] << 24); w[1] = q[4] | (q[5] << 8) | (q[6] << 16) | (q[7] << 24);
            *(u32x2*)(gates + (size_t)row * 4096 + (pn - 12) * 256 + cc) = w;
          } else if (pn == 11) {
            if (cc == 0) *(f32x4*)(dt + (size_t)row * 4) = (f32x4){v[0], v[1], v[2], v[3]};
          } else if (pn == 7) {
            const int g = cc >> 4, i0 = cc & 15;
            *(u32x4*)(U + ((size_t)(g * 512 + (row >> 6)) * UK + (row & 63) * 16 + i0)) = pack8(v);
          } else {
            const int pt = pn < 7 ? pn : pn - 1;
            *(u32x4*)(proj + (size_t)row * PW + pt * 256 + cc) = pack8(v);
          }
        }
      }
  }
};
struct EpiRes {
  static constexpr bool PERM = true, AFTER_DRAIN = false;
  const float* xin; float* xout; bf16_t* xb; float* rsq_out;
  DEVI void operator()(const AccT& acc, const Unit& u, int wr, int wc, int fr, int fq) const {
#pragma unroll
    for (int ai = 0; ai < 2; ++ai)
#pragma unroll
      for (int m = 0; m < 4; ++m) {
        const int row = u.pm * 256 + ai * 128 + wr * 64 + m * 16 + fr;
        float ss = 0.f;
#pragma unroll
        for (int bj = 0; bj < 2; ++bj) {
          const size_t o = (size_t)row * 1024 + u.pn * 256 + bj * 128 + wc * 32 + fq * 8;
          const f32x4 x0 = *(const f32x4*)(xin + o), x1 = *(const f32x4*)(xin + o + 4);
          const f32x4 v0 = acc[ai][bj][m][0] + x0, v1 = acc[ai][bj][m][1] + x1;
          *(f32x4*)(xout + o) = v0; *(f32x4*)(xout + o + 4) = v1;
          u32x4 w; w[0] = pk2(v0[0], v0[1]); w[1] = pk2(v0[2], v0[3]); w[2] = pk2(v1[0], v1[1]); w[3] = pk2(v1[2], v1[3]);
          *(u32x4*)(xb + o) = w;
#pragma unroll
          for (int e = 0; e < 4; ++e) ss += v0[e] * v0[e] + v1[e] * v1[e];
        }
        ss += __shfl_xor(ss, 16); ss += __shfl_xor(ss, 32);
        if (fq == 0) atomicAdd(rsq_out + row, ss);
      }
  }
};
struct EpiFF1 {
  static constexpr bool PERM = true, AFTER_DRAIN = false;
  const float* rowsq; bf16_t* hid;
  DEVI void operator()(const AccT& acc, const Unit& u, int wr, int wc, int fr, int fq) const {
#pragma unroll
    for (int ai = 0; ai < 2; ++ai)
#pragma unroll
      for (int m = 0; m < 4; ++m) {
        const int row = u.pm * 256 + ai * 128 + wr * 64 + m * 16 + fr;
        const float rs = rsqrtf(rowsq[row] * (1.0f / 1024.0f) + EPSF);
#pragma unroll
        for (int bj = 0; bj < 2; ++bj) {
          float v[8];
#pragma unroll
          for (int e = 0; e < 4; ++e) { float a = fmaxf(acc[ai][bj][m][0][e] * rs, 0.f), b = fmaxf(acc[ai][bj][m][1][e] * rs, 0.f); v[e] = a * a; v[4 + e] = b * b; }
          *(u32x4*)(hid + (size_t)row * 4096 + u.pn * 256 + bj * 128 + wc * 32 + fq * 8) = pack8(v);
        }
      }
  }
};
struct EpiPle {
  static constexpr bool PERM = true, AFTER_DRAIN = false;
  bf16_t* ple;
  DEVI void operator()(const AccT& acc, const Unit& u, int wr, int wc, int fr, int fq) const {
#pragma unroll
    for (int ai = 0; ai < 2; ++ai)
#pragma unroll
      for (int m = 0; m < 4; ++m) {
        const int row = u.pm * 256 + ai * 128 + wr * 64 + m * 16 + fr;
#pragma unroll
        for (int bj = 0; bj < 2; ++bj) {
          float v[8];
#pragma unroll
          for (int e = 0; e < 4; ++e) { v[e] = acc[ai][bj][m][0][e]; v[4 + e] = acc[ai][bj][m][1][e]; }
          *(u32x4*)(ple + (size_t)row * 1024 + u.pn * 256 + bj * 128 + wc * 32 + fq * 8) = pack8(v);
        }
      }
  }
};
struct EpiPG {
  static constexpr bool PERM = true, AFTER_DRAIN = false;
  const float* rowsq; const bf16_t* ple; const float* xin; float* xout; bf16_t* xb; float* rsq_out;
  DEVI void operator()(const AccT& acc, const Unit& u, int wr, int wc, int fr, int fq) const {
#pragma unroll
    for (int ai = 0; ai < 2; ++ai)
#pragma unroll
      for (int m = 0; m < 4; ++m) {
        const int row = u.pm * 256 + ai * 128 + wr * 64 + m * 16 + fr;
        const float rs = rsqrtf(rowsq[row] * (1.0f / 1024.0f) + EPSF);
        float ss = 0.f;
#pragma unroll
        for (int bj = 0; bj < 2; ++bj) {
          const size_t o = (size_t)row * 1024 + u.pn * 256 + bj * 128 + wc * 32 + fq * 8;
          const f32x4 x0 = *(const f32x4*)(xin + o), x1 = *(const f32x4*)(xin + o + 4);
          float pl[8]; unpack8(*(const u32x4*)(ple + o), pl);
          float v[8];
#pragma unroll
          for (int e = 0; e < 4; ++e) { v[e] = x0[e] + pl[e] * sigmoidf_(acc[ai][bj][m][0][e] * rs); v[4 + e] = x1[e] + pl[4 + e] * sigmoidf_(acc[ai][bj][m][1][e] * rs); }
          *(f32x4*)(xout + o) = (f32x4){v[0], v[1], v[2], v[3]}; *(f32x4*)(xout + o + 4) = (f32x4){v[4], v[5], v[6], v[7]};
          *(u32x4*)(xb + o) = pack8(v);
#pragma unroll
          for (int e = 0; e < 8; ++e) ss += v[e] * v[e];
        }
        ss += __shfl_xor(ss, 16); ss += __shfl_xor(ss, 32);
        if (fq == 0) atomicAdd(rsq_out + row, ss);
      }
  }
};
struct EpiS5in {
  static constexpr bool PERM = false, AFTER_DRAIN = true;
  bf16_t* U; const float* lam;
  DEVI void operator()(const AccT&, const Unit&, int, int, int, int) const {}
  DEVI void fused(const AccT& acc, const Unit& u, int wr, int wc, int fr, int fq, LAS unsigned char* lds, int wid, int lane) const {
    LAS float* L = (LAS float*)lds;
#pragma unroll
    for (int ai = 0; ai < 2; ++ai)
#pragma unroll
      for (int m = 0; m < 4; ++m) {
        const int rl = ai * 128 + wr * 64 + m * 16 + fr;
#pragma unroll
        for (int n = 0; n < 2; ++n) {
          const int c = wc * 32 + n * 16 + fq * 4;
#pragma unroll
          for (int e = 0; e < 4; ++e) L[rl * 128 + c + e] = acc[ai][0][m][n][e];
        }
      }
    __syncthreads();
    const int tid = ltid(), bl = tid >> 6, p = tid & 63, g = u.grp;
    const float lr = lam[((size_t)(g * 64 + p) * 65 + 64) * 2], li = lam[((size_t)(g * 64 + p) * 65 + 64) * 2 + 1];
    float hr = 0.f, hi = 0.f;
    for (int c = 0; c < 32; ++c) {
      const int rl = bl * 32 + c;
      bf16_t* dst = U + ((size_t)(g * 512 + u.pm * 256 + rl) * UK + 1024);
      dst[p] = f2bf(hr); dst[64 + p] = f2bf(hi);
      const float er = L[rl * 128 + p], ei = L[rl * 128 + 64 + p];
      const float nr = lr * hr - li * hi + er, ni = lr * hi + li * hr + ei;
      hr = nr; hi = ni;
    }
    __syncthreads();
  }
};
struct EpiToep {
  static constexpr bool PERM = true, AFTER_DRAIN = false;
  const bf16_t* U; const float* dskip; bf16_t* Y;
  DEVI void operator()(const AccT& acc, const Unit& u, int wr, int wc, int fr, int fq) const {
    const int g = u.grp;
#pragma unroll
    for (int ai = 0; ai < 2; ++ai)
#pragma unroll
      for (int m = 0; m < 4; ++m) {
        const int r = u.pm * 256 + ai * 128 + wr * 64 + m * 16 + fr;
#pragma unroll
        for (int bj = 0; bj < 2; ++bj) {
          const int cidx = u.pn * 256 + bj * 128 + wc * 32 + fq * 8, s = cidx >> 4, i0 = cidx & 15;
          float uv[8]; unpack8(*(const u32x4*)(U + ((size_t)(g * 512 + r) * UK + cidx)), uv);
          float v[8];
#pragma unroll
          for (int e = 0; e < 8; ++e) { const float a = (e < 4 ? acc[ai][bj][m][0][e] : acc[ai][bj][m][1][e - 4]) + dskip[g * 16 + i0 + e] * uv[e]; v[e] = gelu_tanh(a); }
          *(u32x4*)(Y + (size_t)(r * 64 + s) * 1024 + 512 + g * 16 + i0) = pack8(v);
        }
      }
  }
};
struct EpiGLU {
  static constexpr bool PERM = true, AFTER_DRAIN = false;
  bf16_t* Y;
  DEVI void operator()(const AccT& acc, const Unit& u, int wr, int wc, int fr, int fq) const {
#pragma unroll
    for (int ai = 0; ai < 2; ++ai)
#pragma unroll
      for (int m = 0; m < 4; ++m) {
        const int row = u.pm * 256 + ai * 128 + wr * 64 + m * 16 + fr;
#pragma unroll
        for (int bj = 0; bj < 2; ++bj) {
          bf16_t* p = Y + (size_t)row * 1024 + 512 + bj * 128 + wc * 32 + fq * 8;
          float yv[8]; unpack8(*(const u32x4*)p, yv);
          float v[8];
#pragma unroll
          for (int e = 0; e < 8; ++e) v[e] = yv[e] * sigmoidf_(e < 4 ? acc[ai][bj][m][0][e] : acc[ai][bj][m][1][e - 4]);
          *(u32x4*)p = pack8(v);
        }
      }
  }
};

constexpr int TS = 72;
DEVI f32x4 mma64(const bf16_t* A, int lda, const bf16_t* Bt, int ldb, f32x4 acc, int fr, int fq) {
#pragma unroll
  for (int k = 0; k < 64; k += 32) {
    const bf16x8 a = *(const bf16x8*)(A + fr * lda + k + fq * 8);
    const bf16x8 b = *(const bf16x8*)(Bt + fr * ldb + k + fq * 8);
    acc = mfma16(a, b, acc);
  }
  return acc;
}
DEVI int qpop(int* ctr, int* slot) {
  __syncthreads();
  if (ltid() == 0) *slot = atomicAdd(ctr, 1);
  __syncthreads();
  return *slot;
}

__device__ void hgrn2_seq(const Params& P, int layer, int item, unsigned char* smem) {
  int tid_ = threadIdx.x; asm volatile("" : "+v"(tid_));
  const int tid = tid_, wid = tid >> 6, lane = tid & 63, fr = lane & 15, fq = lane >> 4;
  const int b = item >> 2, h = item & 3, r = tid >> 3, c8 = (tid & 7) * 8;
  float* B32 = (float*)smem;
  float* O32 = (float*)(smem + 16384);
  float* WT = (float*)(smem + 16384 + 16640);
  bf16_t* QB = (bf16_t*)(smem + 35072);
  bf16_t* QT = QB + 64 * TS;
  bf16_t* KT = QT + 64 * TS;
  bf16_t* KET = KT + 4 * 64 * TS;
  bf16_t* VT = KET + 64 * TS;
  bf16_t* SC = VT + 64 * TS;
  bf16_t* ST = SC + 64 * TS;
  const bf16_t* proj = (const bf16_t*)(P.ws + OFF_PROJ);
  bf16_t* Y = (bf16_t*)(P.ws + OFF_Y);
  float lbv[8], og[8];
#pragma unroll
  for (int i = 0; i < 8; ++i) {
    const int k = h * 64 + c8 + i;
    if (layer == 0) lbv[i] = 0.f; else { const float l0 = P.in[4][k], l1 = P.in[4][256 + k]; lbv[i] = 1.0f / (1.0f + expf(l0 - l1)); }
    og[i] = P.in[5][layer * 256 + k];
  }
  f32x4 sacc[2] = {(f32x4){0.f, 0.f, 0.f, 0.f}, (f32x4){0.f, 0.f, 0.f, 0.f}};
  for (int i = tid; i < 2 * 64 * TS; i += 512) ST[i] = 0;
  const bf16_t* pbase = proj + (size_t)(b * SEQ) * PW + h * 64 + c8;
  u32x4 nq, nz, nv, ng;
  { const bf16_t* p = pbase + (size_t)r * PW; nq = *(const u32x4*)p; nz = *(const u32x4*)(p + 256); nv = *(const u32x4*)(p + 512); ng = *(const u32x4*)(p + 768); }
  __syncthreads();
  for (int c = 0; c < NCH; ++c) {
    const int t = c * 64 + r;
    float q[8], z[8], lf[8], kk[8];
    const u32x4 cv = nv, cgt = ng;
    unpack8(nq, q); unpack8(nz, z);
    if (c + 1 < NCH) { const bf16_t* p = pbase + (size_t)(t + 64) * PW; nq = *(const u32x4*)p; nz = *(const u32x4*)(p + 256); nv = *(const u32x4*)(p + 512); ng = *(const u32x4*)(p + 768); }
#pragma unroll
    for (int i = 0; i < 8; ++i) {
      const float e = __expf(-z[i]), inv = 1.0f / (1.0f + e);
      const float f = lbv[i] + (1.0f - lbv[i]) * inv;
      lf[i] = __logf(fmaxf(f, 1e-37f));
      kk[i] = (1.0f - lbv[i]) * e * inv;
    }
#pragma unroll
    for (int d = 8; d < 64; d <<= 1) {
#pragma unroll
      for (int i = 0; i < 8; ++i) { const float tv = __shfl_up(lf[i], d); if (lane >= d) lf[i] += tv; }
    }
    if (lane >= 56) {
#pragma unroll
      for (int i = 0; i < 8; ++i) WT[wid * 64 + c8 + i] = lf[i];
    }
    __syncthreads();
#pragma unroll
    for (int i = 0; i < 8; ++i) {
      float pre = 0.f;
      for (int w = 0; w < wid; ++w) pre += WT[w * 64 + c8 + i];
      lf[i] += pre;
      B32[r * 64 + c8 + i] = lf[i];
    }
    __syncthreads();
    {
      const int I = r >> 4;
      float tq[8], tb[8], vv[8];
      unpack8(cv, vv);
#pragma unroll
      for (int i = 0; i < 8; ++i) { tb[i] = q[i] * __expf(lf[i]); tq[i] = q[i] * __expf(lf[i] - B32[(I * 16) * 64 + c8 + i]); }
      *(u32x4*)(QB + r * TS + c8) = pack8(tb);
      *(u32x4*)(QT + r * TS + c8) = pack8(tq);
      for (int I2 = I; I2 < 4; ++I2) {
        float tk[8];
#pragma unroll
        for (int i = 0; i < 8; ++i) tk[i] = kk[i] * __expf(fminf(B32[(I2 * 16) * 64 + c8 + i] - lf[i], 80.f));
        *(u32x4*)(KT + I2 * 64 * TS + r * TS + c8) = pack8(tk);
      }
#pragma unroll
      for (int i = 0; i < 8; ++i) {
        KET[(c8 + i) * TS + r] = f2bf(kk[i] * __expf(B32[63 * 64 + c8 + i] - lf[i]));
        VT[(c8 + i) * TS + r] = f2bf(vv[i]);
      }
    }
    __syncthreads();
#pragma unroll
    for (int x = 0; x < 2; ++x) {
      const int tl = wid + 8 * x, I = tl >> 2, J = tl & 3;
      f32x4 a = (f32x4){0.f, 0.f, 0.f, 0.f};
      if (J <= I) a = mma64(QT + I * 16 * TS, TS, KT + I * 64 * TS + J * 16 * TS, TS, a, fr, fq);
#pragma unroll
      for (int jj = 0; jj < 4; ++jj) {
        float v = a[jj];
        if (J > I || (J == I && (fq * 4 + jj) < fr)) v = 0.f;
        SC[(I * 16 + fq * 4 + jj) * TS + J * 16 + fr] = f2bf(v);
      }
    }
    __syncthreads();
    const bf16_t* STc = ST + (c & 1) * 64 * TS;
    bf16_t* STn = ST + ((c + 1) & 1) * 64 * TS;
#pragma unroll
    for (int x = 0; x < 2; ++x) {
      const int tb_ = wid >> 1, vb = (wid & 1) * 2 + x;
      f32x4 a = (f32x4){0.f, 0.f, 0.f, 0.f};
      a = mma64(SC + tb_ * 16 * TS, TS, VT + vb * 16 * TS, TS, a, fr, fq);
      a = mma64(QB + tb_ * 16 * TS, TS, STc + vb * 16 * TS, TS, a, fr, fq);
#pragma unroll
      for (int jj = 0; jj < 4; ++jj) O32[(tb_ * 16 + fq * 4 + jj) * 65 + vb * 16 + fr] = a[jj];
      const int kb = (wid & 1) * 2 + x;
      const float dec = __expf(B32[63 * 64 + kb * 16 + fr]);
      f32x4 s = sacc[x];
#pragma unroll
      for (int jj = 0; jj < 4; ++jj) s[jj] *= dec;
      s = mma64(VT + (wid >> 1) * 16 * TS, TS, KET + kb * 16 * TS, TS, s, fr, fq);
      sacc[x] = s;
#pragma unroll
      for (int jj = 0; jj < 4; ++jj) STn[((wid >> 1) * 16 + fq * 4 + jj) * TS + kb * 16 + fr] = f2bf(s[jj]);
    }
    __syncthreads();
    {
      float o[8], gg[8]; float ss = 0.f;
      unpack8(cgt, gg);
#pragma unroll
      for (int i = 0; i < 8; ++i) { o[i] = O32[r * 65 + c8 + i]; ss += o[i] * o[i]; }
      ss += __shfl_xor(ss, 1); ss += __shfl_xor(ss, 2); ss += __shfl_xor(ss, 4);
      const float rs = rsqrtf(ss * (1.0f / 64.0f) + EPSF);
#pragma unroll
      for (int i = 0; i < 8; ++i) o[i] = o[i] * rs * og[i] * siluf_(gg[i]);
      *(u32x4*)(Y + (size_t)(b * SEQ + t) * 1024 + h * 64 + c8) = pack8(o);
    }
  }
  __syncthreads();
}

__device__ void ssd_seq(const Params& P, int layer, int item, unsigned char* smem) {
  int tid_ = threadIdx.x; asm volatile("" : "+v"(tid_));
  const int tid = tid_, wid = tid >> 6, lane = tid & 63, fr = lane & 15, fq = lane >> 4;
  const int b = item >> 1, grp = item & 1, r = tid >> 3, cg_ = tid & 7, c8 = cg_ * 8;
  constexpr int RS = 264;
  bf16_t* RAW = (bf16_t*)smem;
  float* O32 = (float*)smem;
  float* CW = (float*)(smem + 35840);
  float* ACUM = (float*)(smem + 35840 + 5120);
  float* DTV = ACUM + 128;
  bf16_t* XS = (bf16_t*)(smem + 35840 + 5120 + 1024);
  bf16_t* CM = XS + 64 * 136;
  bf16_t* BM = CM + 64 * TS;
  bf16_t* BMT = BM + 64 * TS;
  bf16_t* CS = BMT + 64 * TS;
  bf16_t* XDTT = CS + 64 * TS;
  bf16_t* XDECT = XDTT + 64 * TS;
  bf16_t* MS = XDECT + 64 * TS;
  bf16_t* STATE = MS + 64 * TS;
  const bf16_t* proj = (const bf16_t*)(P.ws + OFF_PROJ);
  const float* dtb = (const float*)(P.ws + OFF_SMALL + S_DT);
  bf16_t* Y = (bf16_t*)(P.ws + OFF_Y);
  const int h0 = grp * 2;
  if (tid < 256) {
    const int lc = tid; const int ch = lc < 128 ? grp * 128 + lc : (lc < 192 ? 256 + grp * 64 + (lc - 128) : 384 + grp * 64 + (lc - 192));
    const float* w = P.in[6] + ((size_t)layer * 512 + ch) * 4;
    CW[lc * 5 + 0] = w[0]; CW[lc * 5 + 1] = w[1]; CW[lc * 5 + 2] = w[2]; CW[lc * 5 + 3] = w[3]; CW[lc * 5 + 4] = P.in[7][layer * 512 + ch];
  }
  for (int i = tid; i < 2 * 64 * TS; i += 512) STATE[i] = 0;
  const float dtbias0 = P.in[8][layer * 4 + h0], dtbias1 = P.in[8][layer * 4 + h0 + 1];
  const float aneg0 = -expf(P.in[9][layer * 4 + h0]), aneg1 = -expf(P.in[9][layer * 4 + h0 + 1]);
  const float dsk0 = P.in[10][layer * 4 + h0], dsk1 = P.in[10][layer * 4 + h0 + 1];
  f32x4 sacc[2][2];
#pragma unroll
  for (int a = 0; a < 2; ++a)
#pragma unroll
    for (int x = 0; x < 2; ++x) sacc[a][x] = (f32x4){0.f, 0.f, 0.f, 0.f};
  __syncthreads();
  for (int c = 0; c < NCH; ++c) {
    const int t0 = b * SEQ + c * 64;
    for (int idx = tid; idx < 67 * 32; idx += 512) {
      const int rr = idx >> 5, pc = idx & 31;
      const int col = pc < 16 ? 1280 + grp * 128 + pc * 8 : (pc < 24 ? 1536 + grp * 64 + (pc - 16) * 8 : 1664 + grp * 64 + (pc - 24) * 8);
      u32x4 v = (u32x4){0u, 0u, 0u, 0u};
      if (c > 0 || rr >= 3) v = *(const u32x4*)(proj + (size_t)(t0 - 3 + rr) * PW + col);
      *(u32x4*)(RAW + rr * RS + pc * 8) = v;
    }
    if (wid == 0) {
      const f32x4 d4 = *(const f32x4*)(dtb + (size_t)(t0 + lane) * 4);
      float x0 = d4[h0] + dtbias0, x1 = d4[h0 + 1] + dtbias1;
      float dt0 = x0 > 20.f ? x0 : log1pf(__expf(x0)), dt1 = x1 > 20.f ? x1 : log1pf(__expf(x1));
      float a0 = dt0 * aneg0, a1 = dt1 * aneg1;
#pragma unroll
      for (int d = 1; d < 64; d <<= 1) { const float u0 = __shfl_up(a0, d), u1 = __shfl_up(a1, d); if (lane >= d) { a0 += u0; a1 += u1; } }
      ACUM[lane] = a0; ACUM[64 + lane] = a1; DTV[lane] = dt0; DTV[64 + lane] = dt1;
    }
    __syncthreads();
#pragma unroll
    for (int q4 = 0; q4 < 4; ++q4) {
      const int lc0 = cg_ * 32 + q4 * 8;
      float accv[8];
#pragma unroll
      for (int i = 0; i < 8; ++i) accv[i] = CW[(lc0 + i) * 5 + 4];
#pragma unroll
      for (int tap = 0; tap < 4; ++tap) {
        float xv[8]; unpack8(*(const u32x4*)(RAW + (r + tap) * RS + lc0), xv);
#pragma unroll
        for (int i = 0; i < 8; ++i) accv[i] += xv[i] * CW[(lc0 + i) * 5 + tap];
      }
#pragma unroll
      for (int i = 0; i < 8; ++i) accv[i] = siluf_(accv[i]);
      if (cg_ < 4) { *(u32x4*)(XS + r * 136 + lc0) = pack8(accv); }
      else if (cg_ < 6) { const int n0 = lc0 - 128; *(u32x4*)(BM + r * TS + n0) = pack8(accv);
#pragma unroll
        for (int i = 0; i < 8; ++i) BMT[(n0 + i) * TS + r] = f2bf(accv[i]); }
      else { const int n0 = lc0 - 192; *(u32x4*)(CM + r * TS + n0) = pack8(accv); }
    }
    __syncthreads();
    f32x4 gt[2];
#pragma unroll
    for (int x = 0; x < 2; ++x) {
      const int tl = wid + 8 * x, lb = tl >> 2, sb = tl & 3;
      gt[x] = (f32x4){0.f, 0.f, 0.f, 0.f};
      if (sb <= lb) gt[x] = mma64(CM + lb * 16 * TS, TS, BM + sb * 16 * TS, TS, gt[x], fr, fq);
    }
#pragma unroll
    for (int hh = 0; hh < 2; ++hh) {
      const float* ac = ACUM + hh * 64;
      {
        float xs[8], cm[8], cs[8]; unpack8(*(const u32x4*)(XS + r * 136 + hh * 64 + c8), xs); unpack8(*(const u32x4*)(CM + r * TS + c8), cm);
        const float dtv = DTV[hh * 64 + r], dec = __expf(ac[63] - ac[r]), ea = __expf(ac[r]);
#pragma unroll
        for (int i = 0; i < 8; ++i) { const float xd = xs[i] * dtv; XDTT[(c8 + i) * TS + r] = f2bf(xd); XDECT[(c8 + i) * TS + r] = f2bf(xd * dec); cs[i] = cm[i] * ea; }
        *(u32x4*)(CS + r * TS + c8) = pack8(cs);
      }
#pragma unroll
      for (int x = 0; x < 2; ++x) {
        const int tl = wid + 8 * x, lb = tl >> 2, sb = tl & 3;
#pragma unroll
        for (int jj = 0; jj < 4; ++jj) {
          const int l = lb * 16 + fq * 4 + jj, s = sb * 16 + fr;
          float v = 0.f;
          if (l >= s) v = gt[x][jj] * __expf(ac[l] - ac[s]);
          MS[l * TS + s] = f2bf(v);
        }
      }
      __syncthreads();
      const bf16_t* STh = STATE + hh * 64 * TS;
      f32x4 snew[2];
#pragma unroll
      for (int x = 0; x < 2; ++x) {
        const int lb = wid >> 1, pb = (wid & 1) * 2 + x;
        f32x4 a = (f32x4){0.f, 0.f, 0.f, 0.f};
        a = mma64(MS + lb * 16 * TS, TS, XDTT + pb * 16 * TS, TS, a, fr, fq);
        a = mma64(CS + lb * 16 * TS, TS, STh + pb * 16 * TS, TS, a, fr, fq);
#pragma unroll
        for (int jj = 0; jj < 4; ++jj) O32[(lb * 16 + fq * 4 + jj) * 129 + hh * 64 + pb * 16 + fr] = a[jj];
        const int nb = (wid & 1) * 2 + x;
        const float dchunk = __expf(ac[63]);
        f32x4 s = sacc[hh][x];
#pragma unroll
        for (int jj = 0; jj < 4; ++jj) s[jj] *= dchunk;
        s = mma64(XDECT + (wid >> 1) * 16 * TS, TS, BMT + nb * 16 * TS, TS, s, fr, fq);
        sacc[hh][x] = s; snew[x] = s;
      }
      __syncthreads();
#pragma unroll
      for (int x = 0; x < 2; ++x) {
        const int nb = (wid & 1) * 2 + x;
#pragma unroll
        for (int jj = 0; jj < 4; ++jj) STATE[hh * 64 * TS + ((wid >> 1) * 16 + fq * 4 + jj) * TS + nb * 16 + fr] = f2bf(snew[x][jj]);
      }
    }
    __syncthreads();
    {
      const int ch0 = cg_ * 16; const float dsk = ch0 < 64 ? dsk0 : dsk1;
      const int t = t0 + r;
      float zz[16], xs[16], y[16];
      unpack8(*(const u32x4*)(proj + (size_t)t * PW + 1024 + grp * 128 + ch0), zz); unpack8(*(const u32x4*)(proj + (size_t)t * PW + 1024 + grp * 128 + ch0 + 8), zz + 8);
      unpack8(*(const u32x4*)(XS + r * 136 + ch0), xs); unpack8(*(const u32x4*)(XS + r * 136 + ch0 + 8), xs + 8);
      float ss = 0.f;
#pragma unroll
      for (int i = 0; i < 16; ++i) { y[i] = (O32[r * 129 + ch0 + i] + dsk * xs[i]) * siluf_(zz[i]); ss += y[i] * y[i]; }
      ss += __shfl_xor(ss, 1); ss += __shfl_xor(ss, 2); ss += __shfl_xor(ss, 4);
      const float rs = rsqrtf(ss * (1.0f / 128.0f) + EPSF);
      const float* ng = P.in[11] + layer * 256 + grp * 128 + ch0;
#pragma unroll
      for (int i = 0; i < 16; ++i) y[i] = y[i] * rs * ng[i];
      bf16_t* dst = Y + (size_t)t * 1024 + 256 + grp * 128 + ch0;
      *(u32x4*)dst = pack8(y); *(u32x4*)(dst + 8) = pack8(y + 8);
    }
    __syncthreads();
  }
}

__device__ void attn_item(const Params& P, int layer, int item, unsigned char* smem) {
  int tid_ = threadIdx.x; asm volatile("" : "+v"(tid_));
  const int tid = tid_, wid = tid >> 6, lane = tid & 63, fr = lane & 15, fq = lane >> 4;
  const int cp = item & 15, h = (item >> 4) & 3, b = item >> 6;
  const int wq = wid >> 2, qb = wid & 3, r = tid >> 3, c8 = (tid & 7) * 8;
  bf16_t* KH = (bf16_t*)smem;
  bf16_t* VTT = KH + 2 * 64 * TS;
  float* BIAS = (float*)(smem + 4 * 64 * TS * 2);
  const bf16_t* proj = (const bf16_t*)(P.ws + OFF_PROJ);
  bf16_t* Y = (bf16_t*)(P.ws + OFF_Y);
  __syncthreads();
  if (tid < 257) BIAS[tid] = P.in[23][((size_t)layer * 4 + h) * 257 + tid];
  const int c0 = cp * 2, cme = c0 + wq;
  const size_t tb = (size_t)b * SEQ;
  bf16x8 qf[2];
  {
    const bf16_t* qp = proj + (tb + cme * 64 + qb * 16 + fr) * PW + 1792 + h * 64;
    float a[8], c[8]; unpack8(*(const u32x4*)(qp + fq * 8), a); unpack8(*(const u32x4*)(qp + 32 + fq * 8), c);
    float ss = 0.f;
#pragma unroll
    for (int i = 0; i < 8; ++i) ss += a[i] * a[i] + c[i] * c[i];
    ss += __shfl_xor(ss, 16); ss += __shfl_xor(ss, 32);
    const float rs = rsqrtf(ss * (1.0f / 64.0f) + EPSF) * 0.125f;
    const float* qg = P.in[21] + layer * 64;
#pragma unroll
    for (int i = 0; i < 8; ++i) { a[i] *= rs * qg[fq * 8 + i]; c[i] *= rs * qg[32 + fq * 8 + i]; }
    u32x4 wa = pack8(a), wc_ = pack8(c);
    qf[0] = *(bf16x8*)&wa; qf[1] = *(bf16x8*)&wc_;
  }
  float kgn[8];
#pragma unroll
  for (int i = 0; i < 8; ++i) kgn[i] = P.in[22][layer * 64 + c8 + i];
  f32x4 oacc[4];
#pragma unroll
  for (int d = 0; d < 4; ++d) oacc[d] = (f32x4){0.f, 0.f, 0.f, 0.f};
  float mrun = -1e30f, lrun = 0.f;
  const int cs = c0 - 8 > 0 ? c0 - 8 : 0, ce = c0 + 1;
  u32x4 nk, nv;
  { const bf16_t* kp = proj + (tb + cs * 64 + r) * PW + 2048 + h * 64 + c8; nk = *(const u32x4*)kp; nv = *(const u32x4*)(kp + 256); }
  for (int cc = cs; cc <= ce; ++cc) {
    const int buf = (cc - cs) & 1;
    {
      float kv[8], vv[8]; unpack8(nk, kv); unpack8(nv, vv);
      if (cc < ce) { const bf16_t* kp = proj + (tb + (cc + 1) * 64 + r) * PW + 2048 + h * 64 + c8; nk = *(const u32x4*)kp; nv = *(const u32x4*)(kp + 256); }
      float ss = 0.f;
#pragma unroll
      for (int i = 0; i < 8; ++i) ss += kv[i] * kv[i];
      ss += __shfl_xor(ss, 1); ss += __shfl_xor(ss, 2); ss += __shfl_xor(ss, 4);
      const float rs = rsqrtf(ss * (1.0f / 64.0f) + EPSF);
#pragma unroll
      for (int i = 0; i < 8; ++i) kv[i] *= rs * kgn[i];
      *(u32x4*)(KH + buf * 64 * TS + r * TS + c8) = pack8(kv);
#pragma unroll
      for (int i = 0; i < 8; ++i) VTT[buf * 64 * TS + (c8 + i) * TS + r] = f2bf(vv[i]);
    }
    __syncthreads();
    const int j = cc - (cme - 8);
    if (j >= 0 && j <= 8) {
      const bf16_t* Kb = KH + buf * 64 * TS; const bf16_t* Vb = VTT + buf * 64 * TS;
      f32x4 s[4];
#pragma unroll
      for (int kt = 0; kt < 4; ++kt) {
        s[kt] = (f32x4){0.f, 0.f, 0.f, 0.f};
#pragma unroll
        for (int ks = 0; ks < 2; ++ks) { const bf16x8 a = *(const bf16x8*)(Kb + (kt * 16 + fr) * TS + ks * 32 + fq * 8); s[kt] = mfma16(a, qf[ks], s[kt]); }
      }
      const int qpos = qb * 16 + fr;
      float mx = -1e30f;
#pragma unroll
      for (int kt = 0; kt < 4; ++kt)
#pragma unroll
        for (int jj = 0; jj < 4; ++jj) {
          const int kpos = j * 64 + kt * 16 + fq * 4 + jj;
          int rel = qpos + 512 - kpos; rel = rel > 128 ? 128 : (rel < -128 ? -128 : rel);
          const float v = s[kt][jj] + BIAS[rel + 128];
          s[kt][jj] = v; mx = fmaxf(mx, v);
        }
      mx = fmaxf(mx, __shfl_xor(mx, 16)); mx = fmaxf(mx, __shfl_xor(mx, 32));
      const float mnew = fmaxf(mrun, mx), alpha = __expf(mrun - mnew);
      mrun = mnew;
      float ps = 0.f;
#pragma unroll
      for (int kt = 0; kt < 4; ++kt)
#pragma unroll
        for (int jj = 0; jj < 4; ++jj) { const float p = __expf(s[kt][jj] - mnew); s[kt][jj] = p; ps += p; }
      lrun = lrun * alpha + ps;
      bf16x8 pb[2];
#pragma unroll
      for (int k2 = 0; k2 < 2; ++k2) {
        u32x4 w; w[0] = pk2(s[2 * k2][0], s[2 * k2][1]); w[1] = pk2(s[2 * k2][2], s[2 * k2][3]); w[2] = pk2(s[2 * k2 + 1][0], s[2 * k2 + 1][1]); w[3] = pk2(s[2 * k2 + 1][2], s[2 * k2 + 1][3]);
        pb[k2] = *(bf16x8*)&w;
      }
#pragma unroll
      for (int d = 0; d < 4; ++d) {
#pragma unroll
        for (int e = 0; e < 4; ++e) oacc[d][e] *= alpha;
#pragma unroll
        for (int k2 = 0; k2 < 2; ++k2) {
          const bf16_t* vp = Vb + (d * 16 + fr) * TS + k2 * 32 + fq * 4;
          const u32x2 lo = *(const u32x2*)vp, hi = *(const u32x2*)(vp + 16);
          u32x4 w; w[0] = lo[0]; w[1] = lo[1]; w[2] = hi[0]; w[3] = hi[1];
          oacc[d] = mfma16(*(bf16x8*)&w, pb[k2], oacc[d]);
        }
      }
    }
  }
  lrun += __shfl_xor(lrun, 16); lrun += __shfl_xor(lrun, 32);
  const float il = 1.0f / lrun;
  bf16_t* yp = Y + (tb + cme * 64 + qb * 16 + fr) * 1024 + 768 + h * 64;
#pragma unroll
  for (int d = 0; d < 4; ++d) {
    u32x2 w; w[0] = pk2(oacc[d][0] * il, oacc[d][1] * il); w[1] = pk2(oacc[d][2] * il, oacc[d][3] * il);
    *(u32x2*)(yp + d * 16 + fq * 4) = w;
  }
}

__device__ void toep_build(const Params& P, int layer, int item) {
  item = lsg(item); layer = lsg(layer);
  const int g = item >> 4, nb = item & 15;
  const float* KTb = (const float*)(P.ws + OFF_SMALL + S_KT) + (size_t)(layer * 16 + g) * 64 * 256;
  const float* lam = (const float*)(P.ws + OFF_SMALL + S_LAM) + (size_t)(layer * 16 + g) * 64 * 65 * 2;
  const float* Cre = P.in[16] + (size_t)(layer * 16 + g) * 16 * 64;
  const float* Cim = P.in[17] + (size_t)(layer * 16 + g) * 16 * 64;
  bf16_t* dst = (bf16_t*)(P.ws + OFF_TOEP) + (size_t)g * 1024 * UK;
  for (int idx = ltid(); idx < 64 * (UK / 2); idx += 512) {
    const int n = nb * 64 + idx / (UK / 2), k0 = (idx % (UK / 2)) * 2;
    const int t = n >> 4, i = n & 15;
    float v[2];
#pragma unroll
    for (int e = 0; e < 2; ++e) {
      const int k = k0 + e;
      if (k < 1024) { const int s = k >> 4, i2 = k & 15; v[e] = t >= s ? KTb[((t - s) * 16 + i) * 16 + i2] : 0.f; }
      else { const int kk = k - 1024, p = kk & 63; const float lr = lam[(p * 65 + t + 1) * 2], li = lam[(p * 65 + t + 1) * 2 + 1];
        const float cr = Cre[i * 64 + p], ci = Cim[i * 64 + p];
        v[e] = kk < 64 ? (cr * lr - ci * li) : -(cr * li + ci * lr); }
    }
    *(unsigned*)(dst + (size_t)n * UK + k0) = pk2(v[0], v[1]);
  }
}

__device__ void wprep_tile(const float* src, int ld, int K, bf16_t* dst, const float* scale, int n0, int k0, int srccol, int nvalid, float* tile) {
  const int tid = ltid();
  __syncthreads();
#pragma unroll
  for (int i = 0; i < 8; ++i) {
    const int idx = tid + 512 * i, kk = idx >> 6, nn = idx & 63;
    float v = 0.f;
    if (nn < nvalid) { v = src[(size_t)(k0 + kk) * ld + srccol + nn]; if (scale) v *= scale[k0 + kk]; }
    tile[kk * 65 + nn] = v;
  }
  __syncthreads();
#pragma unroll
  for (int i = 0; i < 4; ++i) {
    const int idx = tid + 512 * i, nn = idx >> 5, kp = (idx & 31) * 2;
    *(unsigned*)(dst + (size_t)(n0 + nn) * K + k0 + kp) = pk2(tile[kp * 65 + nn], tile[(kp + 1) * 65 + nn]);
  }
}
__device__ void prep_layer(const Params& P, int layer, unsigned char* smem) {
  layer = lsg(layer);
  float* tile = (float*)smem;
  unsigned char* W = P.ws + OFF_W;
  for (int tl = lbid(); tl < 4688; tl += gridDim.x) {
    int x = tl;
    if (x < 1792) {
      const int nt64 = x >> 4, kt = x & 15, pn = nt64 >> 2, sub = nt64 & 3;
      int sc, nv = 64;
      if (pn < 4) sc = pn * 256 + sub * 64; else if (pn == 4) sc = 1024 + sub * 64; else if (pn < 7) sc = 1280 + (pn - 5) * 256 + sub * 64;
      else if (pn == 7) sc = 1796 + sub * 64; else if (pn < 11) sc = 2052 + (pn - 8) * 256 + sub * 64;
      else if (pn == 11) { sc = 1792; nv = sub == 0 ? 4 : 0; } else sc = 2820 + (pn - 12) * 256 + sub * 64;
      wprep_tile(P.in[3] + (size_t)layer * 1024 * 6916, 6916, 1024, (bf16_t*)(W + W_IN), P.in[2] + layer * 1024, nt64 * 64, kt * 64, sc, nv, tile);
      continue;
    }
    x -= 1792;
    if (x < 256) { const int m = x >> 6, y = x & 63, nt = y >> 2, kt = y & 3;
      wprep_tile(P.in[24] + ((size_t)layer * 4 + m) * 256 * 1024, 1024, 256, (bf16_t*)(W + W_BR) + (size_t)m * 1024 * 256, nullptr, nt * 64, kt * 64, nt * 64, 64, tile); continue; }
    x -= 256;
    if (x < 256) { const int nt = x >> 4, kt = x & 15;
      wprep_tile(P.in[25] + (size_t)layer * 1024 * 1024, 1024, 1024, (bf16_t*)(W + W_OUT), nullptr, nt * 64, kt * 64, nt * 64, 64, tile); continue; }
    x -= 256;
    if (x < 1024) { const int nt = x >> 4, kt = x & 15;
      wprep_tile(P.in[27] + (size_t)layer * 1024 * 4096, 4096, 1024, (bf16_t*)(W + W_FF1), P.in[26] + layer * 1024, nt * 64, kt * 64, nt * 64, 64, tile); continue; }
    x -= 1024;
    if (x < 1024) { const int nt = x >> 6, kt = x & 63;
      wprep_tile(P.in[28] + (size_t)layer * 4096 * 1024, 1024, 4096, (bf16_t*)(W + W_FF2), nullptr, nt * 64, kt * 64, nt * 64, 64, tile); continue; }
    x -= 1024;
    if (x < 64) { const int nt = x >> 2, kt = x & 3;
      wprep_tile(P.in[29] + (size_t)layer * 256 * 1024, 1024, 256, (bf16_t*)(W + W_PLE), nullptr, nt * 64, kt * 64, nt * 64, 64, tile); continue; }
    x -= 64;
    if (x < 256) { const int nt = x >> 4, kt = x & 15;
      wprep_tile(P.in[31] + (size_t)layer * 1024 * 1024, 1024, 1024, (bf16_t*)(W + W_PG + (size_t)layer * 2 * MiB), P.in[30] + layer * 1024, nt * 64, kt * 64, nt * 64, 64, tile); continue; }
    x -= 256;
    { const int nt = x >> 2, kt = x & 3;
      wprep_tile(P.in[20] + (size_t)layer * 256 * 256, 256, 256, (bf16_t*)(W + W_GLU), nullptr, nt * 64, kt * 64, nt * 64, 64, tile); }
  }
  const float* lamL = (const float*)(P.ws + OFF_SMALL + S_LAM) + (size_t)layer * 16 * 64 * 65 * 2;
  const float* bbL = (const float*)(P.ws + OFF_SMALL + S_BB) + (size_t)layer * 16 * 64 * 16 * 2;
  bf16_t* mint = (bf16_t*)(P.ws + OFF_MINT);
  for (size_t idx = (size_t)lbid() * 512 + ltid(); idx < (size_t)16 * 256 * 512; idx += (size_t)gridDim.x * 512) {
    const int k0 = (int)(idx & 511) * 2, n = (int)(idx >> 9) & 255, g = (int)(idx >> 17);
    float v[2] = {0.f, 0.f};
    if (n < 128) {
      const int p = n & 63;
#pragma unroll
      for (int e = 0; e < 2; ++e) {
        const int k = k0 + e, s = k >> 4, i2 = k & 15;
        const float lr = lamL[((size_t)(g * 64 + p) * 65 + (63 - s)) * 2], li = lamL[((size_t)(g * 64 + p) * 65 + (63 - s)) * 2 + 1];
        const float br = bbL[((size_t)(g * 64 + p) * 16 + i2) * 2], bi = bbL[((size_t)(g * 64 + p) * 16 + i2) * 2 + 1];
        v[e] = n < 64 ? (lr * br - li * bi) : (lr * bi + li * br);
      }
    }
    *(unsigned*)(mint + ((size_t)(g * 256 + n) * 1024 + k0)) = pk2(v[0], v[1]);
  }
}

__device__ void merge_phase(const Params& P, unsigned char* smem) {
  int tid_ = threadIdx.x; asm volatile("" : "+v"(tid_));
  const int tid = tid_, wid = tid >> 6, lane = tid & 63, fr = lane & 15, fq = lane >> 4, wr = wid >> 2, wc = wid & 3;
  constexpr int LS = 264;
  bf16_t* As = (bf16_t*)smem; bf16_t* Bs = As + 128 * LS;
  const bf16_t* Y = (const bf16_t*)(P.ws + OFF_Y);
  const bf16_t* Wb = (const bf16_t*)(P.ws + OFF_W + W_BR);
  const unsigned char* gates = P.ws + OFF_GATES;
  bf16_t* merged = (bf16_t*)(P.ws + OFF_MERGED);
  for (int tile = lbid(); tile < 2048; tile += gridDim.x) {
    const int pm = tile >> 3, pn = tile & 7, row0 = pm * 128, col0 = pn * 128;
    f32x4 mg[4][2];
#pragma unroll
    for (int a = 0; a < 4; ++a)
#pragma unroll
      for (int n = 0; n < 2; ++n) mg[a][n] = (f32x4){0.f, 0.f, 0.f, 0.f};
    for (int m = 0; m < 4; ++m) {
      __syncthreads();
#pragma unroll
      for (int i = 0; i < 8; ++i) {
        const int idx = tid + 512 * i, rr = idx >> 5, pc = idx & 31;
        *(u32x4*)(As + rr * LS + pc * 8) = *(const u32x4*)(Y + (size_t)(row0 + rr) * 1024 + m * 256 + pc * 8);
        *(u32x4*)(Bs + rr * LS + pc * 8) = *(const u32x4*)(Wb + ((size_t)m * 1024 + col0 + rr) * 256 + pc * 8);
      }
      __syncthreads();
      f32x4 acc[4][2];
#pragma unroll
      for (int a = 0; a < 4; ++a)
#pragma unroll
        for (int n = 0; n < 2; ++n) acc[a][n] = (f32x4){0.f, 0.f, 0.f, 0.f};
#pragma unroll
      for (int k = 0; k < 8; ++k) {
        bf16x8 af[4], bfr[2];
#pragma unroll
        for (int a = 0; a < 4; ++a) af[a] = *(const bf16x8*)(As + (wr * 64 + a * 16 + fr) * LS + k * 32 + fq * 8);
#pragma unroll
        for (int n = 0; n < 2; ++n) bfr[n] = *(const bf16x8*)(Bs + (wc * 32 + n * 16 + fr) * LS + k * 32 + fq * 8);
#pragma unroll
        for (int a = 0; a < 4; ++a)
#pragma unroll
          for (int n = 0; n < 2; ++n) acc[a][n] = mfma16(bfr[n], af[a], acc[a][n]);
      }
#pragma unroll
      for (int a = 0; a < 4; ++a) {
        const int row = row0 + wr * 64 + a * 16 + fr;
#pragma unroll
        for (int n = 0; n < 2; ++n) {
          const unsigned gw = *(const unsigned*)(gates + (size_t)row * 4096 + m * 1024 + col0 + wc * 32 + n * 16 + fq * 4);
#pragma unroll
          for (int e = 0; e < 4; ++e) mg[a][n][e] += acc[a][n][e] * ((float)((gw >> (8 * e)) & 255u) * (1.0f / 255.0f));
        }
      }
    }
#pragma unroll
    for (int a = 0; a < 4; ++a) {
      const int row = row0 + wr * 64 + a * 16 + fr;
#pragma unroll
      for (int n = 0; n < 2; ++n) {
        u32x2 w; w[0] = pk2(mg[a][n][0], mg[a][n][1]); w[1] = pk2(mg[a][n][2], mg[a][n][3]);
        *(u32x2*)(merged + (size_t)row * 1024 + col0 + wc * 32 + n * 16 + fq * 4) = w;
      }
    }
  }
}

__device__ void prep_global_a(const Params& P) {
  const int tid = ltid(), wid = tid >> 6, lane = tid & 63;
  float* rowsq = (float*)(P.ws + OFF_SMALL + S_ROWSQ);
  bf16_t* xb = (bf16_t*)(P.ws + OFF_XB);
  const float* x = P.in[0];
  for (int row = lbid() * 8 + wid; row < T_TOK; row += gridDim.x * 8) {
    float ss = 0.f;
#pragma unroll
    for (int i = 0; i < 2; ++i) {
      const size_t o = (size_t)row * 1024 + i * 512 + lane * 8;
      const f32x4 a = *(const f32x4*)(x + o), c = *(const f32x4*)(x + o + 4);
      u32x4 w; w[0] = pk2(a[0], a[1]); w[1] = pk2(a[2], a[3]); w[2] = pk2(c[0], c[1]); w[3] = pk2(c[2], c[3]);
      *(u32x4*)(xb + o) = w;
#pragma unroll
      for (int e = 0; e < 4; ++e) ss += a[e] * a[e] + c[e] * c[e];
    }
#pragma unroll
    for (int d = 1; d < 64; d <<= 1) ss += __shfl_xor(ss, d);
    if (lane == 0) rowsq[row] = ss;
  }
  const size_t gt = (size_t)lbid() * 512 + tid, gn = (size_t)gridDim.x * 512;
  for (size_t i = gt; i < (size_t)6 * T_TOK; i += gn) rowsq[T_TOK + i] = 0.f;
  int* ctr = (int*)(P.ws + OFF_SMALL + S_CTR);
  if (lbid() == 0 && tid < 64) ctr[tid] = 0;
  float* lam = (float*)(P.ws + OFF_SMALL + S_LAM);
  float* bb = (float*)(P.ws + OFF_SMALL + S_BB);
  for (size_t i = gt; i < (size_t)2 * 16 * 64 * 65; i += gn) {
    const int tau = (int)(i % 65), gp = (int)(i / 65), L = gp >> 10, g = (gp >> 6) & 15;
    const double are = (double)P.in[12][gp], aim = (double)P.in[13][gp], step = exp((double)P.in[19][L * 16 + g]);
    const double mag = exp(are * step * (double)tau), ang = aim * step * (double)tau;
    lam[i * 2] = (float)(mag * cos(ang)); lam[i * 2 + 1] = (float)(mag * sin(ang));
  }
  for (size_t i = gt; i < (size_t)2 * 16 * 64 * 16; i += gn) {
    const int gp = (int)(i >> 4), L = gp >> 10, g = (gp >> 6) & 15;
    const double are = (double)P.in[12][gp], aim = (double)P.in[13][gp], step = exp((double)P.in[19][L * 16 + g]);
    const double mag = exp(are * step), lr = mag * cos(aim * step), li = mag * sin(aim * step);
    const double den = are * are + aim * aim, nr = lr - 1.0;
    const double cr = (nr * are + li * aim) / den, ci = (li * are - nr * aim) / den;
    const double br = (double)P.in[14][i], bi = (double)P.in[15][i];
    bb[i * 2] = (float)(cr * br - ci * bi); bb[i * 2 + 1] = (float)(cr * bi + ci * br);
  }
}
__device__ void prep_global_b(const Params& P) {
  const float* lam = (const float*)(P.ws + OFF_SMALL + S_LAM);
  const float* bb = (const float*)(P.ws + OFF_SMALL + S_BB);
  float* KT = (float*)(P.ws + OFF_SMALL + S_KT);
  for (size_t idx = (size_t)lbid() * 512 + ltid(); idx < (size_t)2 * 16 * 64 * 256; idx += (size_t)gridDim.x * 512) {
    const int i2 = (int)(idx & 15), i = (int)(idx >> 4) & 15, tau = (int)(idx >> 8) & 63, Lg = (int)(idx >> 14);
    const float* cre = P.in[16] + ((size_t)Lg * 16 + i) * 64; const float* cim = P.in[17] + ((size_t)Lg * 16 + i) * 64;
    float acc = 0.f;
    for (int p = 0; p < 64; ++p) {
      const float lr = lam[((size_t)(Lg * 64 + p) * 65 + tau) * 2], li = lam[((size_t)(Lg * 64 + p) * 65 + tau) * 2 + 1];
      const float br = bb[((size_t)(Lg * 64 + p) * 16 + i2) * 2], bi = bb[((size_t)(Lg * 64 + p) * 16 + i2) * 2 + 1];
      const float xr = lr * br - li * bi, xi = lr * bi + li * br;
      acc += cre[p] * xr - cim[p] * xi;
    }
    KT[idx] = acc;
  }
}
__device__ void convert_p(const Params& P, int layer) {
  layer = lsg(layer);
  const float* src = P.in[1] + (size_t)layer * T_TOK * 256;
  bf16_t* dst = (bf16_t*)(P.ws + OFF_PB);
  for (size_t i = ((size_t)lbid() * 512 + ltid()) * 8; i < (size_t)T_TOK * 256; i += (size_t)gridDim.x * 512 * 8) {
    const f32x4 a = *(const f32x4*)(src + i), c = *(const f32x4*)(src + i + 4);
    u32x4 w; w[0] = pk2(a[0], a[1]); w[1] = pk2(a[2], a[3]); w[2] = pk2(c[0], c[1]); w[3] = pk2(c[2], c[3]);
    *(u32x4*)(dst + i) = w;
  }
}

__global__ void __launch_bounds__(512) mega(Params P) {
  extern __shared__ __attribute__((aligned(16))) unsigned char smem[];
  cg::grid_group grid = cg::this_grid();
  LAS unsigned char* lds = (LAS unsigned char*)smem;
  int* qslot = (int*)(smem + LDS_BYTES - 16);
#define PHASE_PTRS unsigned char* ws = lptr(P.ws); float* rowsq = (float*)(ws + OFF_SMALL + S_ROWSQ); bf16_t* xb = (bf16_t*)(ws + OFF_XB); (void)rowsq; (void)xb;
  const int G = gridDim.x, cid = lbid();

  prep_global_a(P);
  grid.sync();
  prep_global_b(P);
  prep_layer(P, lsg(0), smem);
  grid.sync();

#pragma unroll 1
  for (int layer = 0; layer < 2; ++layer) {
    {
      PHASE_PTRS
      Gemm g{xb, (const bf16_t*)(ws + OFF_W + W_IN), 1024, 1024, 1024, 0, 0};
      pg8::StaticOrder S; S.init(128, 28, G, cid);
      EpiG1 E{rowsq + (size_t)(3 * layer) * T_TOK, (bf16_t*)(ws + OFF_PROJ), (bf16_t*)(ws + OFF_U), (float*)(ws + OFF_SMALL + S_DT), ws + OFF_GATES};
      pg8::gemm_phase(lds, g, S, E);
    }
    grid.sync();
    {
      PHASE_PTRS
      int* q = (int*)(ws + OFF_SMALL + S_CTR) + layer * 8;
      for (;;) {
        const int it = qpop(q, qslot);
        if (it >= 1408) break;
        if (it < 32) {
#ifndef SKIP_SSD
          ssd_seq(P, layer, it, smem);
#endif
        }
        else if (it < 96) {
#ifndef SKIP_HG
          hgrn2_seq(P, layer, it - 32, smem);
#endif
        }
        else if (it < 128) {
          const int x = it - 96;
          Gemm g{(const bf16_t*)(ws + OFF_U), (const bf16_t*)(ws + OFF_MINT), UK, 1024, 1024, (size_t)512 * UK * 2, (size_t)256 * 1024 * 2};
          pg8::OneUnit S; S.u = Unit{x & 1, 0, x >> 1};
          EpiS5in E{(bf16_t*)(ws + OFF_U), (const float*)(ws + OFF_SMALL + S_LAM) + (size_t)layer * 16 * 64 * 65 * 2};
          pg8::gemm_phase(lds, g, S, E);
        }
        else if (it < 384) toep_build(P, layer, it - 128);
        else {
#ifndef SKIP_ATT
          attn_item(P, layer, it - 384, smem);
#endif
        }
      }
    }
    grid.sync();
    for (int x = cid; x < 128; x += G) {
      PHASE_PTRS
      Gemm g{(const bf16_t*)(ws + OFF_U), (const bf16_t*)(ws + OFF_TOEP), UK, UK, UK, (size_t)512 * UK * 2, (size_t)1024 * UK * 2};
      pg8::OneUnit S; S.u = Unit{(x >> 2) & 1, x & 3, x >> 3};
      EpiToep E{(const bf16_t*)(ws + OFF_U), P.in[18] + layer * 256, (bf16_t*)(ws + OFF_Y)};
      pg8::gemm_phase(lds, g, S, E);
    }
    grid.sync();
    for (int x = cid; x < 128; x += G) {
      PHASE_PTRS
      Gemm g{(const bf16_t*)(ws + OFF_Y) + 512, (const bf16_t*)(ws + OFF_W + W_GLU), 1024, 256, 256, 0, 0};
      pg8::OneUnit S; S.u = Unit{x, 0, 0};
      EpiGLU E{(bf16_t*)(ws + OFF_Y)};
      pg8::gemm_phase(lds, g, S, E);
    }
    grid.sync();
#ifndef SKIP_MERGE
    merge_phase(P, smem);
#endif
    grid.sync();
    convert_p(P, layer);
    {
      PHASE_PTRS
      Gemm g{(const bf16_t*)(ws + OFF_MERGED), (const bf16_t*)(ws + OFF_W + W_OUT), 1024, 1024, 1024, 0, 0};
      pg8::StaticOrder S; S.init(128, 4, G, cid);
      EpiRes E{layer == 0 ? P.in[0] : P.out, P.out, xb, rowsq + (size_t)(3 * layer + 1) * T_TOK};
      pg8::gemm_phase(lds, g, S, E);
    }
    grid.sync();
    {
      PHASE_PTRS
      Gemm g{xb, (const bf16_t*)(ws + OFF_W + W_FF1), 1024, 1024, 1024, 0, 0};
      pg8::StaticOrder S; S.init(128, 16, G, cid);
      EpiFF1 E{rowsq + (size_t)(3 * layer + 1) * T_TOK, (bf16_t*)(ws + OFF_HID)};
      pg8::gemm_phase(lds, g, S, E);
    }
    {
      PHASE_PTRS
      Gemm g{(const bf16_t*)(ws + OFF_PB), (const bf16_t*)(ws + OFF_W + W_PLE), 256, 256, 256, 0, 0};
      pg8::StaticOrder S; S.init(128, 4, G, cid);
      EpiPle E{(bf16_t*)(ws + OFF_PLE)};
      pg8::gemm_phase(lds, g, S, E);
    }
    grid.sync();
    {
      PHASE_PTRS
      Gemm g{(const bf16_t*)(ws + OFF_HID), (const bf16_t*)(ws + OFF_W + W_FF2), 4096, 4096, 4096, 0, 0};
      pg8::StaticOrder S; S.init(128, 4, G, cid);
      EpiRes E{P.out, P.out, xb, rowsq + (size_t)(3 * layer + 2) * T_TOK};
      pg8::gemm_phase(lds, g, S, E);
    }
    grid.sync();
    {
      PHASE_PTRS
      Gemm g{xb, (const bf16_t*)(ws + OFF_W + W_PG + (size_t)layer * 2 * MiB), 1024, 1024, 1024, 0, 0};
      pg8::StaticOrder S; S.init(128, 4, G, cid);
      EpiPG E{rowsq + (size_t)(3 * layer + 2) * T_TOK, (const bf16_t*)(ws + OFF_PLE), P.out, P.out, xb, rowsq + (size_t)(3 * layer + 3) * T_TOK};
      pg8::gemm_phase(lds, g, S, E);
    }
    if (layer == 0) { __syncthreads(); prep_layer(P, lsg(1), smem); }
    grid.sync();
  }
}

extern "C" void kernel_launch(void* const* d_in, const int* in_sizes, int n_in, void* d_out, int out_size, void* d_ws, size_t ws_size, hipStream_t stream) {
  static int grid_blocks = 0;
  if (ws_size < WS_NEED) { fprintf(stderr, "workspace too small: %zu < %zu\n", ws_size, (size_t)WS_NEED); return; }
  if (!grid_blocks) {
    int dev = 0, cus = 0, per_cu = 0;
    hipGetDevice(&dev);
    hipDeviceGetAttribute(&cus, hipDeviceAttributeMultiprocessorCount, dev);
    hipFuncSetAttribute((const void*)mega, hipFuncAttributeMaxDynamicSharedMemorySize, LDS_BYTES);
    hipOccupancyMaxActiveBlocksPerMultiprocessor(&per_cu, mega, 512, LDS_BYTES);
    if (per_cu < 1) per_cu = 1;
    grid_blocks = cus * per_cu;
    if (grid_blocks > 256) grid_blocks = 256;
  }
  Params P{};
  for (int i = 0; i < 32; ++i) P.in[i] = (const float*)d_in[i];
  P.out = (float*)d_out; P.ws = (unsigned char*)d_ws;
  void* args[] = {&P};
  hipError_t e = hipLaunchCooperativeKernel((void*)mega, dim3(grid_blocks), dim3(512), args, LDS_BYTES, stream);
  if (e != hipSuccess) fprintf(stderr, "cooperative launch failed: %s (grid %d)\n", hipGetErrorString(e), grid_blocks);
}
```

```cpp
#include <hip/hip_runtime.h>
#include <hip/hip_cooperative_groups.h>
#include <cstdio>
namespace cg = cooperative_groups;

#define DEVI __device__ __forceinline__
#define LAS __attribute__((address_space(3)))
typedef unsigned short bf16_t;
typedef short bf16x8 __attribute__((ext_vector_type(8)));
typedef short bf16x4 __attribute__((ext_vector_type(4)));
typedef float f32x4 __attribute__((ext_vector_type(4)));
typedef unsigned u32x4 __attribute__((ext_vector_type(4)));
typedef unsigned u32x2 __attribute__((ext_vector_type(2)));

constexpr int T_TOK = 32768, DM = 1024, SEQ = 2048, NCH = 32;
constexpr int PW = 2560;
constexpr int UK = 1152;
constexpr float EPSF = 1e-6f;
constexpr size_t MiB = 1024ull * 1024ull;
constexpr size_t OFF_GATES = 0, OFF_HID = 0, OFF_Y = 128 * MiB, OFF_PROJ = 192 * MiB, OFF_MERGED = 192 * MiB, OFF_PLE = 256 * MiB,
                 OFF_PB = 320 * MiB, OFF_XB = 352 * MiB, OFF_TOEP = 352 * MiB, OFF_W = 416 * MiB, OFF_MINT = 456 * MiB, OFF_U = 464 * MiB,
                 OFF_SMALL = 483 * MiB, WS_NEED = 490 * MiB;
constexpr size_t W_IN = 0, W_BR = 14 * MiB, W_OUT = 16 * MiB, W_FF1 = 18 * MiB, W_FF2 = 26 * MiB, W_PLE = 34 * MiB, W_GLU = 34 * MiB + 512 * 1024,
                 W_PG = 35 * MiB  ;
constexpr size_t S_ROWSQ = 0, S_KT = 1 * MiB, S_LAM = 3 * MiB, S_BB = 3 * MiB + 1280 * 1024, S_DT = 5 * MiB, S_CTR = 5 * MiB + 512 * 1024, S_BAR = 5 * MiB + 768 * 1024;
constexpr int LDS_BYTES = 152 * 1024;
#ifndef REP_A
#define REP_A 1
#endif
#ifndef REP_B1
#define REP_B1 1
#endif
#ifndef REP_B3
#define REP_B3 1
#endif
#ifndef REP_C
#define REP_C 1
#endif
#ifndef REP_E
#define REP_E 1
#endif

struct Params { const float* in[32]; float* out; unsigned char* ws; };

DEVI int ltid() { int t = threadIdx.x; asm volatile("" : "+v"(t)); return t; }
DEVI int lbid() { int b = blockIdx.x; asm volatile("" : "+s"(b)); return b; }
DEVI unsigned char* lptr(unsigned char* p) { asm volatile("" : "+s"(p)); return p; }
DEVI int lsg(int v) { asm volatile("" : "+s"(v)); return v; }
DEVI float bf2f(unsigned v) { return __uint_as_float(v << 16); }
DEVI bf16_t f2bf(float f) { unsigned u = __float_as_uint(f); u += 0x7FFFu + ((u >> 16) & 1u); return (bf16_t)(u >> 16); }
DEVI unsigned pk2(float lo, float hi) { unsigned r; asm volatile("v_cvt_pk_bf16_f32 %0, %1, %2" : "=v"(r) : "v"(lo), "v"(hi)); return r; }
DEVI void unpack8(u32x4 w, float* f) {
#pragma unroll
  for (int i = 0; i < 4; ++i) { f[2 * i] = __uint_as_float(w[i] << 16); f[2 * i + 1] = __uint_as_float(w[i] & 0xffff0000u); }
}
DEVI u32x4 pack8(const float* f) { u32x4 w; w[0] = pk2(f[0], f[1]); w[1] = pk2(f[2], f[3]); w[2] = pk2(f[4], f[5]); w[3] = pk2(f[6], f[7]); return w; }
DEVI float sigmoidf_(float x) { return 1.0f / (1.0f + __expf(-x)); }
DEVI float siluf_(float x) { return x / (1.0f + __expf(-x)); }
DEVI float gelu_tanh(float x) { float u = 0.7978845608f * (x + 0.044715f * x * x * x); float t = 1.0f - 2.0f / (1.0f + __expf(2.0f * u)); return 0.5f * x * (1.0f + t); }
DEVI f32x4 mfma16(bf16x8 a, bf16x8 b, f32x4 c) { return __builtin_amdgcn_mfma_f32_16x16x32_bf16(a, b, c, 0, 0, 0); }

namespace pg8 {
constexpr int BM = 256, BK = 64, HALF = 128, HTB = HALF * BK * 2, STAGE_BYTES = 8 * HTB, NXCD = 8, WGM = 8;
DEVI int lds_byte(int r, int c) { const int st = (r >> 4) * 2 + (c >> 5), rr = r & 15, cc = c & 31, ob = rr * 64 + cc * 2; return st * 1024 + (ob ^ (((ob >> 9) & 1) << 5)); }
DEVI void stage_rc(int b, int& R, int& C) { const int st = b / 1024, sb = b % 1024, swz = sb ^ (((sb >> 9) & 1) << 5); R = (st >> 1) * 16 + swz / 64; C = (st & 1) * 32 + (swz % 64) / 2; }
DEVI int perm32(int rho) { const int n = rho >> 4, i = rho & 15; return 8 * (i >> 2) + 4 * n + (i & 3); }
struct Unit { int pm, pn, grp; };
struct Gemm { const bf16_t* A; const bf16_t* Bt; int lda, ldb, K; size_t gsA, gsB; };
struct StaticOrder {
  int nM, nN, nwg, G, c;
  DEVI void init(int nM_, int nN_, int G_, int c_) { nM = nM_; nN = nN_; nwg = nM * nN; G = G_; c = c_; }
  DEVI bool next(int i, Unit& u) const {
    const long L = (long)i * G + c; if (L >= nwg) return false;
    int wgid = (int)L; { const int q = nwg / NXCD, r = nwg % NXCD, xcd = wgid % NXCD, off = wgid / NXCD; wgid = (xcd < r ? xcd * (q + 1) : r * (q + 1) + (xcd - r) * q) + off; }
    const int nig = WGM * nN, gid = wgid / nig, fm = gid * WGM, gsz = (nM - fm) < WGM ? (nM - fm) : WGM;
    u.pm = fm + ((wgid % nig) % gsz); u.pn = (wgid % nig) / gsz; u.grp = 0; return true;
  }
};
struct OneUnit { Unit u; DEVI bool next(int i, Unit& o) const { if (i != 0) return false; o = u; return true; } };

template <class Epi, class Sched>
DEVI void gemm_phase(LAS unsigned char* lds, const Gemm g, const Sched& S, const Epi& E) {
  int tid_ = threadIdx.x; asm volatile("" : "+v"(tid_));
  const int tid = tid_, wid = __builtin_amdgcn_readfirstlane(tid >> 6), lane = tid & 63, wr = wid >> 2, wc = wid & 3, fr = lane & 15, fq = lane >> 4;
  const int K = g.K, nt = K / BK;
  unsigned voffA[2], voffB[2];
#pragma unroll
  for (int i = 0; i < 2; ++i) { int R, C; stage_rc(tid * 16 + i * 8192, R, C); const int Rb = Epi::PERM ? ((R & ~31) + perm32(R & 31)) : R;
    voffA[i] = (unsigned)(R * g.lda + C) * 2u; voffB[i] = (unsigned)(Rb * g.ldb + C) * 2u; }
  const size_t kstep = (size_t)(BK * 2);
  const size_t hstepA = (size_t)HALF * g.lda * 2, hstepB = (size_t)HALF * g.ldb * 2;
  const unsigned ldsw = (unsigned)wid * 1024u;
  const int aoff = lds_byte(wr * 64 + fr, fq * 8), boff = lds_byte(wc * 32 + fr, fq * 8);
#define PG8_SA(b, h) (((b) * 2 + (h)) * HTB)
#define PG8_SB(b, h) ((4 + (b) * 2 + (h)) * HTB)
#define PG8_STAGE(bufoff, gbase, voff) do { _Pragma("unroll") for (int _i = 0; _i < 2; ++_i) \
    __builtin_amdgcn_global_load_lds((const unsigned*)((const char*)(gbase) + (voff)[_i]), (LAS unsigned*)(lds + (bufoff) + ldsw + _i * 8192), 16, 0, 0); } while (0)
#define PG8_LDA(dst, b, h) do { _Pragma("unroll") for (int m = 0; m < 4; ++m) _Pragma("unroll") for (int k = 0; k < 2; ++k) dst[m][k] = *(const LAS bf16x8*)(lds + PG8_SA(b, h) + aoff + m * 2048 + k * 1024); } while (0)
#define PG8_LDB(dst, b, h) do { _Pragma("unroll") for (int n = 0; n < 2; ++n) _Pragma("unroll") for (int k = 0; k < 2; ++k) dst[n][k] = *(const LAS bf16x8*)(lds + PG8_SB(b, h) + boff + n * 2048 + k * 1024); } while (0)
#define PG8_MMA(ai, bj, At, Bt) do { __builtin_amdgcn_s_setprio(1); _Pragma("unroll") for (int m = 0; m < 4; ++m) _Pragma("unroll") for (int n = 0; n < 2; ++n) _Pragma("unroll") for (int k = 0; k < 2; ++k) \
    acc[ai][bj][m][n] = __builtin_amdgcn_mfma_f32_16x16x32_bf16(Bt[n][k], At[m][k], acc[ai][bj][m][n], 0, 0, 0); __builtin_amdgcn_s_setprio(0); } while (0)
#define PG8_WAIT_V(n) asm volatile("s_waitcnt vmcnt(" #n ")" ::: "memory")
#define PG8_WAIT_L(n) asm volatile("s_waitcnt lgkmcnt(" #n ")" ::: "memory")
#define PG8_BAR __builtin_amdgcn_s_barrier()
#define PG8_SCHED __builtin_amdgcn_sched_barrier(0)
  Unit cur, nxt; int ui = 0;
  if (!S.next(0, cur)) return;
  f32x4 acc[2][2][4][2];
#pragma unroll
  for (int a = 0; a < 2; ++a)
#pragma unroll
    for (int b = 0; b < 2; ++b)
#pragma unroll
      for (int m = 0; m < 4; ++m)
#pragma unroll
        for (int n = 0; n < 2; ++n) acc[a][b][m][n] = (f32x4){0.f, 0.f, 0.f, 0.f};
  bf16x8 At[4][2], B0[2][2], B1[2][2];
  const char* cA = (const char*)g.A + (size_t)cur.grp * g.gsA + (size_t)cur.pm * 2 * hstepA;
  const char* cB = (const char*)g.Bt + (size_t)cur.grp * g.gsB + (size_t)cur.pn * 2 * hstepB;
  PG8_STAGE(PG8_SB(0, 0), cB, voffB); PG8_STAGE(PG8_SA(0, 0), cA, voffA); PG8_STAGE(PG8_SB(0, 1), cB + hstepB, voffB); PG8_STAGE(PG8_SA(0, 1), cA + hstepA, voffA);
  if (wr == 1) PG8_BAR;
  PG8_WAIT_V(4); PG8_BAR;
  PG8_STAGE(PG8_SB(1, 0), cB + kstep, voffB); PG8_STAGE(PG8_SA(1, 0), cA + kstep, voffA); PG8_STAGE(PG8_SB(1, 1), cB + hstepB + kstep, voffB);
  PG8_WAIT_V(6); PG8_BAR;
  for (;;) {
    const bool has_next = S.next(ui + 1, nxt);
    const char* nA = has_next ? (const char*)g.A + (size_t)nxt.grp * g.gsA + (size_t)nxt.pm * 2 * hstepA : cA;
    const char* nB = has_next ? (const char*)g.Bt + (size_t)nxt.grp * g.gsB + (size_t)nxt.pn * 2 * hstepB : cB;
    for (int t = 0; t < nt; t += 2) {
      const bool last = (t == nt - 2);
      const char* a1 = cA + (size_t)(t + 1) * kstep;
      const char* a2 = last ? nA : cA + (size_t)(t + 2) * kstep; const char* b2 = last ? nB : cB + (size_t)(t + 2) * kstep;
      const char* a3 = a2 + kstep; const char* b3 = b2 + kstep;
      PG8_LDB(B0, 0, 0); PG8_SCHED; PG8_LDA(At, 0, 0); PG8_STAGE(PG8_SA(1, 1), a1 + hstepA, voffA);
      PG8_WAIT_L(8); PG8_BAR; PG8_WAIT_L(0); PG8_MMA(0, 0, At, B0); PG8_BAR; PG8_SCHED;
      PG8_LDB(B1, 0, 1); PG8_STAGE(PG8_SB(0, 0), b2, voffB);
      PG8_BAR; PG8_WAIT_L(0); PG8_MMA(0, 1, At, B1); PG8_BAR;
      PG8_LDA(At, 0, 1); PG8_STAGE(PG8_SA(0, 0), a2, voffA);
      PG8_BAR; PG8_WAIT_L(0); PG8_MMA(1, 0, At, B0); PG8_BAR; PG8_SCHED;
      PG8_STAGE(PG8_SB(0, 1), b2 + hstepB, voffB);
      PG8_WAIT_V(6); PG8_BAR; PG8_MMA(1, 1, At, B1); PG8_BAR;
      PG8_LDB(B0, 1, 0); PG8_SCHED; PG8_LDA(At, 1, 0); PG8_STAGE(PG8_SA(0, 1), a2 + hstepA, voffA);
      PG8_WAIT_L(8); PG8_BAR; PG8_WAIT_L(0); PG8_MMA(0, 0, At, B0); PG8_BAR; PG8_SCHED;
      PG8_LDB(B1, 1, 1); PG8_STAGE(PG8_SB(1, 0), b3, voffB);
      PG8_BAR; PG8_WAIT_L(0); PG8_MMA(0, 1, At, B1); PG8_BAR;
      PG8_LDA(At, 1, 1); PG8_STAGE(PG8_SA(1, 0), a3, voffA);
      PG8_BAR; PG8_WAIT_L(0); PG8_MMA(1, 0, At, B0); PG8_BAR; PG8_SCHED;
      PG8_STAGE(PG8_SB(1, 1), b3 + hstepB, voffB);
      PG8_WAIT_V(6); PG8_BAR; PG8_MMA(1, 1, At, B1); PG8_BAR;
    }
    if constexpr (!Epi::AFTER_DRAIN) { E(acc, cur, wr, wc, fr, fq); }
    if (!has_next) break;
#pragma unroll
    for (int a = 0; a < 2; ++a)
#pragma unroll
      for (int b = 0; b < 2; ++b)
#pragma unroll
        for (int m = 0; m < 4; ++m)
#pragma unroll
          for (int n = 0; n < 2; ++n) acc[a][b][m][n] = (f32x4){0.f, 0.f, 0.f, 0.f};
    cur = nxt; cA = nA; cB = nB; ++ui;
  }
  PG8_WAIT_V(0);
  if (wr == 0) PG8_BAR;
  PG8_BAR;
  if constexpr (Epi::AFTER_DRAIN) { E.fused(acc, cur, wr, wc, fr, fq, lds, wid, lane); }
#undef PG8_SA
#undef PG8_SB
#undef PG8_STAGE
#undef PG8_LDA
#undef PG8_LDB
#undef PG8_MMA
#undef PG8_WAIT_V
#undef PG8_WAIT_L
#undef PG8_BAR
#undef PG8_SCHED
}
}
using pg8::Unit; using pg8::Gemm;
typedef f32x4 AccT[2][2][4][2];

struct EpiG1 {
  static constexpr bool PERM = true, AFTER_DRAIN = false;
  const float* rowsq; bf16_t* proj; bf16_t* U; float* dt; unsigned char* gates;
  DEVI void operator()(const AccT& acc, const Unit& u, int wr, int wc, int fr, int fq) const {
    const int pn = u.pn;
#pragma unroll
    for (int ai = 0; ai < 2; ++ai)
#pragma unroll
      for (int m = 0; m < 4; ++m) {
        const int row = u.pm * 256 + ai * 128 + wr * 64 + m * 16 + fr;
        const float rs = rsqrtf(rowsq[row] * (1.0f / 1024.0f) + EPSF);
#pragma unroll
        for (int bj = 0; bj < 2; ++bj) {
          const int cc = bj * 128 + wc * 32 + fq * 8;
          float v[8];
#pragma unroll
          for (int e = 0; e < 4; ++e) { v[e] = acc[ai][bj][m][0][e] * rs; v[4 + e] = acc[ai][bj][m][1][e] * rs; }
          if (pn >= 12) {
            unsigned q[8];
#pragma unroll
            for (int e = 0; e < 8; ++e) { q[e] = (unsigned)(sigmoidf_(v[e]) * 255.0f + 0.5f); q[e] = q[e] > 255u ? 255u : q[e]; }
            u32x2 w; w[0] = q[0] | (q[1] << 8) | (q[2] << 16) | (q[3] << 24); w[1] = q[4] | (q[5] << 8) | (q[6] << 16) | (q[7] << 24);
            *(u32x2*)(gates + (size_t)row * 4096 + (pn - 12) * 256 + cc) = w;
          } else if (pn == 11) {
            if (cc == 0) *(f32x4*)(dt + (size_t)row * 4) = (f32x4){v[0], v[1], v[2], v[3]};
          } else if (pn == 7) {
            const int g = cc >> 4, i0 = cc & 15;
            *(u32x4*)(U + ((size_t)(g * 512 + (row >> 6)) * UK + (row & 63) * 16 + i0)) = pack8(v);
          } else {
            const int pt = pn < 7 ? pn : pn - 1;
            *(u32x4*)(proj + (size_t)row * PW + pt * 256 + cc) = pack8(v);
          }
        }
      }
  }
};
struct EpiRes {
  static constexpr bool PERM = true, AFTER_DRAIN = false;
  const float* xin; float* xout; bf16_t* xb; float* rsq_out;
  DEVI void operator()(const AccT& acc, const Unit& u, int wr, int wc, int fr, int fq) const {
#pragma unroll
    for (int ai = 0; ai < 2; ++ai)
#pragma unroll
      for (int m = 0; m < 4; ++m) {
        const int row = u.pm * 256 + ai * 128 + wr * 64 + m * 16 + fr;
        float ss = 0.f;
#pragma unroll
        for (int bj = 0; bj < 2; ++bj) {
          const size_t o = (size_t)row * 1024 + u.pn * 256 + bj * 128 + wc * 32 + fq * 8;
          const f32x4 x0 = *(const f32x4*)(xin + o), x1 = *(const f32x4*)(xin + o + 4);
          const f32x4 v0 = acc[ai][bj][m][0] + x0, v1 = acc[ai][bj][m][1] + x1;
          *(f32x4*)(xout + o) = v0; *(f32x4*)(xout + o + 4) = v1;
          u32x4 w; w[0] = pk2(v0[0], v0[1]); w[1] = pk2(v0[2], v0[3]); w[2] = pk2(v1[0], v1[1]); w[3] = pk2(v1[2], v1[3]);
          *(u32x4*)(xb + o) = w;
#pragma unroll
          for (int e = 0; e < 4; ++e) ss += v0[e] * v0[e] + v1[e] * v1[e];
        }
        ss += __shfl_xor(ss, 16); ss += __shfl_xor(ss, 32);
        if (fq == 0) atomicAdd(rsq_out + row, ss);
      }
  }
};
struct EpiFF1 {
  static constexpr bool PERM = true, AFTER_DRAIN = false;
  const float* rowsq; bf16_t* hid;
  DEVI void operator()(const AccT& acc, const Unit& u, int wr, int wc, int fr, int fq) const {
#pragma unroll
    for (int ai = 0; ai < 2; ++ai)
#pragma unroll
      for (int m = 0; m < 4; ++m) {
        const int row = u.pm * 256 + ai * 128 + wr * 64 + m * 16 + fr;
        const float rs = rsqrtf(rowsq[row] * (1.0f / 1024.0f) + EPSF);
#pragma unroll
        for (int bj = 0; bj < 2; ++bj) {
          float v[8];
#pragma unroll
          for (int e = 0; e < 4; ++e) { float a = fmaxf(acc[ai][bj][m][0][e] * rs, 0.f), b = fmaxf(acc[ai][bj][m][1][e] * rs, 0.f); v[e] = a * a; v[4 + e] = b * b; }
          *(u32x4*)(hid + (size_t)row * 4096 + u.pn * 256 + bj * 128 + wc * 32 + fq * 8) = pack8(v);
        }
      }
  }
};
struct EpiPle {
  static constexpr bool PERM = true, AFTER_DRAIN = false;
  bf16_t* ple;
  DEVI void operator()(const AccT& acc, const Unit& u, int wr, int wc, int fr, int fq) const {
#pragma unroll
    for (int ai = 0; ai < 2; ++ai)
#pragma unroll
      for (int m = 0; m < 4; ++m) {
        const int row = u.pm * 256 + ai * 128 + wr * 64 + m * 16 + fr;
#pragma unroll
        for (int bj = 0; bj < 2; ++bj) {
          float v[8];
#pragma unroll
          for (int e = 0; e < 4; ++e) { v[e] = acc[ai][bj][m][0][e]; v[4 + e] = acc[ai][bj][m][1][e]; }
          *(u32x4*)(ple + (size_t)row * 1024 + u.pn * 256 + bj * 128 + wc * 32 + fq * 8) = pack8(v);
        }
      }
  }
};
struct EpiPG {
  static constexpr bool PERM = true, AFTER_DRAIN = false;
  const float* rowsq; const bf16_t* ple; const float* xin; float* xout; bf16_t* xb; float* rsq_out;
  DEVI void operator()(const AccT& acc, const Unit& u, int wr, int wc, int fr, int fq) const {
#pragma unroll
    for (int ai = 0; ai < 2; ++ai)
#pragma unroll
      for (int m = 0; m < 4; ++m) {
        const int row = u.pm * 256 + ai * 128 + wr * 64 + m * 16 + fr;
        const float rs = rsqrtf(rowsq[row] * (1.0f / 1024.0f) + EPSF);
        float ss = 0.f;
#pragma unroll
        for (int bj = 0; bj < 2; ++bj) {
          const size_t o = (size_t)row * 1024 + u.pn * 256 + bj * 128 + wc * 32 + fq * 8;
          const f32x4 x0 = *(const f32x4*)(xin + o), x1 = *(const f32x4*)(xin + o + 4);
          float pl[8]; unpack8(*(const u32x4*)(ple + o), pl);
          float v[8];
#pragma unroll
          for (int e = 0; e < 4; ++e) { v[e] = x0[e] + pl[e] * sigmoidf_(acc[ai][bj][m][0][e] * rs); v[4 + e] = x1[e] + pl[4 + e] * sigmoidf_(acc[ai][bj][m][1][e] * rs); }
          *(f32x4*)(xout + o) = (f32x4){v[0], v[1], v[2], v[3]}; *(f32x4*)(xout + o + 4) = (f32x4){v[4], v[5], v[6], v[7]};
          *(u32x4*)(xb + o) = pack8(v);
#pragma unroll
          for (int e = 0; e < 8; ++e) ss += v[e] * v[e];
        }
        ss += __shfl_xor(ss, 16); ss += __shfl_xor(ss, 32);
        if (fq == 0) atomicAdd(rsq_out + row, ss);
      }
  }
};
struct EpiS5in {
  static constexpr bool PERM = false, AFTER_DRAIN = true;
  bf16_t* U; const float* lam;
  DEVI void operator()(const AccT&, const Unit&, int, int, int, int) const {}
  DEVI void fused(const AccT& acc, const Unit& u, int wr, int wc, int fr, int fq, LAS unsigned char* lds, int wid, int lane) const {
    LAS float* L = (LAS float*)lds;
#pragma unroll
    for (int ai = 0; ai < 2; ++ai)
#pragma unroll
      for (int m = 0; m < 4; ++m) {
        const int rl = ai * 128 + wr * 64 + m * 16 + fr;
#pragma unroll
        for (int n = 0; n < 2; ++n) {
          const int c = wc * 32 + n * 16 + fq * 4;
#pragma unroll
          for (int e = 0; e < 4; ++e) L[rl * 128 + c + e] = acc[ai][0][m][n][e];
        }
      }
    __syncthreads();
    const int tid = ltid(), bl = tid >> 6, p = tid & 63, g = u.grp;
    const float lr = lam[((size_t)(g * 64 + p) * 65 + 64) * 2], li = lam[((size_t)(g * 64 + p) * 65 + 64) * 2 + 1];
    float hr = 0.f, hi = 0.f;
    for (int c = 0; c < 32; ++c) {
      const int rl = bl * 32 + c;
      bf16_t* dst = U + ((size_t)(g * 512 + u.pm * 256 + rl) * UK + 1024);
      dst[p] = f2bf(hr); dst[64 + p] = f2bf(hi);
      const float er = L[rl * 128 + p], ei = L[rl * 128 + 64 + p];
      const float nr = lr * hr - li * hi + er, ni = lr * hi + li * hr + ei;
      hr = nr; hi = ni;
    }
    __syncthreads();
  }
};
struct EpiToep {
  static constexpr bool PERM = true, AFTER_DRAIN = false;
  const bf16_t* U; const float* dskip; bf16_t* Y;
  DEVI void operator()(const AccT& acc, const Unit& u, int wr, int wc, int fr, int fq) const {
    const int g = u.grp;
#pragma unroll
    for (int ai = 0; ai < 2; ++ai)
#pragma unroll
      for (int m = 0; m < 4; ++m) {
        const int r = u.pm * 256 + ai * 128 + wr * 64 + m * 16 + fr;
#pragma unroll
        for (int bj = 0; bj < 2; ++bj) {
          const int cidx = u.pn * 256 + bj * 128 + wc * 32 + fq * 8, s = cidx >> 4, i0 = cidx & 15;
          float uv[8]; unpack8(*(const u32x4*)(U + ((size_t)(g * 512 + r) * UK + cidx)), uv);
          float v[8];
#pragma unroll
          for (int e = 0; e < 8; ++e) { const float a = (e < 4 ? acc[ai][bj][m][0][e] : acc[ai][bj][m][1][e - 4]) + dskip[g * 16 + i0 + e] * uv[e]; v[e] = gelu_tanh(a); }
          *(u32x4*)(Y + (size_t)(r * 64 + s) * 1024 + 512 + g * 16 + i0) = pack8(v);
        }
      }
  }
};
struct EpiGLU {
  static constexpr bool PERM = true, AFTER_DRAIN = false;
  bf16_t* Y;
  DEVI void operator()(const AccT& acc, const Unit& u, int wr, int wc, int fr, int fq) const {
#pragma unroll
    for (int ai = 0; ai < 2; ++ai)
#pragma unroll
      for (int m = 0; m < 4; ++m) {
        const int row = u.pm * 256 + ai * 128 + wr * 64 + m * 16 + fr;
#pragma unroll
        for (int bj = 0; bj < 2; ++bj) {
          bf16_t* p = Y + (size_t)row * 1024 + 512 + bj * 128 + wc * 32 + fq * 8;
          float yv[8]; unpack8(*(const u32x4*)p, yv);
          float v[8];
#pragma unroll
          for (int e = 0; e < 8; ++e) v[e] = yv[e] * sigmoidf_(e < 4 ? acc[ai][bj][m][0][e] : acc[ai][bj][m][1][e - 4]);
          *(u32x4*)p = pack8(v);
        }
      }
  }
};

constexpr int TS = 72;
DEVI f32x4 mma64(const bf16_t* A, int lda, const bf16_t* Bt, int ldb, f32x4 acc, int fr, int fq) {
#pragma unroll
  for (int k = 0; k < 64; k += 32) {
    const bf16x8 a = *(const bf16x8*)(A + fr * lda + k + fq * 8);
    const bf16x8 b = *(const bf16x8*)(Bt + fr * ldb + k + fq * 8);
    acc = mfma16(a, b, acc);
  }
  return acc;
}
DEVI int qpop(int* ctr, int* slot) {
  __syncthreads();
  if (ltid() == 0) *slot = atomicAdd(ctr, 1);
  __syncthreads();
  return *slot;
}

__device__ void hgrn2_seq(const Params& P, int layer, int item, unsigned char* smem) {
  int tid_ = threadIdx.x; asm volatile("" : "+v"(tid_));
  const int tid = tid_, wid = tid >> 6, lane = tid & 63, fr = lane & 15, fq = lane >> 4;
  const int b = item >> 2, h = item & 3, r = tid >> 3, c8 = (tid & 7) * 8;
  float* B32 = (float*)smem;
  float* O32 = (float*)(smem + 16384);
  float* WT = (float*)(smem + 16384 + 16640);
  bf16_t* QB = (bf16_t*)(smem + 35072);
  bf16_t* QT = QB + 64 * TS;
  bf16_t* KT = QT + 64 * TS;
  bf16_t* KET = KT + 4 * 64 * TS;
  bf16_t* VT = KET + 64 * TS;
  bf16_t* SC = VT + 64 * TS;
  bf16_t* ST = SC + 64 * TS;
  const bf16_t* proj = (const bf16_t*)(P.ws + OFF_PROJ);
  bf16_t* Y = (bf16_t*)(P.ws + OFF_Y);
  float lbv[8], og[8];
#pragma unroll
  for (int i = 0; i < 8; ++i) {
    const int k = h * 64 + c8 + i;
    if (layer == 0) lbv[i] = 0.f; else { const float l0 = P.in[4][k], l1 = P.in[4][256 + k]; lbv[i] = 1.0f / (1.0f + expf(l0 - l1)); }
    og[i] = P.in[5][layer * 256 + k];
  }
  f32x4 sacc[2] = {(f32x4){0.f, 0.f, 0.f, 0.f}, (f32x4){0.f, 0.f, 0.f, 0.f}};
  for (int i = tid; i < 2 * 64 * TS; i += 512) ST[i] = 0;
  const bf16_t* pbase = proj + (size_t)(b * SEQ) * PW + h * 64 + c8;
  u32x4 nq, nz, nv, ng;
  { const bf16_t* p = pbase + (size_t)r * PW; nq = *(const u32x4*)p; nz = *(const u32x4*)(p + 256); nv = *(const u32x4*)(p + 512); ng = *(const u32x4*)(p + 768); }
  __syncthreads();
  for (int c = 0; c < NCH; ++c) {
    const int t = c * 64 + r;
    float q[8], z[8], lf[8], kk[8];
    const u32x4 cv = nv, cgt = ng;
    unpack8(nq, q); unpack8(nz, z);
    if (c + 1 < NCH) { const bf16_t* p = pbase + (size_t)(t + 64) * PW; nq = *(const u32x4*)p; nz = *(const u32x4*)(p + 256); nv = *(const u32x4*)(p + 512); ng = *(const u32x4*)(p + 768); }
#pragma unroll
    for (int i = 0; i < 8; ++i) {
      const float e = __expf(-z[i]), inv = 1.0f / (1.0f + e);
      const float f = lbv[i] + (1.0f - lbv[i]) * inv;
      lf[i] = __logf(fmaxf(f, 1e-37f));
      kk[i] = (1.0f - lbv[i]) * e * inv;
    }
#pragma unroll
    for (int d = 8; d < 64; d <<= 1) {
#pragma unroll
      for (int i = 0; i < 8; ++i) { const float tv = __shfl_up(lf[i], d); if (lane >= d) lf[i] += tv; }
    }
    if (lane >= 56) {
#pragma unroll
      for (int i = 0; i < 8; ++i) WT[wid * 64 + c8 + i] = lf[i];
    }
    __syncthreads();
#pragma unroll
    for (int i = 0; i < 8; ++i) {
      float pre = 0.f;
      for (int w = 0; w < wid; ++w) pre += WT[w * 64 + c8 + i];
      lf[i] += pre;
      B32[r * 64 + c8 + i] = lf[i];
    }
    __syncthreads();
    {
      const int I = r >> 4;
      float tq[8], tb[8], vv[8];
      unpack8(cv, vv);
#pragma unroll
      for (int i = 0; i < 8; ++i) { tb[i] = q[i] * __expf(lf[i]); tq[i] = q[i] * __expf(lf[i] - B32[(I * 16) * 64 + c8 + i]); }
      *(u32x4*)(QB + r * TS + c8) = pack8(tb);
      *(u32x4*)(QT + r * TS + c8) = pack8(tq);
      for (int I2 = I; I2 < 4; ++I2) {
        float tk[8];
#pragma unroll
        for (int i = 0; i < 8; ++i) tk[i] = kk[i] * __expf(fminf(B32[(I2 * 16) * 64 + c8 + i] - lf[i], 80.f));
        *(u32x4*)(KT + I2 * 64 * TS + r * TS + c8) = pack8(tk);
      }
#pragma unroll
      for (int i = 0; i < 8; ++i) {
        KET[(c8 + i) * TS + r] = f2bf(kk[i] * __expf(B32[63 * 64 + c8 + i] - lf[i]));
        VT[(c8 + i) * TS + r] = f2bf(vv[i]);
      }
    }
    __syncthreads();
#pragma unroll
    for (int x = 0; x < 2; ++x) {
      const int tl = wid + 8 * x, I = tl >> 2, J = tl & 3;
      f32x4 a = (f32x4){0.f, 0.f, 0.f, 0.f};
      if (J <= I) a = mma64(QT + I * 16 * TS, TS, KT + I * 64 * TS + J * 16 * TS, TS, a, fr, fq);
#pragma unroll
      for (int jj = 0; jj < 4; ++jj) {
        float v = a[jj];
        if (J > I || (J == I && (fq * 4 + jj) < fr)) v = 0.f;
        SC[(I * 16 + fq * 4 + jj) * TS + J * 16 + fr] = f2bf(v);
      }
    }
    __syncthreads();
    const bf16_t* STc = ST + (c & 1) * 64 * TS;
    bf16_t* STn = ST + ((c + 1) & 1) * 64 * TS;
#pragma unroll
    for (int x = 0; x < 2; ++x) {
      const int tb_ = wid >> 1, vb = (wid & 1) * 2 + x;
      f32x4 a = (f32x4){0.f, 0.f, 0.f, 0.f};
      a = mma64(SC + tb_ * 16 * TS, TS, VT + vb * 16 * TS, TS, a, fr, fq);
      a = mma64(QB + tb_ * 16 * TS, TS, STc + vb * 16 * TS, TS, a, fr, fq);
#pragma unroll
      for (int jj = 0; jj < 4; ++jj) O32[(tb_ * 16 + fq * 4 + jj) * 65 + vb * 16 + fr] = a[jj];
      const int kb = (wid & 1) * 2 + x;
      const float dec = __expf(B32[63 * 64 + kb * 16 + fr]);
      f32x4 s = sacc[x];
#pragma unroll
      for (int jj = 0; jj < 4; ++jj) s[jj] *= dec;
      s = mma64(VT + (wid >> 1) * 16 * TS, TS, KET + kb * 16 * TS, TS, s, fr, fq);
      sacc[x] = s;
#pragma unroll
      for (int jj = 0; jj < 4; ++jj) STn[((wid >> 1) * 16 + fq * 4 + jj) * TS + kb * 16 + fr] = f2bf(s[jj]);
    }
    __syncthreads();
    {
      float o[8], gg[8]; float ss = 0.f;
      unpack8(cgt, gg);
#pragma unroll
      for (int i = 0; i < 8; ++i) { o[i] = O32[r * 65 + c8 + i]; ss += o[i] * o[i]; }
      ss += __shfl_xor(ss, 1); ss += __shfl_xor(ss, 2); ss += __shfl_xor(ss, 4);
      const float rs = rsqrtf(ss * (1.0f / 64.0f) + EPSF);
#pragma unroll
      for (int i = 0; i < 8; ++i) o[i] = o[i] * rs * og[i] * siluf_(gg[i]);
      *(u32x4*)(Y + (size_t)(b * SEQ + t) * 1024 + h * 64 + c8) = pack8(o);
    }
  }
  __syncthreads();
}

__device__ void ssd_seq(const Params& P, int layer, int item, unsigned char* smem) {
  int tid_ = threadIdx.x; asm volatile("" : "+v"(tid_));
  const int tid = tid_, wid = tid >> 6, lane = tid & 63, fr = lane & 15, fq = lane >> 4;
  const int b = item >> 1, grp = item & 1, r = tid >> 3, cg_ = tid & 7, c8 = cg_ * 8;
  constexpr int RS = 264;
  bf16_t* RAW = (bf16_t*)smem;
  float* O32 = (float*)smem;
  float* CW = (float*)(smem + 35840);
  float* ACUM = (float*)(smem + 35840 + 5120);
  float* DTV = ACUM + 128;
  bf16_t* XS = (bf16_t*)(smem + 35840 + 5120 + 1024);
  bf16_t* CM = XS + 64 * 136;
  bf16_t* BM = CM + 64 * TS;
  bf16_t* BMT = BM + 64 * TS;
  bf16_t* CS = BMT + 64 * TS;
  bf16_t* XDTT = CS + 64 * TS;
  bf16_t* XDECT = XDTT + 64 * TS;
  bf16_t* MS = XDECT + 64 * TS;
  bf16_t* STATE = MS + 64 * TS;
  const bf16_t* proj = (const bf16_t*)(P.ws + OFF_PROJ);
  const float* dtb = (const float*)(P.ws + OFF_SMALL + S_DT);
  bf16_t* Y = (bf16_t*)(P.ws + OFF_Y);
  const int h0 = grp * 2;
  if (tid < 256) {
    const int lc = tid; const int ch = lc < 128 ? grp * 128 + lc : (lc < 192 ? 256 + grp * 64 + (lc - 128) : 384 + grp * 64 + (lc - 192));
    const float* w = P.in[6] + ((size_t)layer * 512 + ch) * 4;
    CW[lc * 5 + 0] = w[0]; CW[lc * 5 + 1] = w[1]; CW[lc * 5 + 2] = w[2]; CW[lc * 5 + 3] = w[3]; CW[lc * 5 + 4] = P.in[7][layer * 512 + ch];
  }
  for (int i = tid; i < 2 * 64 * TS; i += 512) STATE[i] = 0;
  const float dtbias0 = P.in[8][layer * 4 + h0], dtbias1 = P.in[8][layer * 4 + h0 + 1];
  const float aneg0 = -expf(P.in[9][layer * 4 + h0]), aneg1 = -expf(P.in[9][layer * 4 + h0 + 1]);
  const float dsk0 = P.in[10][layer * 4 + h0], dsk1 = P.in[10][layer * 4 + h0 + 1];
  f32x4 sacc[2][2];
#pragma unroll
  for (int a = 0; a < 2; ++a)
#pragma unroll
    for (int x = 0; x < 2; ++x) sacc[a][x] = (f32x4){0.f, 0.f, 0.f, 0.f};
  __syncthreads();
  for (int c = 0; c < NCH; ++c) {
    const int t0 = b * SEQ + c * 64;
    for (int idx = tid; idx < 67 * 32; idx += 512) {
      const int rr = idx >> 5, pc = idx & 31;
      const int col = pc < 16 ? 1280 + grp * 128 + pc * 8 : (pc < 24 ? 1536 + grp * 64 + (pc - 16) * 8 : 1664 + grp * 64 + (pc - 24) * 8);
      u32x4 v = (u32x4){0u, 0u, 0u, 0u};
      if (c > 0 || rr >= 3) v = *(const u32x4*)(proj + (size_t)(t0 - 3 + rr) * PW + col);
      *(u32x4*)(RAW + rr * RS + pc * 8) = v;
    }
    if (wid == 0) {
      const f32x4 d4 = *(const f32x4*)(dtb + (size_t)(t0 + lane) * 4);
      float x0 = d4[h0] + dtbias0, x1 = d4[h0 + 1] + dtbias1;
      float dt0 = x0 > 20.f ? x0 : log1pf(__expf(x0)), dt1 = x1 > 20.f ? x1 : log1pf(__expf(x1));
      float a0 = dt0 * aneg0, a1 = dt1 * aneg1;
#pragma unroll
      for (int d = 1; d < 64; d <<= 1) { const float u0 = __shfl_up(a0, d), u1 = __shfl_up(a1, d); if (lane >= d) { a0 += u0; a1 += u1; } }
      ACUM[lane] = a0; ACUM[64 + lane] = a1; DTV[lane] = dt0; DTV[64 + lane] = dt1;
    }
    __syncthreads();
#pragma unroll
    for (int q4 = 0; q4 < 4; ++q4) {
      const int lc0 = cg_ * 32 + q4 * 8;
      float accv[8];
#pragma unroll
      for (int i = 0; i < 8; ++i) accv[i] = CW[(lc0 + i) * 5 + 4];
#pragma unroll
      for (int tap = 0; tap < 4; ++tap) {
        float xv[8]; unpack8(*(const u32x4*)(RAW + (r + tap) * RS + lc0), xv);
#pragma unroll
        for (int i = 0; i < 8; ++i) accv[i] += xv[i] * CW[(lc0 + i) * 5 + tap];
      }
#pragma unroll
      for (int i = 0; i < 8; ++i) accv[i] = siluf_(accv[i]);
      if (cg_ < 4) { *(u32x4*)(XS + r * 136 + lc0) = pack8(accv); }
      else if (cg_ < 6) { const int n0 = lc0 - 128; *(u32x4*)(BM + r * TS + n0) = pack8(accv);
#pragma unroll
        for (int i = 0; i < 8; ++i) BMT[(n0 + i) * TS + r] = f2bf(accv[i]); }
      else { const int n0 = lc0 - 192; *(u32x4*)(CM + r * TS + n0) = pack8(accv); }
    }
    __syncthreads();
    f32x4 gt[2];
#pragma unroll
    for (int x = 0; x < 2; ++x) {
      const int tl = wid + 8 * x, lb = tl >> 2, sb = tl & 3;
      gt[x] = (f32x4){0.f, 0.f, 0.f, 0.f};
      if (sb <= lb) gt[x] = mma64(CM + lb * 16 * TS, TS, BM + sb * 16 * TS, TS, gt[x], fr, fq);
    }
#pragma unroll
    for (int hh = 0; hh < 2; ++hh) {
      const float* ac = ACUM + hh * 64;
      {
        float xs[8], cm[8], cs[8]; unpack8(*(const u32x4*)(XS + r * 136 + hh * 64 + c8), xs); unpack8(*(const u32x4*)(CM + r * TS + c8), cm);
        const float dtv = DTV[hh * 64 + r], dec = __expf(ac[63] - ac[r]), ea = __expf(ac[r]);
#pragma unroll
        for (int i = 0; i < 8; ++i) { const float xd = xs[i] * dtv; XDTT[(c8 + i) * TS + r] = f2bf(xd); XDECT[(c8 + i) * TS + r] = f2bf(xd * dec); cs[i] = cm[i] * ea; }
        *(u32x4*)(CS + r * TS + c8) = pack8(cs);
      }
#pragma unroll
      for (int x = 0; x < 2; ++x) {
        const int tl = wid + 8 * x, lb = tl >> 2, sb = tl & 3;
#pragma unroll
        for (int jj = 0; jj < 4; ++jj) {
          const int l = lb * 16 + fq * 4 + jj, s = sb * 16 + fr;
          float v = 0.f;
          if (l >= s) v = gt[x][jj] * __expf(ac[l] - ac[s]);
          MS[l * TS + s] = f2bf(v);
        }
      }
      __syncthreads();
      const bf16_t* STh = STATE + hh * 64 * TS;
      f32x4 snew[2];
#pragma unroll
      for (int x = 0; x < 2; ++x) {
        const int lb = wid >> 1, pb = (wid & 1) * 2 + x;
        f32x4 a = (f32x4){0.f, 0.f, 0.f, 0.f};
        a = mma64(MS + lb * 16 * TS, TS, XDTT + pb * 16 * TS, TS, a, fr, fq);
        a = mma64(CS + lb * 16 * TS, TS, STh + pb * 16 * TS, TS, a, fr, fq);
#pragma unroll
        for (int jj = 0; jj < 4; ++jj) O32[(lb * 16 + fq * 4 + jj) * 129 + hh * 64 + pb * 16 + fr] = a[jj];
        const int nb = (wid & 1) * 2 + x;
        const float dchunk = __expf(ac[63]);
        f32x4 s = sacc[hh][x];
#pragma unroll
        for (int jj = 0; jj < 4; ++jj) s[jj] *= dchunk;
        s = mma64(XDECT + (wid >> 1) * 16 * TS, TS, BMT + nb * 16 * TS, TS, s, fr, fq);
        sacc[hh][x] = s; snew[x] = s;
      }
      __syncthreads();
#pragma unroll
      for (int x = 0; x < 2; ++x) {
        const int nb = (wid & 1) * 2 + x;
#pragma unroll
        for (int jj = 0; jj < 4; ++jj) STATE[hh * 64 * TS + ((wid >> 1) * 16 + fq * 4 + jj) * TS + nb * 16 + fr] = f2bf(snew[x][jj]);
      }
    }
    __syncthreads();
    {
      const int ch0 = cg_ * 16; const float dsk = ch0 < 64 ? dsk0 : dsk1;
      const int t = t0 + r;
      float zz[16], xs[16], y[16];
      unpack8(*(const u32x4*)(proj + (size_t)t * PW + 1024 + grp * 128 + ch0), zz); unpack8(*(const u32x4*)(proj + (size_t)t * PW + 1024 + grp * 128 + ch0 + 8), zz + 8);
      unpack8(*(const u32x4*)(XS + r * 136 + ch0), xs); unpack8(*(const u32x4*)(XS + r * 136 + ch0 + 8), xs + 8);
      float ss = 0.f;
#pragma unroll
      for (int i = 0; i < 16; ++i) { y[i] = (O32[r * 129 + ch0 + i] + dsk * xs[i]) * siluf_(zz[i]); ss += y[i] * y[i]; }
      ss += __shfl_xor(ss, 1); ss += __shfl_xor(ss, 2); ss += __shfl_xor(ss, 4);
      const float rs = rsqrtf(ss * (1.0f / 128.0f) + EPSF);
      const float* ng = P.in[11] + layer * 256 + grp * 128 + ch0;
#pragma unroll
      for (int i = 0; i < 16; ++i) y[i] = y[i] * rs * ng[i];
      bf16_t* dst = Y + (size_t)t * 1024 + 256 + grp * 128 + ch0;
      *(u32x4*)dst = pack8(y); *(u32x4*)(dst + 8) = pack8(y + 8);
    }
    __syncthreads();
  }
}

__device__ void attn_item(const Params& P, int layer, int item, unsigned char* smem) {
  int tid_ = threadIdx.x; asm volatile("" : "+v"(tid_));
  const int tid = tid_, wid = tid >> 6, lane = tid & 63, fr = lane & 15, fq = lane >> 4;
  const int cp = item & 15, h = (item >> 4) & 3, b = item >> 6;
  const int wq = wid >> 2, qb = wid & 3, r = tid >> 3, c8 = (tid & 7) * 8;
  bf16_t* KH = (bf16_t*)smem;
  bf16_t* VTT = KH + 2 * 64 * TS;
  float* BIAS = (float*)(smem + 4 * 64 * TS * 2);
  const bf16_t* proj = (const bf16_t*)(P.ws + OFF_PROJ);
  bf16_t* Y = (bf16_t*)(P.ws + OFF_Y);
  __syncthreads();
  if (tid < 257) BIAS[tid] = P.in[23][((size_t)layer * 4 + h) * 257 + tid];
  const int c0 = cp * 2, cme = c0 + wq;
  const size_t tb = (size_t)b * SEQ;
  bf16x8 qf[2];
  {
    const bf16_t* qp = proj + (tb + cme * 64 + qb * 16 + fr) * PW + 1792 + h * 64;
    float a[8], c[8]; unpack8(*(const u32x4*)(qp + fq * 8), a); unpack8(*(const u32x4*)(qp + 32 + fq * 8), c);
    float ss = 0.f;
#pragma unroll
    for (int i = 0; i < 8; ++i) ss += a[i] * a[i] + c[i] * c[i];
    ss += __shfl_xor(ss, 16); ss += __shfl_xor(ss, 32);
    const float rs = rsqrtf(ss * (1.0f / 64.0f) + EPSF) * 0.125f;
    const float* qg = P.in[21] + layer * 64;
#pragma unroll
    for (int i = 0; i < 8; ++i) { a[i] *= rs * qg[fq * 8 + i]; c[i] *= rs * qg[32 + fq * 8 + i]; }
    u32x4 wa = pack8(a), wc_ = pack8(c);
    qf[0] = *(bf16x8*)&wa; qf[1] = *(bf16x8*)&wc_;
  }
  float kgn[8];
#pragma unroll
  for (int i = 0; i < 8; ++i) kgn[i] = P.in[22][layer * 64 + c8 + i];
  f32x4 oacc[4];
#pragma unroll
  for (int d = 0; d < 4; ++d) oacc[d] = (f32x4){0.f, 0.f, 0.f, 0.f};
  float mrun = -1e30f, lrun = 0.f;
  const int cs = c0 - 8 > 0 ? c0 - 8 : 0, ce = c0 + 1;
  u32x4 nk, nv;
  { const bf16_t* kp = proj + (tb + cs * 64 + r) * PW + 2048 + h * 64 + c8; nk = *(const u32x4*)kp; nv = *(const u32x4*)(kp + 256); }
  for (int cc = cs; cc <= ce; ++cc) {
    const int buf = (cc - cs) & 1;
    {
      float kv[8], vv[8]; unpack8(nk, kv); unpack8(nv, vv);
      if (cc < ce) { const bf16_t* kp = proj + (tb + (cc + 1) * 64 + r) * PW + 2048 + h * 64 + c8; nk = *(const u32x4*)kp; nv = *(const u32x4*)(kp + 256); }
      float ss = 0.f;
#pragma unroll
      for (int i = 0; i < 8; ++i) ss += kv[i] * kv[i];
      ss += __shfl_xor(ss, 1); ss += __shfl_xor(ss, 2); ss += __shfl_xor(ss, 4);
      const float rs = rsqrtf(ss * (1.0f / 64.0f) + EPSF);
#pragma unroll
      for (int i = 0; i < 8; ++i) kv[i] *= rs * kgn[i];
      *(u32x4*)(KH + buf * 64 * TS + r * TS + c8) = pack8(kv);
#pragma unroll
      for (int i = 0; i < 8; ++i) VTT[buf * 64 * TS + (c8 + i) * TS + r] = f2bf(vv[i]);
    }
    __syncthreads();
    const int j = cc - (cme - 8);
    if (j >= 0 && j <= 8) {
      const bf16_t* Kb = KH + buf * 64 * TS; const bf16_t* Vb = VTT + buf * 64 * TS;
      f32x4 s[4];
#pragma unroll
      for (int kt = 0; kt < 4; ++kt) {
        s[kt] = (f32x4){0.f, 0.f, 0.f, 0.f};
#pragma unroll
        for (int ks = 0; ks < 2; ++ks) { const bf16x8 a = *(const bf16x8*)(Kb + (kt * 16 + fr) * TS + ks * 32 + fq * 8); s[kt] = mfma16(a, qf[ks], s[kt]); }
      }
      const int qpos = qb * 16 + fr;
      float mx = -1e30f;
#pragma unroll
      for (int kt = 0; kt < 4; ++kt)
#pragma unroll
        for (int jj = 0; jj < 4; ++jj) {
          const int kpos = j * 64 + kt * 16 + fq * 4 + jj;
          int rel = qpos + 512 - kpos; rel = rel > 128 ? 128 : (rel < -128 ? -128 : rel);
          const float v = s[kt][jj] + BIAS[rel + 128];
          s[kt][jj] = v; mx = fmaxf(mx, v);
        }
      mx = fmaxf(mx, __shfl_xor(mx, 16)); mx = fmaxf(mx, __shfl_xor(mx, 32));
      const float mnew = fmaxf(mrun, mx), alpha = __expf(mrun - mnew);
      mrun = mnew;
      float ps = 0.f;
#pragma unroll
      for (int kt = 0; kt < 4; ++kt)
#pragma unroll
        for (int jj = 0; jj < 4; ++jj) { const float p = __expf(s[kt][jj] - mnew); s[kt][jj] = p; ps += p; }
      lrun = lrun * alpha + ps;
      bf16x8 pb[2];
#pragma unroll
      for (int k2 = 0; k2 < 2; ++k2) {
        u32x4 w; w[0] = pk2(s[2 * k2][0], s[2 * k2][1]); w[1] = pk2(s[2 * k2][2], s[2 * k2][3]); w[2] = pk2(s[2 * k2 + 1][0], s[2 * k2 + 1][1]); w[3] = pk2(s[2 * k2 + 1][2], s[2 * k2 + 1][3]);
        pb[k2] = *(bf16x8*)&w;
      }
#pragma unroll
      for (int d = 0; d < 4; ++d) {
#pragma unroll
        for (int e = 0; e < 4; ++e) oacc[d][e] *= alpha;
#pragma unroll
        for (int k2 = 0; k2 < 2; ++k2) {
          const bf16_t* vp = Vb + (d * 16 + fr) * TS + k2 * 32 + fq * 4;
          const u32x2 lo = *(const u32x2*)vp, hi = *(const u32x2*)(vp + 16);
          u32x4 w; w[0] = lo[0]; w[1] = lo[1]; w[2] = hi[0]; w[3] = hi[1];
          oacc[d] = mfma16(*(bf16x8*)&w, pb[k2], oacc[d]);
        }
      }
    }
  }
  lrun += __shfl_xor(lrun, 16); lrun += __shfl_xor(lrun, 32);
  const float il = 1.0f / lrun;
  bf16_t* yp = Y + (tb + cme * 64 + qb * 16 + fr) * 1024 + 768 + h * 64;
#pragma unroll
  for (int d = 0; d < 4; ++d) {
    u32x2 w; w[0] = pk2(oacc[d][0] * il, oacc[d][1] * il); w[1] = pk2(oacc[d][2] * il, oacc[d][3] * il);
    *(u32x2*)(yp + d * 16 + fq * 4) = w;
  }
}

__device__ void toep_build(const Params& P, int layer, int item) {
  item = lsg(item); layer = lsg(layer);
  const int g = item >> 4, nb = item & 15;
  const float* KTb = (const float*)(P.ws + OFF_SMALL + S_KT) + (size_t)(layer * 16 + g) * 64 * 256;
  const float* lam = (const float*)(P.ws + OFF_SMALL + S_LAM) + (size_t)(layer * 16 + g) * 64 * 65 * 2;
  const float* Cre = P.in[16] + (size_t)(layer * 16 + g) * 16 * 64;
  const float* Cim = P.in[17] + (size_t)(layer * 16 + g) * 16 * 64;
  bf16_t* dst = (bf16_t*)(P.ws + OFF_TOEP) + (size_t)g * 1024 * UK;
  for (int idx = ltid(); idx < 64 * (UK / 2); idx += 512) {
    const int n = nb * 64 + idx / (UK / 2), k0 = (idx % (UK / 2)) * 2;
    const int t = n >> 4, i = n & 15;
    float v[2];
#pragma unroll
    for (int e = 0; e < 2; ++e) {
      const int k = k0 + e;
      if (k < 1024) { const int s = k >> 4, i2 = k & 15; v[e] = t >= s ? KTb[((t - s) * 16 + i) * 16 + i2] : 0.f; }
      else { const int kk = k - 1024, p = kk & 63; const float lr = lam[(p * 65 + t + 1) * 2], li = lam[(p * 65 + t + 1) * 2 + 1];
        const float cr = Cre[i * 64 + p], ci = Cim[i * 64 + p];
        v[e] = kk < 64 ? (cr * lr - ci * li) : -(cr * li + ci * lr); }
    }
    *(unsigned*)(dst + (size_t)n * UK + k0) = pk2(v[0], v[1]);
  }
}

__device__ void wprep_tile(const float* src, int ld, int K, bf16_t* dst, const float* scale, int n0, int k0, int srccol, int nvalid, float* tile) {
  const int tid = ltid();
  __syncthreads();
#pragma unroll
  for (int i = 0; i < 8; ++i) {
    const int idx = tid + 512 * i, kk = idx >> 6, nn = idx & 63;
    float v = 0.f;
    if (nn < nvalid) { v = src[(size_t)(k0 + kk) * ld + srccol + nn]; if (scale) v *= scale[k0 + kk]; }
    tile[kk * 65 + nn] = v;
  }
  __syncthreads();
#pragma unroll
  for (int i = 0; i < 4; ++i) {
    const int idx = tid + 512 * i, nn = idx >> 5, kp = (idx & 31) * 2;
    *(unsigned*)(dst + (size_t)(n0 + nn) * K + k0 + kp) = pk2(tile[kp * 65 + nn], tile[(kp + 1) * 65 + nn]);
  }
}
__device__ void prep_layer(const Params& P, int layer, unsigned char* smem) {
  layer = lsg(layer);
  float* tile = (float*)smem;
  unsigned char* W = P.ws + OFF_W;
  for (int tl = lbid(); tl < 4688; tl += gridDim.x) {
    int x = tl;
    if (x < 1792) {
      const int nt64 = x >> 4, kt = x & 15, pn = nt64 >> 2, sub = nt64 & 3;
      int sc, nv = 64;
      if (pn < 4) sc = pn * 256 + sub * 64; else if (pn == 4) sc = 1024 + sub * 64; else if (pn < 7) sc = 1280 + (pn - 5) * 256 + sub * 64;
      else if (pn == 7) sc = 1796 + sub * 64; else if (pn < 11) sc = 2052 + (pn - 8) * 256 + sub * 64;
      else if (pn == 11) { sc = 1792; nv = sub == 0 ? 4 : 0; } else sc = 2820 + (pn - 12) * 256 + sub * 64;
      wprep_tile(P.in[3] + (size_t)layer * 1024 * 6916, 6916, 1024, (bf16_t*)(W + W_IN), P.in[2] + layer * 1024, nt64 * 64, kt * 64, sc, nv, tile);
      continue;
    }
    x -= 1792;
    if (x < 256) { const int m = x >> 6, y = x & 63, nt = y >> 2, kt = y & 3;
      wprep_tile(P.in[24] + ((size_t)layer * 4 + m) * 256 * 1024, 1024, 256, (bf16_t*)(W + W_BR) + (size_t)m * 1024 * 256, nullptr, nt * 64, kt * 64, nt * 64, 64, tile); continue; }
    x -= 256;
    if (x < 256) { const int nt = x >> 4, kt = x & 15;
      wprep_tile(P.in[25] + (size_t)layer * 1024 * 1024, 1024, 1024, (bf16_t*)(W + W_OUT), nullptr, nt * 64, kt * 64, nt * 64, 64, tile); continue; }
    x -= 256;
    if (x < 1024) { const int nt = x >> 4, kt = x & 15;
      wprep_tile(P.in[27] + (size_t)layer * 1024 * 4096, 4096, 1024, (bf16_t*)(W + W_FF1), P.in[26] + layer * 1024, nt * 64, kt * 64, nt * 64, 64, tile); continue; }
    x -= 1024;
    if (x < 1024) { const int nt = x >> 6, kt = x & 63;
      wprep_tile(P.in[28] + (size_t)layer * 4096 * 1024, 1024, 4096, (bf16_t*)(W + W_FF2), nullptr, nt * 64, kt * 64, nt * 64, 64, tile); continue; }
    x -= 1024;
    if (x < 64) { const int nt = x >> 2, kt = x & 3;
      wprep_tile(P.in[29] + (size_t)layer * 256 * 1024, 1024, 256, (bf16_t*)(W + W_PLE), nullptr, nt * 64, kt * 64, nt * 64, 64, tile); continue; }
    x -= 64;
    if (x < 256) { const int nt = x >> 4, kt = x & 15;
      wprep_tile(P.in[31] + (size_t)layer * 1024 * 1024, 1024, 1024, (bf16_t*)(W + W_PG + (size_t)layer * 2 * MiB), P.in[30] + layer * 1024, nt * 64, kt * 64, nt * 64, 64, tile); continue; }
    x -= 256;
    { const int nt = x >> 2, kt = x & 3;
      wprep_tile(P.in[20] + (size_t)layer * 256 * 256, 256, 256, (bf16_t*)(W + W_GLU), nullptr, nt * 64, kt * 64, nt * 64, 64, tile); }
  }
  const float* lamL = (const float*)(P.ws + OFF_SMALL + S_LAM) + (size_t)layer * 16 * 64 * 65 * 2;
  const float* bbL = (const float*)(P.ws + OFF_SMALL + S_BB) + (size_t)layer * 16 * 64 * 16 * 2;
  bf16_t* mint = (bf16_t*)(P.ws + OFF_MINT);
  for (size_t idx = (size_t)lbid() * 512 + ltid(); idx < (size_t)16 * 256 * 512; idx += (size_t)gridDim.x * 512) {
    const int k0 = (int)(idx & 511) * 2, n = (int)(idx >> 9) & 255, g = (int)(idx >> 17);
    float v[2] = {0.f, 0.f};
    if (n < 128) {
      const int p = n & 63;
#pragma unroll
      for (int e = 0; e < 2; ++e) {
        const int k = k0 + e, s = k >> 4, i2 = k & 15;
        const float lr = lamL[((size_t)(g * 64 + p) * 65 + (63 - s)) * 2], li = lamL[((size_t)(g * 64 + p) * 65 + (63 - s)) * 2 + 1];
        const float br = bbL[((size_t)(g * 64 + p) * 16 + i2) * 2], bi = bbL[((size_t)(g * 64 + p) * 16 + i2) * 2 + 1];
        v[e] = n < 64 ? (lr * br - li * bi) : (lr * bi + li * br);
      }
    }
    *(unsigned*)(mint + ((size_t)(g * 256 + n) * 1024 + k0)) = pk2(v[0], v[1]);
  }
}

__device__ void merge_phase(const Params& P, unsigned char* smem) {
  int tid_ = threadIdx.x; asm volatile("" : "+v"(tid_));
  const int tid = tid_, wid = tid >> 6, lane = tid & 63, fr = lane & 15, fq = lane >> 4, wr = wid >> 2, wc = wid & 3;
  constexpr int LS = 136, BUFE = 2 * 128 * LS;
  bf16_t* L0 = (bf16_t*)smem;
  const bf16_t* Y = (const bf16_t*)(P.ws + OFF_Y);
  const bf16_t* Wb = (const bf16_t*)(P.ws + OFF_W + W_BR);
  const unsigned char* gates = P.ws + OFF_GATES;
  bf16_t* merged = (bf16_t*)(P.ws + OFF_MERGED);
  const int cid = lbid(), G = gridDim.x;
  const int ntile = (2048 - cid + G - 1) / G, total = ntile * 8;
  u32x4 pa[4], pb[4];
  unsigned gw[4][2];
  f32x4 mg[4][2], acc[4][2];
#pragma unroll
  for (int a = 0; a < 4; ++a)
#pragma unroll
    for (int n = 0; n < 2; ++n) { mg[a][n] = (f32x4){0.f, 0.f, 0.f, 0.f}; acc[a][n] = (f32x4){0.f, 0.f, 0.f, 0.f}; }
#define MG_LOAD(g_) do { const int tile_ = cid + ((g_) >> 3) * G, s_ = (g_) & 7, m_ = s_ >> 1, kh_ = s_ & 1, r0_ = (tile_ >> 3) * 128, c0_ = (tile_ & 7) * 128; \
    _Pragma("unroll") for (int i = 0; i < 4; ++i) { const int idx = tid + 512 * i, rr = idx >> 4, pc = idx & 15; \
      pa[i] = *(const u32x4*)(Y + (size_t)(r0_ + rr) * 1024 + m_ * 256 + kh_ * 128 + pc * 8); \
      pb[i] = *(const u32x4*)(Wb + ((size_t)m_ * 1024 + c0_ + rr) * 256 + kh_ * 128 + pc * 8); } } while (0)
#define MG_STORE(buf_) do { bf16_t* A_ = L0 + (buf_) * BUFE; bf16_t* B_ = A_ + 128 * LS; \
    _Pragma("unroll") for (int i = 0; i < 4; ++i) { const int idx = tid + 512 * i, rr = idx >> 4, pc = idx & 15; \
      *(u32x4*)(A_ + rr * LS + pc * 8) = pa[i]; *(u32x4*)(B_ + rr * LS + pc * 8) = pb[i]; } } while (0)
  if (total > 0) { MG_LOAD(0); MG_STORE(0); }
  __syncthreads();
  for (int g = 0; g < total; ++g) {
    const int tile = cid + (g >> 3) * G, s = g & 7, m = s >> 1, kh = s & 1, row0 = (tile >> 3) * 128, col0 = (tile & 7) * 128;
    if (g + 1 < total) MG_LOAD(g + 1);
    if (kh == 0) {
#pragma unroll
      for (int a = 0; a < 4; ++a)
#pragma unroll
        for (int n = 0; n < 2; ++n)
          gw[a][n] = *(const unsigned*)(gates + (size_t)(row0 + wr * 64 + a * 16 + fr) * 4096 + m * 1024 + col0 + wc * 32 + n * 16 + fq * 4);
    }
    const bf16_t* As = L0 + (g & 1) * BUFE; const bf16_t* Bs = As + 128 * LS;
#pragma unroll
    for (int k = 0; k < 4; ++k) {
      bf16x8 af[4], bfr[2];
#pragma unroll
      for (int a = 0; a < 4; ++a) af[a] = *(const bf16x8*)(As + (wr * 64 + a * 16 + fr) * LS + k * 32 + fq * 8);
#pragma unroll
      for (int n = 0; n < 2; ++n) bfr[n] = *(const bf16x8*)(Bs + (wc * 32 + n * 16 + fr) * LS + k * 32 + fq * 8);
#pragma unroll
      for (int a = 0; a < 4; ++a)
#pragma unroll
        for (int n = 0; n < 2; ++n) acc[a][n] = mfma16(bfr[n], af[a], acc[a][n]);
    }
    if (kh == 1) {
#pragma unroll
      for (int a = 0; a < 4; ++a)
#pragma unroll
        for (int n = 0; n < 2; ++n) {
#pragma unroll
          for (int e = 0; e < 4; ++e) mg[a][n][e] += acc[a][n][e] * ((float)((gw[a][n] >> (8 * e)) & 255u) * (1.0f / 255.0f));
          acc[a][n] = (f32x4){0.f, 0.f, 0.f, 0.f};
        }
      if (s == 7) {
#pragma unroll
        for (int a = 0; a < 4; ++a) {
          const int row = row0 + wr * 64 + a * 16 + fr;
#pragma unroll
          for (int n = 0; n < 2; ++n) {
            u32x2 w; w[0] = pk2(mg[a][n][0], mg[a][n][1]); w[1] = pk2(mg[a][n][2], mg[a][n][3]);
            *(u32x2*)(merged + (size_t)row * 1024 + col0 + wc * 32 + n * 16 + fq * 4) = w;
            mg[a][n] = (f32x4){0.f, 0.f, 0.f, 0.f};
          }
        }
      }
    }
    if (g + 1 < total) MG_STORE((g + 1) & 1);
    __syncthreads();
  }
#undef MG_LOAD
#undef MG_STORE
}

__device__ void prep_global_a(const Params& P) {
  const int tid = ltid(), wid = tid >> 6, lane = tid & 63;
  float* rowsq = (float*)(P.ws + OFF_SMALL + S_ROWSQ);
  bf16_t* xb = (bf16_t*)(P.ws + OFF_XB);
  const float* x = P.in[0];
  for (int row = lbid() * 8 + wid; row < T_TOK; row += gridDim.x * 8) {
    float ss = 0.f;
#pragma unroll
    for (int i = 0; i < 2; ++i) {
      const size_t o = (size_t)row * 1024 + i * 512 + lane * 8;
      const f32x4 a = *(const f32x4*)(x + o), c = *(const f32x4*)(x + o + 4);
      u32x4 w; w[0] = pk2(a[0], a[1]); w[1] = pk2(a[2], a[3]); w[2] = pk2(c[0], c[1]); w[3] = pk2(c[2], c[3]);
      *(u32x4*)(xb + o) = w;
#pragma unroll
      for (int e = 0; e < 4; ++e) ss += a[e] * a[e] + c[e] * c[e];
    }
#pragma unroll
    for (int d = 1; d < 64; d <<= 1) ss += __shfl_xor(ss, d);
    if (lane == 0) rowsq[row] = ss;
  }
  const size_t gt = (size_t)lbid() * 512 + tid, gn = (size_t)gridDim.x * 512;
  for (size_t i = gt; i < (size_t)6 * T_TOK; i += gn) rowsq[T_TOK + i] = 0.f;
  int* ctr = (int*)(P.ws + OFF_SMALL + S_CTR);
  if (lbid() == 0 && tid < 64) ctr[tid] = 0;
  float* lam = (float*)(P.ws + OFF_SMALL + S_LAM);
  float* bb = (float*)(P.ws + OFF_SMALL + S_BB);
  for (size_t i = gt; i < (size_t)2 * 16 * 64 * 65; i += gn) {
    const int tau = (int)(i % 65), gp = (int)(i / 65), L = gp >> 10, g = (gp >> 6) & 15;
    const double are = (double)P.in[12][gp], aim = (double)P.in[13][gp], step = exp((double)P.in[19][L * 16 + g]);
    const double mag = exp(are * step * (double)tau), ang = aim * step * (double)tau;
    lam[i * 2] = (float)(mag * cos(ang)); lam[i * 2 + 1] = (float)(mag * sin(ang));
  }
  for (size_t i = gt; i < (size_t)2 * 16 * 64 * 16; i += gn) {
    const int gp = (int)(i >> 4), L = gp >> 10, g = (gp >> 6) & 15;
    const double are = (double)P.in[12][gp], aim = (double)P.in[13][gp], step = exp((double)P.in[19][L * 16 + g]);
    const double mag = exp(are * step), lr = mag * cos(aim * step), li = mag * sin(aim * step);
    const double den = are * are + aim * aim, nr = lr - 1.0;
    const double cr = (nr * are + li * aim) / den, ci = (li * are - nr * aim) / den;
    const double br = (double)P.in[14][i], bi = (double)P.in[15][i];
    bb[i * 2] = (float)(cr * br - ci * bi); bb[i * 2 + 1] = (float)(cr * bi + ci * br);
  }
}
__device__ void prep_global_b(const Params& P) {
  const float* lam = (const float*)(P.ws + OFF_SMALL + S_LAM);
  const float* bb = (const float*)(P.ws + OFF_SMALL + S_BB);
  float* KT = (float*)(P.ws + OFF_SMALL + S_KT);
  for (size_t idx = (size_t)lbid() * 512 + ltid(); idx < (size_t)2 * 16 * 64 * 256; idx += (size_t)gridDim.x * 512) {
    const int i2 = (int)(idx & 15), i = (int)(idx >> 4) & 15, tau = (int)(idx >> 8) & 63, Lg = (int)(idx >> 14);
    const float* cre = P.in[16] + ((size_t)Lg * 16 + i) * 64; const float* cim = P.in[17] + ((size_t)Lg * 16 + i) * 64;
    float acc = 0.f;
    for (int p = 0; p < 64; ++p) {
      const float lr = lam[((size_t)(Lg * 64 + p) * 65 + tau) * 2], li = lam[((size_t)(Lg * 64 + p) * 65 + tau) * 2 + 1];
      const float br = bb[((size_t)(Lg * 64 + p) * 16 + i2) * 2], bi = bb[((size_t)(Lg * 64 + p) * 16 + i2) * 2 + 1];
      const float xr = lr * br - li * bi, xi = lr * bi + li * br;
      acc += cre[p] * xr - cim[p] * xi;
    }
    KT[idx] = acc;
  }
}
__device__ void convert_p(const Params& P, int layer) {
  layer = lsg(layer);
  const float* src = P.in[1] + (size_t)layer * T_TOK * 256;
  bf16_t* dst = (bf16_t*)(P.ws + OFF_PB);
  for (size_t i = ((size_t)lbid() * 512 + ltid()) * 8; i < (size_t)T_TOK * 256; i += (size_t)gridDim.x * 512 * 8) {
    const f32x4 a = *(const f32x4*)(src + i), c = *(const f32x4*)(src + i + 4);
    u32x4 w; w[0] = pk2(a[0], a[1]); w[1] = pk2(a[2], a[3]); w[2] = pk2(c[0], c[1]); w[3] = pk2(c[2], c[3]);
    *(u32x4*)(dst + i) = w;
  }
}


#define XB_TMO      128
#define XB_XCNT(j)  (256  + 64 * (j))
#define XB_XSUB(j)  (1280 + 64 * (j))
#define XB_XGEN(j)  (2304 + 64 * (j))
#define XB_TOP      3328
#define XB_TOPGEN   3392
#define XCD_BAR_WORDS 3456
#define XB_SPIN_CAP (1u << 18)
DEVI unsigned xb_ld(unsigned* p) { return __hip_atomic_load(p, __ATOMIC_RELAXED, __HIP_MEMORY_SCOPE_AGENT); }
DEVI unsigned xb_add(unsigned* p, unsigned v) { return __hip_atomic_fetch_add(p, v, __ATOMIC_RELAXED, __HIP_MEMORY_SCOPE_AGENT); }
DEVI unsigned xb_xcc_id() { return (unsigned)__builtin_amdgcn_s_getreg((3 << 11) | 20) & 0xFu; }
#define XB_SPIN(cond, bar) do { unsigned _sp = 0; while (cond) { __builtin_amdgcn_s_sleep(1); \
    if ((++_sp & 255u) == 0u) { if (xb_ld(&(bar)[XB_TMO])) break; if (_sp > XB_SPIN_CAP) { atomicAdd(&(bar)[XB_TMO], 1u); break; } } } } while (0)
struct XcdBarrier { unsigned* bar; unsigned x; volatile LAS unsigned* st; };
DEVI XcdBarrier xcd_barrier_post(unsigned* bar, volatile LAS unsigned* st) {
  XcdBarrier b; b.bar = bar; b.x = xb_xcc_id(); b.st = st;
  if (threadIdx.x == 0) (void)xb_add(&bar[XB_XCNT(b.x)], 1u);
  return b;
}
DEVI void xcd_barrier_complete(unsigned* bar, unsigned x, unsigned& nloc, unsigned& nx) {
  const unsigned G = gridDim.x * gridDim.y * gridDim.z;
  unsigned sum, cnt, mine, sp = 0u;
  for (;;) {
    sum = 0u; cnt = 0u; mine = 0u;
#pragma unroll
    for (unsigned j = 0; j < 16; ++j) { const unsigned c = xb_ld(&bar[XB_XCNT(j)]); sum += c; cnt += (c > 0u) ? 1u : 0u; mine = (j == x) ? c : mine; }
    if (sum == G) break;
    __builtin_amdgcn_s_sleep(1);
    if ((++sp & 255u) == 0u) { if (xb_ld(&bar[XB_TMO])) break; if (sp > XB_SPIN_CAP) { atomicAdd(&bar[XB_TMO], 1u); break; } }
  }
  nloc = mine > 0u ? mine : 1u; nx = cnt > 0u ? cnt : 1u;
}
DEVI void xcd_barrier(unsigned* bar_, volatile LAS unsigned* st_) {
  XcdBarrier b; b.bar = bar_; b.st = st_; b.x = xb_xcc_id();
  asm volatile("s_waitcnt vmcnt(0)" ::: "memory");
  __syncthreads();
  if (ltid() == 0) {
    unsigned* bar = b.bar;
    __builtin_amdgcn_s_waitcnt(0);
    unsigned nloc = b.st[0], nx = b.st[1];
    if (nloc == 0u) { xcd_barrier_complete(bar, b.x, nloc, nx); b.st[0] = nloc; b.st[1] = nx; }
    const unsigned old = xb_add(&bar[XB_XSUB(b.x)], 1u);
    const unsigned gen = old / nloc;
    if (old + 1u == (gen + 1u) * nloc) {
      __builtin_amdgcn_fence(__ATOMIC_RELEASE, "agent");
      asm volatile("s_waitcnt vmcnt(0)" ::: "memory");
      const unsigned og = xb_add(&bar[XB_TOP], 1u);
      const unsigned tg = og / nx;
      if (og + 1u == (tg + 1u) * nx) xb_add(&bar[XB_TOPGEN], 1u);
      else XB_SPIN(xb_ld(&bar[XB_TOPGEN]) == tg, bar);
      __builtin_amdgcn_fence(__ATOMIC_ACQUIRE, "agent");
      xb_add(&bar[XB_XGEN(b.x)], 1u);
      asm volatile("s_waitcnt vmcnt(0)" ::: "memory");
    } else {
      XB_SPIN(xb_ld(&bar[XB_XGEN(b.x)]) == gen, bar);
      __builtin_amdgcn_fence(__ATOMIC_ACQUIRE, "agent");
      asm volatile("s_waitcnt vmcnt(0)" ::: "memory");
    }
  }
  __syncthreads();
}

__global__ void __launch_bounds__(512) mega(Params P) {
  extern __shared__ __attribute__((aligned(16))) unsigned char smem[];
  cg::grid_group grid = cg::this_grid();
  LAS unsigned char* lds = (LAS unsigned char*)smem;
  int* qslot = (int*)(smem + LDS_BYTES - 16);
#define PHASE_PTRS unsigned char* ws = lptr(P.ws); float* rowsq = (float*)(ws + OFF_SMALL + S_ROWSQ); bf16_t* xb = (bf16_t*)(ws + OFF_XB); (void)rowsq; (void)xb;
  const int G = gridDim.x, cid = lbid();

  {
    volatile LAS unsigned* stw = (volatile LAS unsigned*)(lds + LDS_BYTES - 64);
    if (threadIdx.x < 4) stw[threadIdx.x] = 0u;
    unsigned* barw = (unsigned*)(P.ws + OFF_SMALL + S_BAR);
    if (cid == 0) for (int i = threadIdx.x; i < XCD_BAR_WORDS; i += 512) barw[i] = 0u;
  }
  prep_global_a(P);
  grid.sync();
  (void)xcd_barrier_post((unsigned*)(P.ws + OFF_SMALL + S_BAR), (volatile LAS unsigned*)(lds + LDS_BYTES - 64));
#define GRID_BAR() xcd_barrier((unsigned*)(lptr(P.ws) + OFF_SMALL + S_BAR), (volatile LAS unsigned*)(lds + LDS_BYTES - 64))
  prep_global_b(P);
  prep_layer(P, lsg(0), smem);
  GRID_BAR();

#pragma unroll 1
  for (int layer = 0; layer < 2; ++layer) {
    for (int rep = 0; rep < REP_A; ++rep) {
      PHASE_PTRS
      Gemm g{xb, (const bf16_t*)(ws + OFF_W + W_IN), 1024, 1024, 1024, 0, 0};
      pg8::StaticOrder S; S.init(128, 28, G, cid);
      EpiG1 E{rowsq + (size_t)(3 * layer) * T_TOK, (bf16_t*)(ws + OFF_PROJ), (bf16_t*)(ws + OFF_U), (float*)(ws + OFF_SMALL + S_DT), ws + OFF_GATES};
      pg8::gemm_phase(lds, g, S, E);
    }
    GRID_BAR();
    for (int rep = 0; rep < REP_B1; ++rep) {
      PHASE_PTRS
      int* q = (int*)(ws + OFF_SMALL + S_CTR) + layer * 8 + rep * 16;
      for (;;) {
        const int it = qpop(q, qslot);
        if (it >= 1408) break;
        if (it < 32) {
#ifndef SKIP_SSD
          ssd_seq(P, layer, it, smem);
#endif
        }
        else if (it < 96) {
#ifndef SKIP_HG
          hgrn2_seq(P, layer, it - 32, smem);
#endif
        }
        else if (it < 128) {
          const int x = it - 96;
          Gemm g{(const bf16_t*)(ws + OFF_U), (const bf16_t*)(ws + OFF_MINT), UK, 1024, 1024, (size_t)512 * UK * 2, (size_t)256 * 1024 * 2};
          pg8::OneUnit S; S.u = Unit{x & 1, 0, x >> 1};
          EpiS5in E{(bf16_t*)(ws + OFF_U), (const float*)(ws + OFF_SMALL + S_LAM) + (size_t)layer * 16 * 64 * 65 * 2};
          pg8::gemm_phase(lds, g, S, E);
        }
        else if (it < 384) toep_build(P, layer, it - 128);
        else {
#ifndef SKIP_ATT
          attn_item(P, layer, it - 384, smem);
#endif
        }
      }
    }
    GRID_BAR();
    for (int rep = 0; rep < REP_B3; ++rep)
    for (int x = cid; x < 128; x += G) {
      PHASE_PTRS
      Gemm g{(const bf16_t*)(ws + OFF_U), (const bf16_t*)(ws + OFF_TOEP), UK, UK, UK, (size_t)512 * UK * 2, (size_t)1024 * UK * 2};
      pg8::OneUnit S; S.u = Unit{(x >> 2) & 1, x & 3, x >> 3};
      EpiToep E{(const bf16_t*)(ws + OFF_U), P.in[18] + layer * 256, (bf16_t*)(ws + OFF_Y)};
      pg8::gemm_phase(lds, g, S, E);
    }
    GRID_BAR();
    for (int x = cid; x < 128; x += G) {
      PHASE_PTRS
      Gemm g{(const bf16_t*)(ws + OFF_Y) + 512, (const bf16_t*)(ws + OFF_W + W_GLU), 1024, 256, 256, 0, 0};
      pg8::OneUnit S; S.u = Unit{x, 0, 0};
      EpiGLU E{(bf16_t*)(ws + OFF_Y)};
      pg8::gemm_phase(lds, g, S, E);
    }
    GRID_BAR();
    for (int rep = 0; rep < REP_C; ++rep) merge_phase(P, smem);
    GRID_BAR();
    convert_p(P, layer);
    {
      PHASE_PTRS
      Gemm g{(const bf16_t*)(ws + OFF_MERGED), (const bf16_t*)(ws + OFF_W + W_OUT), 1024, 1024, 1024, 0, 0};
      pg8::StaticOrder S; S.init(128, 4, G, cid);
      EpiRes E{layer == 0 ? P.in[0] : P.out, P.out, xb, rowsq + (size_t)(3 * layer + 1) * T_TOK};
      pg8::gemm_phase(lds, g, S, E);
    }
    GRID_BAR();
    for (int rep = 0; rep < REP_E; ++rep) {
      PHASE_PTRS
      Gemm g{xb, (const bf16_t*)(ws + OFF_W + W_FF1), 1024, 1024, 1024, 0, 0};
      pg8::StaticOrder S; S.init(128, 16, G, cid);
      EpiFF1 E{rowsq + (size_t)(3 * layer + 1) * T_TOK, (bf16_t*)(ws + OFF_HID)};
      pg8::gemm_phase(lds, g, S, E);
    }
    {
      PHASE_PTRS
      Gemm g{(const bf16_t*)(ws + OFF_PB), (const bf16_t*)(ws + OFF_W + W_PLE), 256, 256, 256, 0, 0};
      pg8::StaticOrder S; S.init(128, 4, G, cid);
      EpiPle E{(bf16_t*)(ws + OFF_PLE)};
      pg8::gemm_phase(lds, g, S, E);
    }
    GRID_BAR();
    {
      PHASE_PTRS
      Gemm g{(const bf16_t*)(ws + OFF_HID), (const bf16_t*)(ws + OFF_W + W_FF2), 4096, 4096, 4096, 0, 0};
      pg8::StaticOrder S; S.init(128, 4, G, cid);
      EpiRes E{P.out, P.out, xb, rowsq + (size_t)(3 * layer + 2) * T_TOK};
      pg8::gemm_phase(lds, g, S, E);
    }
    GRID_BAR();
    {
      PHASE_PTRS
      Gemm g{xb, (const bf16_t*)(ws + OFF_W + W_PG + (size_t)layer * 2 * MiB), 1024, 1024, 1024, 0, 0};
      pg8::StaticOrder S; S.init(128, 4, G, cid);
      EpiPG E{rowsq + (size_t)(3 * layer + 2) * T_TOK, (const bf16_t*)(ws + OFF_PLE), P.out, P.out, xb, rowsq + (size_t)(3 * layer + 3) * T_TOK};
      pg8::gemm_phase(lds, g, S, E);
    }
    if (layer == 0) { __syncthreads(); prep_layer(P, lsg(1), smem); }
    GRID_BAR();
  }
}

extern "C" void kernel_launch(void* const* d_in, const int* in_sizes, int n_in, void* d_out, int out_size, void* d_ws, size_t ws_size, hipStream_t stream) {
  static int grid_blocks = 0;
  if (ws_size < WS_NEED) { fprintf(stderr, "workspace too small: %zu < %zu\n", ws_size, (size_t)WS_NEED); return; }
  if (!grid_blocks) {
    int dev = 0, cus = 0, per_cu = 0;
    hipGetDevice(&dev);
    hipDeviceGetAttribute(&cus, hipDeviceAttributeMultiprocessorCount, dev);
    hipFuncSetAttribute((const void*)mega, hipFuncAttributeMaxDynamicSharedMemorySize, LDS_BYTES);
    hipOccupancyMaxActiveBlocksPerMultiprocessor(&per_cu, mega, 512, LDS_BYTES);
    if (per_cu < 1) per_cu = 1;
    grid_blocks = cus * per_cu;
    if (grid_blocks > 256) grid_blocks = 256;
  }
  Params P{};
  for (int i = 0; i < 32; ++i) P.in[i] = (const float*)d_in[i];
  P.out = (float*)d_out; P.ws = (unsigned char*)d_ws;
  void* args[] = {&P};
  hipError_t e = hipLaunchCooperativeKernel((void*)mega, dim3(grid_blocks), dim3(512), args, LDS_BYTES, stream);
  if (e != hipSuccess) fprintf(stderr, "cooperative launch failed: %s (grid %d)\n", hipGetErrorString(e), grid_blocks);
}
```

```cpp
#include <hip/hip_runtime.h>
#include <hip/hip_cooperative_groups.h>
#include <cstdio>
namespace cg = cooperative_groups;

#define DEVI __device__ __forceinline__
#define LAS __attribute__((address_space(3)))
typedef unsigned short bf16_t;
typedef short bf16x8 __attribute__((ext_vector_type(8)));
typedef short bf16x4 __attribute__((ext_vector_type(4)));
typedef float f32x4 __attribute__((ext_vector_type(4)));
typedef unsigned u32x4 __attribute__((ext_vector_type(4)));
typedef unsigned u32x2 __attribute__((ext_vector_type(2)));

constexpr int T_TOK = 32768, DM = 1024, SEQ = 2048, NCH = 32;
constexpr int PW = 2560;
constexpr int UK = 1152;
constexpr float EPSF = 1e-6f;
constexpr size_t MiB = 1024ull * 1024ull;
constexpr size_t OFF_GATES = 0, OFF_HID = 0, OFF_Y = 128 * MiB, OFF_PROJ = 192 * MiB, OFF_MERGED = 192 * MiB, OFF_PLE = 256 * MiB,
                 OFF_PB = 320 * MiB, OFF_XB = 352 * MiB, OFF_TOEP = 352 * MiB, OFF_W = 416 * MiB, OFF_MINT = 456 * MiB, OFF_U = 464 * MiB,
                 OFF_SMALL = 483 * MiB, WS_NEED = 493 * MiB;
constexpr size_t W_IN = 0, W_BR = 14 * MiB, W_OUT = 16 * MiB, W_FF1 = 18 * MiB, W_FF2 = 26 * MiB, W_PLE = 34 * MiB, W_GLU = 34 * MiB + 512 * 1024,
                 W_PG = 35 * MiB  ;
constexpr size_t S_ROWSQ = 6 * MiB, S_KT = 1 * MiB, S_LAM = 3 * MiB, S_BB = 3 * MiB + 1280 * 1024, S_DT = 5 * MiB, S_CTR = 5 * MiB + 512 * 1024, S_BAR = 5 * MiB + 768 * 1024, S_SSQ = 8 * MiB;
constexpr int LDS_BYTES = 152 * 1024;
#ifndef REP_A
#define REP_A 1
#endif
#ifndef REP_B1
#define REP_B1 1
#endif
#ifndef REP_B3
#define REP_B3 1
#endif
#ifndef REP_C
#define REP_C 1
#endif
#ifndef REP_E
#define REP_E 1
#endif

struct Params { const float* in[32]; float* out; unsigned char* ws; };

DEVI int ltid() { int t = threadIdx.x; asm volatile("" : "+v"(t)); return t; }
DEVI int lbid() { int b = blockIdx.x; asm volatile("" : "+s"(b)); return b; }
DEVI unsigned char* lptr(unsigned char* p) { asm volatile("" : "+s"(p)); return p; }
DEVI int lsg(int v) { asm volatile("" : "+s"(v)); return v; }
DEVI float bf2f(unsigned v) { return __uint_as_float(v << 16); }
DEVI bf16_t f2bf(float f) { unsigned u = __float_as_uint(f); u += 0x7FFFu + ((u >> 16) & 1u); return (bf16_t)(u >> 16); }
DEVI unsigned pk2(float lo, float hi) { unsigned r; asm volatile("v_cvt_pk_bf16_f32 %0, %1, %2" : "=v"(r) : "v"(lo), "v"(hi)); return r; }
DEVI void unpack8(u32x4 w, float* f) {
#pragma unroll
  for (int i = 0; i < 4; ++i) { f[2 * i] = __uint_as_float(w[i] << 16); f[2 * i + 1] = __uint_as_float(w[i] & 0xffff0000u); }
}
DEVI u32x4 pack8(const float* f) { u32x4 w; w[0] = pk2(f[0], f[1]); w[1] = pk2(f[2], f[3]); w[2] = pk2(f[4], f[5]); w[3] = pk2(f[6], f[7]); return w; }
typedef unsigned long long u64;
constexpr float RSQ_SCALE = 16777216.0f, RSQ_INV = 1.0f / (16777216.0f * 1024.0f);
DEVI float rs_from(const u64* p, int row) { return rsqrtf((float)p[row] * RSQ_INV + EPSF); }
DEVI void rs_add(u64* p, int row, float ss) { atomicAdd(p + row, (u64)(ss * RSQ_SCALE + 0.5f)); }
#define DPP_SHR(v, n) __int_as_float(__builtin_amdgcn_update_dpp(0, __float_as_int(v), 0x110 + (n), 0xF, 0xF, false))
DEVI float wave_incl_scan(float v, int lane) {
  v += DPP_SHR(v, 1); v += DPP_SHR(v, 2); v += DPP_SHR(v, 4); v += DPP_SHR(v, 8);
  const float t0 = __int_as_float(__builtin_amdgcn_readlane(__float_as_int(v), 15));
  const float t1 = __int_as_float(__builtin_amdgcn_readlane(__float_as_int(v), 31));
  const float t2 = __int_as_float(__builtin_amdgcn_readlane(__float_as_int(v), 47));
  const int row = lane >> 4;
  return v + (row >= 1 ? t0 : 0.f) + (row >= 2 ? t1 : 0.f) + (row >= 3 ? t2 : 0.f);
}
#define DPP_MOV(v, ctrl) __int_as_float(__builtin_amdgcn_update_dpp(0, __float_as_int(v), (ctrl), 0xF, 0xF, false))
DEVI float sum8(float v) {
  v += DPP_MOV(v, 0xB1);
  v += DPP_MOV(v, 0x4E);
  v += DPP_MOV(v, 0x141);
  return v;
}
DEVI float frcp(float x) { return __builtin_amdgcn_rcpf(x); }
DEVI float sigmoidf_(float x) { return frcp(1.0f + __expf(-x)); }
DEVI float siluf_(float x) { return x * frcp(1.0f + __expf(-x)); }
DEVI float gelu_tanh(float x) { float u = 0.7978845608f * (x + 0.044715f * x * x * x); float t = 1.0f - 2.0f * frcp(1.0f + __expf(2.0f * u)); return 0.5f * x * (1.0f + t); }
DEVI f32x4 mfma16(bf16x8 a, bf16x8 b, f32x4 c) { return __builtin_amdgcn_mfma_f32_16x16x32_bf16(a, b, c, 0, 0, 0); }

namespace pg8 {
constexpr int BM = 256, BK = 64, HALF = 128, HTB = HALF * BK * 2, STAGE_BYTES = 8 * HTB, NXCD = 8, WGM = 8;
DEVI int lds_byte(int r, int c) { const int st = (r >> 4) * 2 + (c >> 5), rr = r & 15, cc = c & 31, ob = rr * 64 + cc * 2; return st * 1024 + (ob ^ (((ob >> 9) & 1) << 5)); }
DEVI void stage_rc(int b, int& R, int& C) { const int st = b / 1024, sb = b % 1024, swz = sb ^ (((sb >> 9) & 1) << 5); R = (st >> 1) * 16 + swz / 64; C = (st & 1) * 32 + (swz % 64) / 2; }
DEVI int perm32(int rho) { const int n = rho >> 4, i = rho & 15; return 8 * (i >> 2) + 4 * n + (i & 3); }
struct Unit { int pm, pn, grp; };
struct Gemm { const bf16_t* A; const bf16_t* Bt; int lda, ldb, K; size_t gsA, gsB; };
struct StaticOrder {
  int nM, nN, nwg, G, c;
  DEVI void init(int nM_, int nN_, int G_, int c_) { nM = nM_; nN = nN_; nwg = nM * nN; G = G_; c = c_; }
  DEVI bool next(int i, Unit& u) const {
    const long L = (long)i * G + c; if (L >= nwg) return false;
    int wgid = (int)L; { const int q = nwg / NXCD, r = nwg % NXCD, xcd = wgid % NXCD, off = wgid / NXCD; wgid = (xcd < r ? xcd * (q + 1) : r * (q + 1) + (xcd - r) * q) + off; }
    const int nig = WGM * nN, gid = wgid / nig, fm = gid * WGM, gsz = (nM - fm) < WGM ? (nM - fm) : WGM;
    u.pm = fm + ((wgid % nig) % gsz); u.pn = (wgid % nig) / gsz; u.grp = 0; return true;
  }
};
struct OneUnit { Unit u; DEVI bool next(int i, Unit& o) const { if (i != 0) return false; o = u; return true; } };

template <class Epi, class Sched>
DEVI void gemm_phase(LAS unsigned char* lds, const Gemm g, const Sched& S, const Epi& E) {
  int tid_ = threadIdx.x; asm volatile("" : "+v"(tid_));
  const int tid = tid_, wid = __builtin_amdgcn_readfirstlane(tid >> 6), lane = tid & 63, wr = wid >> 2, wc = wid & 3, fr = lane & 15, fq = lane >> 4;
  const int K = g.K, nt = K / BK;
  unsigned voffA[2], voffB[2];
#pragma unroll
  for (int i = 0; i < 2; ++i) { int R, C; stage_rc(tid * 16 + i * 8192, R, C); const int Rb = Epi::PERM ? ((R & ~31) + perm32(R & 31)) : R;
    voffA[i] = (unsigned)(R * g.lda + C) * 2u; voffB[i] = (unsigned)(Rb * g.ldb + C) * 2u; }
  const size_t kstep = (size_t)(BK * 2);
  const size_t hstepA = (size_t)HALF * g.lda * 2, hstepB = (size_t)HALF * g.ldb * 2;
  const unsigned ldsw = (unsigned)wid * 1024u;
  const int aoff = lds_byte(wr * 64 + fr, fq * 8), boff = lds_byte(wc * 32 + fr, fq * 8);
#define PG8_SA(b, h) (((b) * 2 + (h)) * HTB)
#define PG8_SB(b, h) ((4 + (b) * 2 + (h)) * HTB)
#define PG8_STAGE(bufoff, gbase, voff) do { _Pragma("unroll") for (int _i = 0; _i < 2; ++_i) \
    __builtin_amdgcn_global_load_lds((const unsigned*)((const char*)(gbase) + (voff)[_i]), (LAS unsigned*)(lds + (bufoff) + ldsw + _i * 8192), 16, 0, 0); } while (0)
#define PG8_LDA(dst, b, h) do { _Pragma("unroll") for (int m = 0; m < 4; ++m) _Pragma("unroll") for (int k = 0; k < 2; ++k) dst[m][k] = *(const LAS bf16x8*)(lds + PG8_SA(b, h) + aoff + m * 2048 + k * 1024); } while (0)
#define PG8_LDB(dst, b, h) do { _Pragma("unroll") for (int n = 0; n < 2; ++n) _Pragma("unroll") for (int k = 0; k < 2; ++k) dst[n][k] = *(const LAS bf16x8*)(lds + PG8_SB(b, h) + boff + n * 2048 + k * 1024); } while (0)
#define PG8_MMA(ai, bj, At, Bt) do { __builtin_amdgcn_s_setprio(1); _Pragma("unroll") for (int m = 0; m < 4; ++m) _Pragma("unroll") for (int n = 0; n < 2; ++n) _Pragma("unroll") for (int k = 0; k < 2; ++k) \
    acc[ai][bj][m][n] = __builtin_amdgcn_mfma_f32_16x16x32_bf16(Bt[n][k], At[m][k], acc[ai][bj][m][n], 0, 0, 0); __builtin_amdgcn_s_setprio(0); } while (0)
#define PG8_WAIT_V(n) asm volatile("s_waitcnt vmcnt(" #n ")" ::: "memory")
#define PG8_WAIT_L(n) asm volatile("s_waitcnt lgkmcnt(" #n ")" ::: "memory")
#define PG8_BAR __builtin_amdgcn_s_barrier()
#define PG8_SCHED __builtin_amdgcn_sched_barrier(0)
  Unit cur, nxt; int ui = 0;
  if (!S.next(0, cur)) return;
  f32x4 acc[2][2][4][2];
#pragma unroll
  for (int a = 0; a < 2; ++a)
#pragma unroll
    for (int b = 0; b < 2; ++b)
#pragma unroll
      for (int m = 0; m < 4; ++m)
#pragma unroll
        for (int n = 0; n < 2; ++n) acc[a][b][m][n] = (f32x4){0.f, 0.f, 0.f, 0.f};
  bf16x8 At[4][2], B0[2][2], B1[2][2];
  const char* cA = (const char*)g.A + (size_t)cur.grp * g.gsA + (size_t)cur.pm * 2 * hstepA;
  const char* cB = (const char*)g.Bt + (size_t)cur.grp * g.gsB + (size_t)cur.pn * 2 * hstepB;
  PG8_STAGE(PG8_SB(0, 0), cB, voffB); PG8_STAGE(PG8_SA(0, 0), cA, voffA); PG8_STAGE(PG8_SB(0, 1), cB + hstepB, voffB); PG8_STAGE(PG8_SA(0, 1), cA + hstepA, voffA);
  if (wr == 1) PG8_BAR;
  PG8_WAIT_V(4); PG8_BAR;
  PG8_STAGE(PG8_SB(1, 0), cB + kstep, voffB); PG8_STAGE(PG8_SA(1, 0), cA + kstep, voffA); PG8_STAGE(PG8_SB(1, 1), cB + hstepB + kstep, voffB);
  PG8_WAIT_V(6); PG8_BAR;
  for (;;) {
    const bool has_next = S.next(ui + 1, nxt);
    const char* nA = has_next ? (const char*)g.A + (size_t)nxt.grp * g.gsA + (size_t)nxt.pm * 2 * hstepA : cA;
    const char* nB = has_next ? (const char*)g.Bt + (size_t)nxt.grp * g.gsB + (size_t)nxt.pn * 2 * hstepB : cB;
    for (int t = 0; t < nt; t += 2) {
      const bool last = (t == nt - 2);
      const char* a1 = cA + (size_t)(t + 1) * kstep;
      const char* a2 = last ? nA : cA + (size_t)(t + 2) * kstep; const char* b2 = last ? nB : cB + (size_t)(t + 2) * kstep;
      const char* a3 = a2 + kstep; const char* b3 = b2 + kstep;
      PG8_LDB(B0, 0, 0); PG8_SCHED; PG8_LDA(At, 0, 0); PG8_STAGE(PG8_SA(1, 1), a1 + hstepA, voffA);
      PG8_WAIT_L(8); PG8_BAR; PG8_WAIT_L(0); PG8_MMA(0, 0, At, B0); PG8_BAR; PG8_SCHED;
      PG8_LDB(B1, 0, 1); PG8_STAGE(PG8_SB(0, 0), b2, voffB);
      PG8_BAR; PG8_WAIT_L(0); PG8_MMA(0, 1, At, B1); PG8_BAR;
      PG8_LDA(At, 0, 1); PG8_STAGE(PG8_SA(0, 0), a2, voffA);
      PG8_BAR; PG8_WAIT_L(0); PG8_MMA(1, 0, At, B0); PG8_BAR; PG8_SCHED;
      PG8_STAGE(PG8_SB(0, 1), b2 + hstepB, voffB);
      PG8_WAIT_V(6); PG8_BAR; PG8_MMA(1, 1, At, B1); PG8_BAR;
      PG8_LDB(B0, 1, 0); PG8_SCHED; PG8_LDA(At, 1, 0); PG8_STAGE(PG8_SA(0, 1), a2 + hstepA, voffA);
      PG8_WAIT_L(8); PG8_BAR; PG8_WAIT_L(0); PG8_MMA(0, 0, At, B0); PG8_BAR; PG8_SCHED;
      PG8_LDB(B1, 1, 1); PG8_STAGE(PG8_SB(1, 0), b3, voffB);
      PG8_BAR; PG8_WAIT_L(0); PG8_MMA(0, 1, At, B1); PG8_BAR;
      PG8_LDA(At, 1, 1); PG8_STAGE(PG8_SA(1, 0), a3, voffA);
      PG8_BAR; PG8_WAIT_L(0); PG8_MMA(1, 0, At, B0); PG8_BAR; PG8_SCHED;
      PG8_STAGE(PG8_SB(1, 1), b3 + hstepB, voffB);
      PG8_WAIT_V(6); PG8_BAR; PG8_MMA(1, 1, At, B1); PG8_BAR;
    }
    asm volatile("s_nop 7\n\ts_nop 7" ::: "memory");
    if constexpr (!Epi::AFTER_DRAIN) { E(acc, cur, wr, wc, fr, fq); }
    if (!has_next) break;
#pragma unroll
    for (int a = 0; a < 2; ++a)
#pragma unroll
      for (int b = 0; b < 2; ++b)
#pragma unroll
        for (int m = 0; m < 4; ++m)
#pragma unroll
          for (int n = 0; n < 2; ++n) acc[a][b][m][n] = (f32x4){0.f, 0.f, 0.f, 0.f};
    cur = nxt; cA = nA; cB = nB; ++ui;
  }
  PG8_WAIT_V(0);
  if (wr == 0) PG8_BAR;
  PG8_BAR;
  if constexpr (Epi::AFTER_DRAIN) { E.fused(acc, cur, wr, wc, fr, fq, lds, wid, lane); }
#undef PG8_SA
#undef PG8_SB
#undef PG8_STAGE
#undef PG8_LDA
#undef PG8_LDB
#undef PG8_MMA
#undef PG8_WAIT_V
#undef PG8_WAIT_L
#undef PG8_BAR
#undef PG8_SCHED
}
}
using pg8::Unit; using pg8::Gemm;
typedef f32x4 AccT[2][2][4][2];

struct EpiG1 {
  static constexpr bool PERM = true, AFTER_DRAIN = false;
  const u64* rowsq; bf16_t* proj; bf16_t* U; float* dt; unsigned char* gates;
  DEVI void operator()(const AccT& acc, const Unit& u, int wr, int wc, int fr, int fq) const {
    const int pn = u.pn;
    float rsv[2][4];
#pragma unroll
    for (int ai = 0; ai < 2; ++ai)
#pragma unroll
      for (int m = 0; m < 4; ++m) rsv[ai][m] = rs_from(rowsq, u.pm * 256 + ai * 128 + wr * 64 + m * 16 + fr);
#pragma unroll
    for (int ai = 0; ai < 2; ++ai)
#pragma unroll
      for (int m = 0; m < 4; ++m) {
        const int row = u.pm * 256 + ai * 128 + wr * 64 + m * 16 + fr;
        const float rs = rsv[ai][m];
#pragma unroll
        for (int bj = 0; bj < 2; ++bj) {
          const int cc = bj * 128 + wc * 32 + fq * 8;
          float v[8];
#pragma unroll
          for (int e = 0; e < 4; ++e) { v[e] = acc[ai][bj][m][0][e] * rs; v[4 + e] = acc[ai][bj][m][1][e] * rs; }
          if (pn >= 12) {
            unsigned q[8];
#pragma unroll
            for (int e = 0; e < 8; ++e) { q[e] = (unsigned)(sigmoidf_(v[e]) * 255.0f + 0.5f); q[e] = q[e] > 255u ? 255u : q[e]; }
            u32x2 w; w[0] = q[0] | (q[1] << 8) | (q[2] << 16) | (q[3] << 24); w[1] = q[4] | (q[5] << 8) | (q[6] << 16) | (q[7] << 24);
            *(u32x2*)(gates + (size_t)row * 4096 + (pn - 12) * 256 + cc) = w;
          } else if (pn == 11) {
            if (cc == 0) *(f32x4*)(dt + (size_t)row * 4) = (f32x4){v[0], v[1], v[2], v[3]};
          } else if (pn == 7) {
            const int g = cc >> 4, i0 = cc & 15;
            *(u32x4*)(U + ((size_t)(g * 512 + (row >> 6)) * UK + (row & 63) * 16 + i0)) = pack8(v);
          } else {
            const int pt = pn < 7 ? pn : pn - 1;
            *(u32x4*)(proj + (size_t)row * PW + pt * 256 + cc) = pack8(v);
          }
        }
      }
  }
};
template <bool XF32>
struct EpiRes {
  static constexpr bool PERM = true, AFTER_DRAIN = false;
  const float* xin; bf16_t* xb; u64* rsq_out;
  DEVI void operator()(const AccT& acc, const Unit& u, int wr, int wc, int fr, int fq) const {
#pragma unroll
    for (int ai = 0; ai < 2; ++ai)
#pragma unroll
    for (int mh = 0; mh < 2; ++mh) {
      f32x4 xf[4][2][2]; u32x4 xh[4][2];
#pragma unroll
      for (int m = 2 * mh; m < 2 * mh + 2; ++m)
#pragma unroll
        for (int bj = 0; bj < 2; ++bj) {
          const size_t o = (size_t)(u.pm * 256 + ai * 128 + wr * 64 + m * 16 + fr) * 1024 + u.pn * 256 + bj * 128 + wc * 32 + fq * 8;
          if (XF32) { xf[m][bj][0] = *(const f32x4*)(xin + o); xf[m][bj][1] = *(const f32x4*)(xin + o + 4); }
          else xh[m][bj] = *(const u32x4*)(xb + o);
        }
#pragma unroll
      for (int m = 2 * mh; m < 2 * mh + 2; ++m) {
        const int row = u.pm * 256 + ai * 128 + wr * 64 + m * 16 + fr;
        float ss = 0.f;
#pragma unroll
        for (int bj = 0; bj < 2; ++bj) {
          const size_t o = (size_t)row * 1024 + u.pn * 256 + bj * 128 + wc * 32 + fq * 8;
          float xo[8];
          if (XF32) {
#pragma unroll
            for (int e = 0; e < 4; ++e) { xo[e] = xf[m][bj][0][e]; xo[4 + e] = xf[m][bj][1][e]; } }
          else unpack8(xh[m][bj], xo);
          float v[8];
#pragma unroll
          for (int e = 0; e < 4; ++e) { v[e] = acc[ai][bj][m][0][e] + xo[e]; v[4 + e] = acc[ai][bj][m][1][e] + xo[4 + e]; }
          const u32x4 w = pack8(v);
          *(u32x4*)(xb + o) = w;
          float vr[8]; unpack8(w, vr);
#pragma unroll
          for (int e = 0; e < 8; ++e) ss += vr[e] * vr[e];
        }
        ss += __shfl_xor(ss, 16); ss += __shfl_xor(ss, 32);
        if (fq == 0) rs_add(rsq_out, row, ss);
      }
    }
  }
};
struct EpiFF1 {
  static constexpr bool PERM = true, AFTER_DRAIN = false;
  const u64* rowsq; bf16_t* hid;
  DEVI void operator()(const AccT& acc, const Unit& u, int wr, int wc, int fr, int fq) const {
    float rsv[2][4];
#pragma unroll
    for (int ai = 0; ai < 2; ++ai)
#pragma unroll
      for (int m = 0; m < 4; ++m) rsv[ai][m] = rs_from(rowsq, u.pm * 256 + ai * 128 + wr * 64 + m * 16 + fr);
#pragma unroll
    for (int ai = 0; ai < 2; ++ai)
#pragma unroll
      for (int m = 0; m < 4; ++m) {
        const int row = u.pm * 256 + ai * 128 + wr * 64 + m * 16 + fr;
        const float rs = rsv[ai][m];
#pragma unroll
        for (int bj = 0; bj < 2; ++bj) {
          float v[8];
#pragma unroll
          for (int e = 0; e < 4; ++e) { float a = fmaxf(acc[ai][bj][m][0][e] * rs, 0.f), b = fmaxf(acc[ai][bj][m][1][e] * rs, 0.f); v[e] = a * a; v[4 + e] = b * b; }
          *(u32x4*)(hid + (size_t)row * 4096 + u.pn * 256 + bj * 128 + wc * 32 + fq * 8) = pack8(v);
        }
      }
  }
};
struct EpiPle {
  static constexpr bool PERM = true, AFTER_DRAIN = false;
  bf16_t* ple;
  DEVI void operator()(const AccT& acc, const Unit& u, int wr, int wc, int fr, int fq) const {
#pragma unroll
    for (int ai = 0; ai < 2; ++ai)
#pragma unroll
      for (int m = 0; m < 4; ++m) {
        const int row = u.pm * 256 + ai * 128 + wr * 64 + m * 16 + fr;
#pragma unroll
        for (int bj = 0; bj < 2; ++bj) {
          float v[8];
#pragma unroll
          for (int e = 0; e < 4; ++e) { v[e] = acc[ai][bj][m][0][e]; v[4 + e] = acc[ai][bj][m][1][e]; }
          *(u32x4*)(ple + (size_t)row * 1024 + u.pn * 256 + bj * 128 + wc * 32 + fq * 8) = pack8(v);
        }
      }
  }
};
struct EpiPG {
  static constexpr bool PERM = true, AFTER_DRAIN = false;
  const u64* rowsq; const bf16_t* ple; const bf16_t* xbo; float* xout; bf16_t* xbn; u64* rsq_out; int last;
  DEVI void operator()(const AccT& acc, const Unit& u, int wr, int wc, int fr, int fq) const {
#pragma unroll
    for (int ai = 0; ai < 2; ++ai)
#pragma unroll
    for (int mh = 0; mh < 2; ++mh) {
      u32x4 xh[4][2], ph[4][2]; float rsv[4];
#pragma unroll
      for (int m = 2 * mh; m < 2 * mh + 2; ++m) {
        const int row = u.pm * 256 + ai * 128 + wr * 64 + m * 16 + fr;
        rsv[m] = rs_from(rowsq, row);
#pragma unroll
        for (int bj = 0; bj < 2; ++bj) {
          const size_t o = (size_t)row * 1024 + u.pn * 256 + bj * 128 + wc * 32 + fq * 8;
          xh[m][bj] = *(const u32x4*)(xbo + o); ph[m][bj] = *(const u32x4*)(ple + o);
        }
      }
#pragma unroll
      for (int m = 2 * mh; m < 2 * mh + 2; ++m) {
        const int row = u.pm * 256 + ai * 128 + wr * 64 + m * 16 + fr;
        const float rs = rsv[m];
        float ss = 0.f;
#pragma unroll
        for (int bj = 0; bj < 2; ++bj) {
          const size_t o = (size_t)row * 1024 + u.pn * 256 + bj * 128 + wc * 32 + fq * 8;
          float xo[8]; unpack8(xh[m][bj], xo);
          float pl[8]; unpack8(ph[m][bj], pl);
          float v[8];
#pragma unroll
          for (int e = 0; e < 4; ++e) { v[e] = xo[e] + pl[e] * sigmoidf_(acc[ai][bj][m][0][e] * rs); v[4 + e] = xo[4 + e] + pl[4 + e] * sigmoidf_(acc[ai][bj][m][1][e] * rs); }
          *(f32x4*)(xout + o) = (f32x4){v[0], v[1], v[2], v[3]}; *(f32x4*)(xout + o + 4) = (f32x4){v[4], v[5], v[6], v[7]};
          if (!last) { *(u32x4*)(xbn + o) = pack8(v);
#pragma unroll
          for (int e = 0; e < 8; ++e) ss += v[e] * v[e]; }
        }
        if (!last) { ss += __shfl_xor(ss, 16); ss += __shfl_xor(ss, 32);
        if (fq == 0) rs_add(rsq_out, row, ss); }
      }
    }
  }
};
struct EpiS5in {
  static constexpr bool PERM = false, AFTER_DRAIN = true;
  bf16_t* U; const float* lam;
  DEVI void operator()(const AccT&, const Unit&, int, int, int, int) const {}
  DEVI void fused(const AccT& acc, const Unit& u, int wr, int wc, int fr, int fq, LAS unsigned char* lds, int wid, int lane) const {
    LAS float* L = (LAS float*)lds;
#pragma unroll
    for (int ai = 0; ai < 2; ++ai)
#pragma unroll
      for (int m = 0; m < 4; ++m) {
        const int rl = ai * 128 + wr * 64 + m * 16 + fr;
#pragma unroll
        for (int n = 0; n < 2; ++n) {
          const int c = wc * 32 + n * 16 + fq * 4;
#pragma unroll
          for (int e = 0; e < 4; ++e) L[rl * 128 + c + e] = acc[ai][0][m][n][e];
        }
      }
    __syncthreads();
    const int tid = ltid(), bl = tid >> 6, p = tid & 63, g = u.grp;
    const float lr = lam[((size_t)(g * 64 + p) * 65 + 64) * 2], li = lam[((size_t)(g * 64 + p) * 65 + 64) * 2 + 1];
    float hr = 0.f, hi = 0.f;
    for (int c = 0; c < 32; ++c) {
      const int rl = bl * 32 + c;
      bf16_t* dst = U + ((size_t)(g * 512 + u.pm * 256 + rl) * UK + 1024);
      dst[p] = f2bf(hr); dst[64 + p] = f2bf(hi);
      const float er = L[rl * 128 + p], ei = L[rl * 128 + 64 + p];
      const float nr = lr * hr - li * hi + er, ni = lr * hi + li * hr + ei;
      hr = nr; hi = ni;
    }
    __syncthreads();
  }
};
struct EpiToep {
  static constexpr bool PERM = true, AFTER_DRAIN = false;
  const bf16_t* U; const float* dskip; bf16_t* Y;
  DEVI void operator()(const AccT& acc, const Unit& u, int wr, int wc, int fr, int fq) const {
    const int g = u.grp, i0 = (fq * 8) & 15;
    float dk[8];
#pragma unroll
    for (int e = 0; e < 8; ++e) dk[e] = dskip[g * 16 + i0 + e];
#pragma unroll
    for (int ai = 0; ai < 2; ++ai)
#pragma unroll
    for (int mh = 0; mh < 2; ++mh) {
      u32x4 uh[4][2];
#pragma unroll
      for (int m = 2 * mh; m < 2 * mh + 2; ++m)
#pragma unroll
        for (int bj = 0; bj < 2; ++bj) {
          const int r = u.pm * 256 + ai * 128 + wr * 64 + m * 16 + fr, cidx = u.pn * 256 + bj * 128 + wc * 32 + fq * 8;
          uh[m][bj] = *(const u32x4*)(U + ((size_t)(g * 512 + r) * UK + cidx));
        }
#pragma unroll
      for (int m = 2 * mh; m < 2 * mh + 2; ++m) {
        const int r = u.pm * 256 + ai * 128 + wr * 64 + m * 16 + fr;
#pragma unroll
        for (int bj = 0; bj < 2; ++bj) {
          const int cidx = u.pn * 256 + bj * 128 + wc * 32 + fq * 8, s = cidx >> 4;
          float uv[8]; unpack8(uh[m][bj], uv);
          float v[8];
#pragma unroll
          for (int e = 0; e < 8; ++e) { const float a = (e < 4 ? acc[ai][bj][m][0][e] : acc[ai][bj][m][1][e - 4]) + dk[e] * uv[e]; v[e] = gelu_tanh(a); }
          *(u32x4*)(Y + (size_t)(r * 64 + s) * 1024 + 512 + g * 16 + i0) = pack8(v);
        }
      }
    }
  }
};
struct EpiGLU {
  static constexpr bool PERM = true, AFTER_DRAIN = false;
  bf16_t* Y;
  DEVI void operator()(const AccT& acc, const Unit& u, int wr, int wc, int fr, int fq) const {
#pragma unroll
    for (int ai = 0; ai < 2; ++ai)
#pragma unroll
    for (int mh = 0; mh < 2; ++mh) {
      u32x4 yh[4][2];
#pragma unroll
      for (int m = 2 * mh; m < 2 * mh + 2; ++m)
#pragma unroll
        for (int bj = 0; bj < 2; ++bj)
          yh[m][bj] = *(const u32x4*)(Y + (size_t)(u.pm * 256 + ai * 128 + wr * 64 + m * 16 + fr) * 1024 + 512 + bj * 128 + wc * 32 + fq * 8);
#pragma unroll
      for (int m = 2 * mh; m < 2 * mh + 2; ++m) {
        const int row = u.pm * 256 + ai * 128 + wr * 64 + m * 16 + fr;
#pragma unroll
        for (int bj = 0; bj < 2; ++bj) {
          bf16_t* p = Y + (size_t)row * 1024 + 512 + bj * 128 + wc * 32 + fq * 8;
          float yv[8]; unpack8(yh[m][bj], yv);
          float v[8];
#pragma unroll
          for (int e = 0; e < 8; ++e) v[e] = yv[e] * sigmoidf_(e < 4 ? acc[ai][bj][m][0][e] : acc[ai][bj][m][1][e - 4]);
          *(u32x4*)p = pack8(v);
        }
      }
    }
  }
};

constexpr int TS = 72;
DEVI f32x4 mma64(const bf16_t* A, int lda, const bf16_t* Bt, int ldb, f32x4 acc, int fr, int fq) {
#pragma unroll
  for (int k = 0; k < 64; k += 32) {
    const bf16x8 a = *(const bf16x8*)(A + fr * lda + k + fq * 8);
    const bf16x8 b = *(const bf16x8*)(Bt + fr * ldb + k + fq * 8);
    acc = mfma16(a, b, acc);
  }
  return acc;
}
DEVI int qpop(int* ctr, int* slot) {
  __syncthreads();
  if (ltid() == 0) *slot = atomicAdd(ctr, 1);
  __syncthreads();
  return __builtin_amdgcn_readfirstlane(*slot);
}

DEVI void dep_publish(int* cnt) {
  asm volatile("s_waitcnt vmcnt(0)" ::: "memory");
  __syncthreads();
  if (ltid() == 0) {
    __builtin_amdgcn_fence(__ATOMIC_RELEASE, "agent");
    asm volatile("s_waitcnt vmcnt(0)" ::: "memory");
    __hip_atomic_fetch_add(cnt, 1, __ATOMIC_RELAXED, __HIP_MEMORY_SCOPE_AGENT);
  }
}
DEVI void dep_wait(int* cnt, int need) {
  if (ltid() == 0) {
    unsigned sp = 0;
    while (__hip_atomic_load(cnt, __ATOMIC_RELAXED, __HIP_MEMORY_SCOPE_AGENT) < need) { __builtin_amdgcn_s_sleep(2); if (++sp > (1u << 22)) break; }
    __builtin_amdgcn_fence(__ATOMIC_ACQUIRE, "agent");
    asm volatile("s_waitcnt vmcnt(0)" ::: "memory");
  }
  __syncthreads();
}

__device__ void hgrn2_seq(const Params& P, int layer, int item, unsigned char* smem) {
  int tid_ = threadIdx.x; asm volatile("" : "+v"(tid_));
  const int tid = tid_, wid = tid >> 6, lane = tid & 63, fr = lane & 15, fq = lane >> 4;
  const int b = item >> 2, h = item & 3, r = lane, c8 = wid * 8;
  const int r2 = tid >> 3, c82 = (tid & 7) * 8;
  float* B32 = (float*)smem;
  float* O32 = (float*)(smem + 16384);
  float* WT = (float*)(smem + 16384 + 16640);
  bf16_t* QB = (bf16_t*)(smem + 35072);
  bf16_t* QT = QB + 64 * TS;
  bf16_t* KT = QT + 64 * TS;
  bf16_t* KET = KT + 4 * 64 * TS;
  bf16_t* VT = KET + 64 * TS;
  bf16_t* SC = VT + 64 * TS;
  bf16_t* ST = SC + 64 * TS;
  const bf16_t* proj = (const bf16_t*)(P.ws + OFF_PROJ);
  bf16_t* Y = (bf16_t*)(P.ws + OFF_Y);
  float lbv[8], og[8];
#pragma unroll
  for (int i = 0; i < 8; ++i) {
    const int k = h * 64 + c8 + i;
    if (layer == 0) lbv[i] = 0.f; else { const float l0 = P.in[4][k], l1 = P.in[4][256 + k]; lbv[i] = 1.0f / (1.0f + expf(l0 - l1)); }
    og[i] = P.in[5][layer * 256 + h * 64 + c82 + i];
  }
  f32x4 sacc[2] = {(f32x4){0.f, 0.f, 0.f, 0.f}, (f32x4){0.f, 0.f, 0.f, 0.f}};
  for (int i = tid; i < 2 * 64 * TS; i += 512) ST[i] = 0;
  const bf16_t* pbase = proj + (size_t)(b * SEQ) * PW + h * 64 + c8;
  const bf16_t* gbase = proj + (size_t)(b * SEQ) * PW + 768 + h * 64 + c82;
  u32x4 nq, nz, nv, ng;
  { const bf16_t* p = pbase + (size_t)r * PW; nq = *(const u32x4*)p; nz = *(const u32x4*)(p + 256); nv = *(const u32x4*)(p + 512); ng = *(const u32x4*)(gbase + (size_t)r2 * PW); }
  __syncthreads();
  for (int c = 0; c < NCH; ++c) {
    const int t = c * 64 + r;
    float q[8], z[8], lf[8], kk[8];
    const u32x4 cv = nv, cgt = ng;
    unpack8(nq, q); unpack8(nz, z);
    if (c + 1 < NCH) { const bf16_t* p = pbase + (size_t)(t + 64) * PW; nq = *(const u32x4*)p; nz = *(const u32x4*)(p + 256); nv = *(const u32x4*)(p + 512); ng = *(const u32x4*)(gbase + (size_t)(c * 64 + 64 + r2) * PW); }
#pragma unroll
    for (int i = 0; i < 8; ++i) {
      const float e = __expf(-z[i]), inv = frcp(1.0f + e);
      const float f = lbv[i] + (1.0f - lbv[i]) * inv;
      lf[i] = __logf(fmaxf(f, 1e-37f));
      kk[i] = (1.0f - lbv[i]) * e * inv;
    }
#pragma unroll
    for (int i = 0; i < 8; ++i) lf[i] = wave_incl_scan(lf[i], lane);
#pragma unroll
    for (int i = 0; i < 8; ++i) B32[r * 64 + c8 + i] = lf[i];
    __syncthreads();
    {
      const int I = r >> 4;
      float tq[8], tb[8], vv[8];
      unpack8(cv, vv);
#pragma unroll
      for (int i = 0; i < 8; ++i) { tb[i] = q[i] * __expf(lf[i]); tq[i] = q[i] * __expf(lf[i] - B32[(I * 16) * 64 + c8 + i]); }
      *(u32x4*)(QB + r * TS + c8) = pack8(tb);
      *(u32x4*)(QT + r * TS + c8) = pack8(tq);
      for (int I2 = I; I2 < 4; ++I2) {
        float tk[8];
#pragma unroll
        for (int i = 0; i < 8; ++i) tk[i] = kk[i] * __expf(fminf(B32[(I2 * 16) * 64 + c8 + i] - lf[i], 80.f));
        *(u32x4*)(KT + I2 * 64 * TS + r * TS + c8) = pack8(tk);
      }
#pragma unroll
      for (int i = 0; i < 8; ++i) {
        KET[(c8 + i) * TS + r] = f2bf(kk[i] * __expf(B32[63 * 64 + c8 + i] - lf[i]));
        VT[(c8 + i) * TS + r] = f2bf(vv[i]);
      }
    }
    __syncthreads();
#pragma unroll
    for (int x = 0; x < 2; ++x) {
      const int tl = wid + 8 * x, I = tl >> 2, J = tl & 3;
      f32x4 a = (f32x4){0.f, 0.f, 0.f, 0.f};
      if (J <= I) a = mma64(QT + I * 16 * TS, TS, KT + I * 64 * TS + J * 16 * TS, TS, a, fr, fq);
#pragma unroll
      for (int jj = 0; jj < 4; ++jj) {
        float v = a[jj];
        if (J > I || (J == I && (fq * 4 + jj) < fr)) v = 0.f;
        SC[(I * 16 + fq * 4 + jj) * TS + J * 16 + fr] = f2bf(v);
      }
    }
    __syncthreads();
    const bf16_t* STc = ST + (c & 1) * 64 * TS;
    bf16_t* STn = ST + ((c + 1) & 1) * 64 * TS;
#pragma unroll
    for (int x = 0; x < 2; ++x) {
      const int tb_ = wid >> 1, vb = (wid & 1) * 2 + x;
      f32x4 a = (f32x4){0.f, 0.f, 0.f, 0.f};
      a = mma64(SC + tb_ * 16 * TS, TS, VT + vb * 16 * TS, TS, a, fr, fq);
      a = mma64(QB + tb_ * 16 * TS, TS, STc + vb * 16 * TS, TS, a, fr, fq);
#pragma unroll
      for (int jj = 0; jj < 4; ++jj) O32[(tb_ * 16 + fq * 4 + jj) * 65 + vb * 16 + fr] = a[jj];
      const int kb = (wid & 1) * 2 + x;
      const float dec = __expf(B32[63 * 64 + kb * 16 + fr]);
      f32x4 s = sacc[x];
#pragma unroll
      for (int jj = 0; jj < 4; ++jj) s[jj] *= dec;
      s = mma64(VT + (wid >> 1) * 16 * TS, TS, KET + kb * 16 * TS, TS, s, fr, fq);
      sacc[x] = s;
#pragma unroll
      for (int jj = 0; jj < 4; ++jj) STn[((wid >> 1) * 16 + fq * 4 + jj) * TS + kb * 16 + fr] = f2bf(s[jj]);
    }
    __syncthreads();
    {
      float o[8], gg[8]; float ss = 0.f;
      unpack8(cgt, gg);
#pragma unroll
      for (int i = 0; i < 8; ++i) { o[i] = O32[r2 * 65 + c82 + i]; ss += o[i] * o[i]; }
      ss = sum8(ss);
      const float rs = rsqrtf(ss * (1.0f / 64.0f) + EPSF);
#pragma unroll
      for (int i = 0; i < 8; ++i) o[i] = o[i] * rs * og[i] * siluf_(gg[i]);
      *(u32x4*)(Y + (size_t)(b * SEQ + c * 64 + r2) * 1024 + h * 64 + c82) = pack8(o);
    }
  }
  __syncthreads();
}

__device__ void ssd_seq(const Params& P, int layer, int item, unsigned char* smem) {
  int tid_ = threadIdx.x; asm volatile("" : "+v"(tid_));
  const int tid = tid_, wid = tid >> 6, lane = tid & 63, fr = lane & 15, fq = lane >> 4;
  const int b = item >> 2, h = item & 3, grp = h >> 1, r = lane, cg_ = wid, c8 = wid * 8;
  const int r2 = tid >> 3, cg2 = tid & 7, c82 = cg2 * 8;
  constexpr int RS = 200;
  bf16_t* RAW = (bf16_t*)smem;
  float* O32 = (float*)smem;
  float* CW = (float*)(smem + 27136);
  float* ACUM = (float*)(smem + 27136 + 3840);
  float* DTV = ACUM + 64;
  bf16_t* XS = (bf16_t*)(smem + 27136 + 3840 + 512);
  bf16_t* CM = XS + 64 * TS;
  bf16_t* BM = CM + 64 * TS;
  bf16_t* BMT = BM + 64 * TS;
  bf16_t* CS = BMT + 64 * TS;
  bf16_t* XDTT = CS + 64 * TS;
  bf16_t* XDECT = XDTT + 64 * TS;
  bf16_t* MS = XDECT + 64 * TS;
  bf16_t* STATE = MS + 64 * TS;
  const bf16_t* proj = (const bf16_t*)(P.ws + OFF_PROJ);
  const float* dtb = (const float*)(P.ws + OFF_SMALL + S_DT);
  u64* ssq = (u64*)(P.ws + OFF_SMALL + S_SSQ) + (size_t)layer * T_TOK * 2;
  bf16_t* Y = (bf16_t*)(P.ws + OFF_Y);
  if (tid < 192) {
    const int lc = tid; const int ch = lc < 64 ? h * 64 + lc : (lc < 128 ? 256 + grp * 64 + (lc - 64) : 384 + grp * 64 + (lc - 128));
    const float* w = P.in[6] + ((size_t)layer * 512 + ch) * 4;
    CW[0 * 192 + lc] = w[0]; CW[1 * 192 + lc] = w[1]; CW[2 * 192 + lc] = w[2]; CW[3 * 192 + lc] = w[3]; CW[4 * 192 + lc] = P.in[7][layer * 512 + ch];
  }
  for (int i = tid; i < 64 * TS; i += 512) STATE[i] = 0;
  const float dtbias = P.in[8][layer * 4 + h], aneg = -expf(P.in[9][layer * 4 + h]), dsk = P.in[10][layer * 4 + h];
  f32x4 sacc[2] = {(f32x4){0.f, 0.f, 0.f, 0.f}, (f32x4){0.f, 0.f, 0.f, 0.f}};
  __syncthreads();
  u32x4 rw[4], zr; float dtr = 0.f;
#define SSD_PREFETCH(cc) do { const int t0n = b * SEQ + (cc) * 64; \
    _Pragma("unroll") for (int i = 0; i < 4; ++i) { const int idx = tid + 512 * i; rw[i] = (u32x4){0u, 0u, 0u, 0u}; \
      if (idx < 67 * 24) { const int rr = idx / 24, pc = idx - rr * 24; \
        const int col = pc < 8 ? 1280 + h * 64 + pc * 8 : (pc < 16 ? 1536 + grp * 64 + (pc - 8) * 8 : 1664 + grp * 64 + (pc - 16) * 8); \
        if ((cc) > 0 || rr >= 3) rw[i] = *(const u32x4*)(proj + (size_t)(t0n - 3 + rr) * PW + col); } } \
    if (wid == 0) dtr = dtb[(size_t)(t0n + lane) * 4 + h]; \
    zr = *(const u32x4*)(proj + (size_t)(t0n + r2) * PW + 1024 + h * 64 + c82); } while (0)
  SSD_PREFETCH(0);
  for (int c = 0; c < NCH; ++c) {
    const int t0 = b * SEQ + c * 64;
#pragma unroll
    for (int i = 0; i < 4; ++i) { const int idx = tid + 512 * i; if (idx < 67 * 24) { const int rr = idx / 24, pc = idx - rr * 24; *(u32x4*)(RAW + rr * RS + pc * 8) = rw[i]; } }
    if (wid == 0) {
      const float x0 = dtr + dtbias;
      const float dt0 = x0 > 20.f ? x0 : log1pf(__expf(x0));
      float a0 = dt0 * aneg;
      a0 = wave_incl_scan(a0, lane);
      ACUM[lane] = a0; DTV[lane] = dt0;
    }
    const u32x4 zraw = zr;
    if (c + 1 < NCH) SSD_PREFETCH(c + 1);
    __syncthreads();
#pragma unroll
    for (int q3 = 0; q3 < 3; ++q3) {
      const int lc0 = cg_ * 24 + q3 * 8;
      float accv[8];
      { const f32x4 b0 = *(const f32x4*)(CW + 4 * 192 + lc0), b1 = *(const f32x4*)(CW + 4 * 192 + lc0 + 4);
#pragma unroll
        for (int i = 0; i < 4; ++i) { accv[i] = b0[i]; accv[4 + i] = b1[i]; } }
#pragma unroll
      for (int tap = 0; tap < 4; ++tap) {
        float xv[8]; unpack8(*(const u32x4*)(RAW + (r + tap) * RS + lc0), xv);
        const f32x4 w0 = *(const f32x4*)(CW + tap * 192 + lc0), w1 = *(const f32x4*)(CW + tap * 192 + lc0 + 4);
#pragma unroll
        for (int i = 0; i < 4; ++i) { accv[i] += xv[i] * w0[i]; accv[4 + i] += xv[4 + i] * w1[i]; }
      }
#pragma unroll
      for (int i = 0; i < 8; ++i) accv[i] = siluf_(accv[i]);
      if (lc0 < 64) { *(u32x4*)(XS + r * TS + lc0) = pack8(accv); }
      else if (lc0 < 128) { const int n0 = lc0 - 64; *(u32x4*)(BM + r * TS + n0) = pack8(accv);
#pragma unroll
        for (int i = 0; i < 8; ++i) BMT[(n0 + i) * TS + r] = f2bf(accv[i]); }
      else { const int n0 = lc0 - 128; *(u32x4*)(CM + r * TS + n0) = pack8(accv); }
    }
    __syncthreads();
    {
      float xs[8], cm[8], cs[8]; unpack8(*(const u32x4*)(XS + r * TS + c8), xs); unpack8(*(const u32x4*)(CM + r * TS + c8), cm);
      const float dtv = DTV[r], dec = __expf(ACUM[63] - ACUM[r]), ea = __expf(ACUM[r]);
#pragma unroll
      for (int i = 0; i < 8; ++i) { const float xd = xs[i] * dtv; XDTT[(c8 + i) * TS + r] = f2bf(xd); XDECT[(c8 + i) * TS + r] = f2bf(xd * dec); cs[i] = cm[i] * ea; }
      *(u32x4*)(CS + r * TS + c8) = pack8(cs);
    }
#pragma unroll
    for (int x = 0; x < 2; ++x) {
      const int tl = wid + 8 * x, lb = tl >> 2, sb = tl & 3;
      f32x4 gt = (f32x4){0.f, 0.f, 0.f, 0.f};
      if (sb <= lb) gt = mma64(CM + lb * 16 * TS, TS, BM + sb * 16 * TS, TS, gt, fr, fq);
#pragma unroll
      for (int jj = 0; jj < 4; ++jj) {
        const int l = lb * 16 + fq * 4 + jj, sidx = sb * 16 + fr;
        float v = 0.f;
        if (l >= sidx) v = gt[jj] * __expf(ACUM[l] - ACUM[sidx]);
        MS[l * TS + sidx] = f2bf(v);
      }
    }
    __syncthreads();
    f32x4 snew[2];
#pragma unroll
    for (int x = 0; x < 2; ++x) {
      const int lb = wid >> 1, pb = (wid & 1) * 2 + x;
      f32x4 a = (f32x4){0.f, 0.f, 0.f, 0.f};
      a = mma64(MS + lb * 16 * TS, TS, XDTT + pb * 16 * TS, TS, a, fr, fq);
      a = mma64(CS + lb * 16 * TS, TS, STATE + pb * 16 * TS, TS, a, fr, fq);
#pragma unroll
      for (int jj = 0; jj < 4; ++jj) O32[(lb * 16 + fq * 4 + jj) * 65 + pb * 16 + fr] = a[jj];
      const int nb = (wid & 1) * 2 + x;
      const float dchunk = __expf(ACUM[63]);
      f32x4 sv = sacc[x];
#pragma unroll
      for (int jj = 0; jj < 4; ++jj) sv[jj] *= dchunk;
      sv = mma64(XDECT + (wid >> 1) * 16 * TS, TS, BMT + nb * 16 * TS, TS, sv, fr, fq);
      sacc[x] = sv; snew[x] = sv;
    }
    __syncthreads();
#pragma unroll
    for (int x = 0; x < 2; ++x) {
      const int nb = (wid & 1) * 2 + x;
#pragma unroll
      for (int jj = 0; jj < 4; ++jj) STATE[((wid >> 1) * 16 + fq * 4 + jj) * TS + nb * 16 + fr] = f2bf(snew[x][jj]);
    }
    {
      const int t = t0 + r2;
      float zz[8], xs[8], y[8];
      unpack8(zraw, zz); unpack8(*(const u32x4*)(XS + r2 * TS + c82), xs);
      float ss = 0.f;
#pragma unroll
      for (int i = 0; i < 8; ++i) y[i] = (O32[r2 * 65 + c82 + i] + dsk * xs[i]) * siluf_(zz[i]);
      const u32x4 w = pack8(y);
      float yr[8]; unpack8(w, yr);
#pragma unroll
      for (int i = 0; i < 8; ++i) ss += yr[i] * yr[i];
      ss = sum8(ss);
      if (cg2 == 0) atomicAdd(ssq + (size_t)t * 2 + grp, (u64)(ss * RSQ_SCALE + 0.5f));
      *(u32x4*)(Y + (size_t)t * 1024 + 256 + h * 64 + c82) = w;
    }
    __syncthreads();
  }
#undef SSD_PREFETCH
}

__device__ void attn_item(const Params& P, int layer, int item, unsigned char* smem) {
  int tid_ = threadIdx.x; asm volatile("" : "+v"(tid_));
  const int tid = tid_, wid = tid >> 6, lane = tid & 63, fr = lane & 15, fq = lane >> 4;
  const int cp = item & 15, h = (item >> 4) & 3, b = item >> 6;
  const int wq = wid >> 2, qb = wid & 3, r = tid >> 3, c8 = (tid & 7) * 8;
  bf16_t* KH = (bf16_t*)smem;
  bf16_t* VTT = KH + 2 * 64 * TS;
  float* BIAS = (float*)(smem + 4 * 64 * TS * 2);
  const bf16_t* proj = (const bf16_t*)(P.ws + OFF_PROJ);
  bf16_t* Y = (bf16_t*)(P.ws + OFF_Y);
  __syncthreads();
  if (tid < 257) BIAS[tid] = P.in[23][((size_t)layer * 4 + h) * 257 + tid];
  const int c0 = cp * 2, cme = c0 + wq;
  const size_t tb = (size_t)b * SEQ;
  bf16x8 qf[2];
  {
    const bf16_t* qp = proj + (tb + cme * 64 + qb * 16 + fr) * PW + 1792 + h * 64;
    float a[8], c[8]; unpack8(*(const u32x4*)(qp + fq * 8), a); unpack8(*(const u32x4*)(qp + 32 + fq * 8), c);
    float ss = 0.f;
#pragma unroll
    for (int i = 0; i < 8; ++i) ss += a[i] * a[i] + c[i] * c[i];
    ss += __shfl_xor(ss, 16); ss += __shfl_xor(ss, 32);
    const float rs = rsqrtf(ss * (1.0f / 64.0f) + EPSF) * 0.125f;
    const float* qg = P.in[21] + layer * 64;
#pragma unroll
    for (int i = 0; i < 8; ++i) { a[i] *= rs * qg[fq * 8 + i]; c[i] *= rs * qg[32 + fq * 8 + i]; }
    u32x4 wa = pack8(a), wc_ = pack8(c);
    qf[0] = *(bf16x8*)&wa; qf[1] = *(bf16x8*)&wc_;
  }
  float kgn[8];
#pragma unroll
  for (int i = 0; i < 8; ++i) kgn[i] = P.in[22][layer * 64 + c8 + i];
  f32x4 oacc[4];
#pragma unroll
  for (int d = 0; d < 4; ++d) oacc[d] = (f32x4){0.f, 0.f, 0.f, 0.f};
  float mrun = -1e30f, lrun = 0.f;
  const int cs = c0 - 8 > 0 ? c0 - 8 : 0, ce = c0 + 1;
  u32x4 nk, nv;
  { const bf16_t* kp = proj + (tb + cs * 64 + r) * PW + 2048 + h * 64 + c8; nk = *(const u32x4*)kp; nv = *(const u32x4*)(kp + 256); }
  for (int cc = cs; cc <= ce; ++cc) {
    const int buf = (cc - cs) & 1;
    {
      float kv[8], vv[8]; unpack8(nk, kv); unpack8(nv, vv);
      float ss = 0.f;
#pragma unroll
      for (int i = 0; i < 8; ++i) ss += kv[i] * kv[i];
      ss = sum8(ss);
      const float rs = rsqrtf(ss * (1.0f / 64.0f) + EPSF);
#pragma unroll
      for (int i = 0; i < 8; ++i) kv[i] *= rs * kgn[i];
      *(u32x4*)(KH + buf * 64 * TS + r * TS + c8) = pack8(kv);
#pragma unroll
      for (int i = 0; i < 8; ++i) VTT[buf * 64 * TS + (c8 + i) * TS + r] = f2bf(vv[i]);
    }
    __syncthreads();
    if (cc < ce) { const bf16_t* kp = proj + (tb + (cc + 1) * 64 + r) * PW + 2048 + h * 64 + c8; nk = *(const u32x4*)kp; nv = *(const u32x4*)(kp + 256); }
    const int j = cc - (cme - 8);
    if (j >= 0 && j <= 8) {
      const bf16_t* Kb = KH + buf * 64 * TS; const bf16_t* Vb = VTT + buf * 64 * TS;
      f32x4 s[4];
#pragma unroll
      for (int kt = 0; kt < 4; ++kt) {
        s[kt] = (f32x4){0.f, 0.f, 0.f, 0.f};
#pragma unroll
        for (int ks = 0; ks < 2; ++ks) { const bf16x8 a = *(const bf16x8*)(Kb + (kt * 16 + fr) * TS + ks * 32 + fq * 8); s[kt] = mfma16(a, qf[ks], s[kt]); }
      }
      const int qpos = qb * 16 + fr;
      float bv[4][4];
      if (j <= 5) {
        const float bc = BIAS[256];
#pragma unroll
        for (int kt = 0; kt < 4; ++kt)
#pragma unroll
          for (int jj = 0; jj < 4; ++jj) bv[kt][jj] = bc;
      } else {
#pragma unroll
        for (int kt = 0; kt < 4; ++kt)
#pragma unroll
          for (int jj = 0; jj < 4; ++jj) {
            const int kpos = j * 64 + kt * 16 + fq * 4 + jj;
            int rel = qpos + 512 - kpos; rel = rel > 128 ? 128 : (rel < -128 ? -128 : rel);
            bv[kt][jj] = BIAS[rel + 128];
          }
      }
      float mx = -1e30f;
#pragma unroll
      for (int kt = 0; kt < 4; ++kt)
#pragma unroll
        for (int jj = 0; jj < 4; ++jj) { const float v = s[kt][jj] + bv[kt][jj]; s[kt][jj] = v; mx = fmaxf(mx, v); }
      mx = fmaxf(mx, __shfl_xor(mx, 16)); mx = fmaxf(mx, __shfl_xor(mx, 32));
      const float mnew = fmaxf(mrun, mx), alpha = __expf(mrun - mnew);
      mrun = mnew;
      float ps = 0.f;
#pragma unroll
      for (int kt = 0; kt < 4; ++kt)
#pragma unroll
        for (int jj = 0; jj < 4; ++jj) { const float p = __expf(s[kt][jj] - mnew); s[kt][jj] = p; ps += p; }
      lrun = lrun * alpha + ps;
      bf16x8 pb[2];
#pragma unroll
      for (int k2 = 0; k2 < 2; ++k2) {
        u32x4 w; w[0] = pk2(s[2 * k2][0], s[2 * k2][1]); w[1] = pk2(s[2 * k2][2], s[2 * k2][3]); w[2] = pk2(s[2 * k2 + 1][0], s[2 * k2 + 1][1]); w[3] = pk2(s[2 * k2 + 1][2], s[2 * k2 + 1][3]);
        pb[k2] = *(bf16x8*)&w;
      }
#pragma unroll
      for (int d = 0; d < 4; ++d) {
#pragma unroll
        for (int e = 0; e < 4; ++e) oacc[d][e] *= alpha;
#pragma unroll
        for (int k2 = 0; k2 < 2; ++k2) {
          const bf16_t* vp = Vb + (d * 16 + fr) * TS + k2 * 32 + fq * 4;
          const u32x2 lo = *(const u32x2*)vp, hi = *(const u32x2*)(vp + 16);
          u32x4 w; w[0] = lo[0]; w[1] = lo[1]; w[2] = hi[0]; w[3] = hi[1];
          oacc[d] = mfma16(*(bf16x8*)&w, pb[k2], oacc[d]);
        }
      }
    }
  }
  lrun += __shfl_xor(lrun, 16); lrun += __shfl_xor(lrun, 32);
  const float il = frcp(lrun);
  bf16_t* yp = Y + (tb + cme * 64 + qb * 16 + fr) * 1024 + 768 + h * 64;
#pragma unroll
  for (int d = 0; d < 4; ++d) {
    u32x2 w; w[0] = pk2(oacc[d][0] * il, oacc[d][1] * il); w[1] = pk2(oacc[d][2] * il, oacc[d][3] * il);
    *(u32x2*)(yp + d * 16 + fq * 4) = w;
  }
}

__device__ void toep_build(const Params& P, int layer, int item) {
  item = lsg(item); layer = lsg(layer);
  const int g = item >> 4, nb = item & 15;
  const float* __restrict__ KTb = (const float*)(P.ws + OFF_SMALL + S_KT) + (size_t)(layer * 16 + g) * 64 * 256;
  const float* __restrict__ lam = (const float*)(P.ws + OFF_SMALL + S_LAM) + (size_t)(layer * 16 + g) * 64 * 65 * 2;
  const float* __restrict__ Cre = P.in[16] + (size_t)(layer * 16 + g) * 16 * 64;
  const float* __restrict__ Cim = P.in[17] + (size_t)(layer * 16 + g) * 16 * 64;
  bf16_t* __restrict__ dst = (bf16_t*)(P.ws + OFF_TOEP) + (size_t)g * 1024 * UK;
  const int tid = ltid();
#pragma unroll 3
  for (int idx = tid; idx < 64 * 144; idx += 512) {
    const int n = nb * 64 + idx / 144, k0 = (idx % 144) * 8;
    const int t = n >> 4, i = n & 15;
    float v[8];
    if (k0 < 1024) {
      const int sidx = k0 >> 4, i2 = k0 & 15;
      if (t >= sidx) {
        const f32x4 a0 = *(const f32x4*)(KTb + ((t - sidx) * 16 + i) * 16 + i2), a1 = *(const f32x4*)(KTb + ((t - sidx) * 16 + i) * 16 + i2 + 4);
#pragma unroll
        for (int e = 0; e < 4; ++e) { v[e] = a0[e]; v[4 + e] = a1[e]; }
      } else {
#pragma unroll
        for (int e = 0; e < 8; ++e) v[e] = 0.f;
      }
    } else {
      const int kk0 = k0 - 1024, part = kk0 >> 6, p0 = kk0 & 63;
#pragma unroll
      for (int e = 0; e < 8; ++e) {
        const int p = p0 + e;
        const float lr = lam[(p * 65 + t + 1) * 2], li = lam[(p * 65 + t + 1) * 2 + 1];
        const float cr = Cre[i * 64 + p], ci = Cim[i * 64 + p];
        v[e] = part == 0 ? (cr * lr - ci * li) : -(cr * li + ci * lr);
      }
    }
    *(u32x4*)(dst + (size_t)n * UK + k0) = pack8(v);
  }
}

struct WDesc { const float* src; const float* scale; bf16_t* dst; int ld, K, n0, k0, sc, nv; };
DEVI WDesc wdesc(const Params& P, int layer, int tl) {
  unsigned char* W = P.ws + OFF_W;
  WDesc d; int x = tl; d.nv = 64;
  if (x < 1792) {
    const int nt64 = x >> 4, kt = x & 15, pn = nt64 >> 2, sub = nt64 & 3;
    int sc;
    if (pn < 4) sc = pn * 256 + sub * 64; else if (pn == 4) sc = 1024 + sub * 64; else if (pn < 7) sc = 1280 + (pn - 5) * 256 + sub * 64;
    else if (pn == 7) sc = 1796 + sub * 64; else if (pn < 11) sc = 2052 + (pn - 8) * 256 + sub * 64;
    else if (pn == 11) { sc = 1792; d.nv = sub == 0 ? 4 : 0; } else sc = 2820 + (pn - 12) * 256 + sub * 64;
    d.src = P.in[3] + (size_t)layer * 1024 * 6916; d.ld = 6916; d.K = 1024; d.dst = (bf16_t*)(W + W_IN); d.scale = P.in[2] + layer * 1024; d.n0 = nt64 * 64; d.k0 = kt * 64; d.sc = sc; return d;
  }
  x -= 1792;
  if (x < 256) { const int m = x >> 6, y = x & 63, nt = y >> 2, kt = y & 3;
    d.src = P.in[24] + ((size_t)layer * 4 + m) * 256 * 1024; d.ld = 1024; d.K = 256; d.dst = (bf16_t*)(W + W_BR) + (size_t)m * 1024 * 256; d.scale = m == 1 ? P.in[11] + layer * 256 : nullptr; d.n0 = nt * 64; d.k0 = kt * 64; d.sc = nt * 64; return d; }
  x -= 256;
  if (x < 256) { const int nt = x >> 4, kt = x & 15;
    d.src = P.in[25] + (size_t)layer * 1024 * 1024; d.ld = 1024; d.K = 1024; d.dst = (bf16_t*)(W + W_OUT); d.scale = nullptr; d.n0 = nt * 64; d.k0 = kt * 64; d.sc = nt * 64; return d; }
  x -= 256;
  if (x < 1024) { const int nt = x >> 4, kt = x & 15;
    d.src = P.in[27] + (size_t)layer * 1024 * 4096; d.ld = 4096; d.K = 1024; d.dst = (bf16_t*)(W + W_FF1); d.scale = P.in[26] + layer * 1024; d.n0 = nt * 64; d.k0 = kt * 64; d.sc = nt * 64; return d; }
  x -= 1024;
  if (x < 1024) { const int nt = x >> 6, kt = x & 63;
    d.src = P.in[28] + (size_t)layer * 4096 * 1024; d.ld = 1024; d.K = 4096; d.dst = (bf16_t*)(W + W_FF2); d.scale = nullptr; d.n0 = nt * 64; d.k0 = kt * 64; d.sc = nt * 64; return d; }
  x -= 1024;
  if (x < 64) { const int nt = x >> 2, kt = x & 3;
    d.src = P.in[29] + (size_t)layer * 256 * 1024; d.ld = 1024; d.K = 256; d.dst = (bf16_t*)(W + W_PLE); d.scale = nullptr; d.n0 = nt * 64; d.k0 = kt * 64; d.sc = nt * 64; return d; }
  x -= 64;
  if (x < 256) { const int nt = x >> 4, kt = x & 15;
    d.src = P.in[31] + (size_t)layer * 1024 * 1024; d.ld = 1024; d.K = 1024; d.dst = (bf16_t*)(W + W_PG + (size_t)layer * 2 * MiB); d.scale = P.in[30] + layer * 1024; d.n0 = nt * 64; d.k0 = kt * 64; d.sc = nt * 64; return d; }
  x -= 256;
  { const int nt = x >> 2, kt = x & 3;
    d.src = P.in[20] + (size_t)layer * 256 * 256; d.ld = 256; d.K = 256; d.dst = (bf16_t*)(W + W_GLU); d.scale = nullptr; d.n0 = nt * 64; d.k0 = kt * 64; d.sc = nt * 64; return d; }
}
DEVI void wload(const WDesc& d, int tid, float* v) {
#pragma unroll
  for (int i = 0; i < 8; ++i) {
    const int idx = tid + 512 * i, kk = idx >> 6, nn = idx & 63;
    float x = 0.f;
    if (nn < d.nv) { x = d.src[(size_t)(d.k0 + kk) * d.ld + d.sc + nn]; if (d.scale) x *= d.scale[d.k0 + kk]; }
    v[i] = x;
  }
}
__device__ void prep_layer(const Params& P, int layer, unsigned char* smem) {
  layer = lsg(layer);
  float* tile = (float*)smem;
  const int tid = ltid(), G = gridDim.x;
  float cur[8], nxt[8];
  int tl = lbid();
  WDesc dc{};
  if (tl < 4688) { dc = wdesc(P, layer, tl); wload(dc, tid, cur); }
  for (; tl < 4688; tl += G) {
    WDesc dn{}; const bool has = tl + G < 4688;
    if (has) { dn = wdesc(P, layer, tl + G); wload(dn, tid, nxt); }
    __syncthreads();
#pragma unroll
    for (int i = 0; i < 8; ++i) { const int idx = tid + 512 * i, kk = idx >> 6, nn = idx & 63; tile[kk * 65 + nn] = cur[i]; }
    __syncthreads();
#pragma unroll
    for (int i = 0; i < 4; ++i) {
      const int idx = tid + 512 * i, nn = idx >> 5, kp = (idx & 31) * 2;
      *(unsigned*)(dc.dst + (size_t)(dc.n0 + nn) * dc.K + dc.k0 + kp) = pk2(tile[kp * 65 + nn], tile[(kp + 1) * 65 + nn]);
    }
    if (has) {
#pragma unroll
      for (int i = 0; i < 8; ++i) cur[i] = nxt[i];
      dc = dn;
    }
  }
  const float* __restrict__ lamL = (const float*)(P.ws + OFF_SMALL + S_LAM) + (size_t)layer * 16 * 64 * 65 * 2;
  const float* __restrict__ bbL = (const float*)(P.ws + OFF_SMALL + S_BB) + (size_t)layer * 16 * 64 * 16 * 2;
  bf16_t* __restrict__ mint = (bf16_t*)(P.ws + OFF_MINT);
#pragma unroll 4
  for (size_t idx = (size_t)lbid() * 512 + ltid(); idx < (size_t)16 * 256 * 512; idx += (size_t)gridDim.x * 512) {
    const int k0 = (int)(idx & 511) * 2, n = (int)(idx >> 9) & 255, g = (int)(idx >> 17);
    float v[2] = {0.f, 0.f};
    if (n < 128) {
      const int p = n & 63;
#pragma unroll
      for (int e = 0; e < 2; ++e) {
        const int k = k0 + e, s = k >> 4, i2 = k & 15;
        const float lr = lamL[((size_t)(g * 64 + p) * 65 + (63 - s)) * 2], li = lamL[((size_t)(g * 64 + p) * 65 + (63 - s)) * 2 + 1];
        const float br = bbL[((size_t)(g * 64 + p) * 16 + i2) * 2], bi = bbL[((size_t)(g * 64 + p) * 16 + i2) * 2 + 1];
        v[e] = n < 64 ? (lr * br - li * bi) : (lr * bi + li * br);
      }
    }
    *(unsigned*)(mint + ((size_t)(g * 256 + n) * 1024 + k0)) = pk2(v[0], v[1]);
  }
}

__device__ void merge_phase(const Params& P, int layer, unsigned char* smem) {
  int tid_ = threadIdx.x; asm volatile("" : "+v"(tid_));
  const int tid = tid_, wid = tid >> 6, lane = tid & 63, fr = lane & 15, fq = lane >> 4, wr = wid >> 2, wc = wid & 3;
  constexpr int LS = 136, BUFE = 2 * 128 * LS;
  bf16_t* L0 = (bf16_t*)smem;
  const bf16_t* Y = (const bf16_t*)(P.ws + OFF_Y);
  const bf16_t* Wb = (const bf16_t*)(P.ws + OFF_W + W_BR);
  const unsigned char* gates = P.ws + OFF_GATES;
  bf16_t* merged = (bf16_t*)(P.ws + OFF_MERGED);
  const int cid = lbid(), G = gridDim.x;
  const int ntile = (2048 - cid + G - 1) / G, total = ntile * 8;
  const u64* ssq = (const u64*)(P.ws + OFF_SMALL + S_SSQ) + (size_t)lsg(layer) * T_TOK * 2;
  u32x4 pa0[4], pa1[4], pbx[4];
  unsigned gw[4][2];
  float rc0[4], rc1[4];
  f32x4 mg[4][2], acc[4][2];
#pragma unroll
  for (int a = 0; a < 4; ++a)
#pragma unroll
    for (int n = 0; n < 2; ++n) { mg[a][n] = (f32x4){0.f, 0.f, 0.f, 0.f}; acc[a][n] = (f32x4){0.f, 0.f, 0.f, 0.f}; }
#define MG_LOADA(g_, pa) do { const int gc_ = (g_) < total ? (g_) : total - 1; \
    const int tile_ = cid + (gc_ >> 3) * G, s_ = gc_ & 7, m_ = s_ >> 1, kh_ = s_ & 1, r0_ = (tile_ >> 3) * 128; \
    _Pragma("unroll") for (int i = 0; i < 4; ++i) { const int idx = tid + 512 * i, rr = idx >> 4, pc = idx & 15; \
      pa[i] = *(const u32x4*)(Y + (size_t)(r0_ + rr) * 1024 + m_ * 256 + kh_ * 128 + pc * 8); } } while (0)
#define MG_LOADB(g_, pb) do { const int gc_ = (g_) < total ? (g_) : total - 1; \
    const int tile_ = cid + (gc_ >> 3) * G, s_ = gc_ & 7, m_ = s_ >> 1, kh_ = s_ & 1, c0_ = (tile_ & 7) * 128; \
    _Pragma("unroll") for (int i = 0; i < 4; ++i) { const int idx = tid + 512 * i, rr = idx >> 4, pc = idx & 15; \
      pb[i] = *(const u32x4*)(Wb + ((size_t)m_ * 1024 + c0_ + rr) * 256 + kh_ * 128 + pc * 8); } } while (0)
#define MG_LOADG(g_, gq, r0v, r1v) do { const int gc_ = (g_) < total ? (g_) : total - 2; \
    const int tile_ = cid + (gc_ >> 3) * G, m_ = (gc_ & 7) >> 1, r0_ = (tile_ >> 3) * 128, c0_ = (tile_ & 7) * 128; \
    _Pragma("unroll") for (int a = 0; a < 4; ++a) { const int row_ = r0_ + wr * 64 + a * 16 + fr; \
      _Pragma("unroll") for (int n = 0; n < 2; ++n) gq[a][n] = *(const unsigned*)(gates + (size_t)row_ * 4096 + m_ * 1024 + c0_ + wc * 32 + n * 16 + fq * 4); \
      r0v[a] = (float)ssq[(size_t)row_ * 2]; r1v[a] = (float)ssq[(size_t)row_ * 2 + 1]; } } while (0)
#define MG_STORE(buf_, pa, pb) do { bf16_t* A_ = L0 + (buf_) * BUFE; bf16_t* B_ = A_ + 128 * LS; \
    _Pragma("unroll") for (int i = 0; i < 4; ++i) { const int idx = tid + 512 * i, rr = idx >> 4, pc = idx & 15; \
      *(u32x4*)(A_ + rr * LS + pc * 8) = pa[i]; *(u32x4*)(B_ + rr * LS + pc * 8) = pb[i]; } } while (0)
#define MG_COMPUTE(buf) do { const bf16_t* As = L0 + (buf) * BUFE; const bf16_t* Bs = As + 128 * LS; \
    _Pragma("unroll") for (int k = 0; k < 4; ++k) { \
      bf16x8 af[4], bfr[2]; \
      _Pragma("unroll") for (int a = 0; a < 4; ++a) af[a] = *(const bf16x8*)(As + (wr * 64 + a * 16 + fr) * LS + k * 32 + fq * 8); \
      _Pragma("unroll") for (int n = 0; n < 2; ++n) bfr[n] = *(const bf16x8*)(Bs + (wc * 32 + n * 16 + fr) * LS + k * 32 + fq * 8); \
      _Pragma("unroll") for (int a = 0; a < 4; ++a) _Pragma("unroll") for (int n = 0; n < 2; ++n) acc[a][n] = mfma16(bfr[n], af[a], acc[a][n]); } } while (0)
#define MG_GATE(rv, isb) do { \
    _Pragma("unroll") for (int a = 0; a < 4; ++a) { \
      const float rsq_ = rsqrtf(rv[a] * (1.0f / (16777216.0f * 128.0f)) + EPSF) * (1.0f / 255.0f); \
      const float rs1 = (isb) ? rsq_ : (1.0f / 255.0f); \
      _Pragma("unroll") for (int n = 0; n < 2; ++n) { \
        _Pragma("unroll") for (int e = 0; e < 4; ++e) mg[a][n][e] += acc[a][n][e] * ((float)((gw[a][n] >> (8 * e)) & 255u) * rs1); \
        acc[a][n] = (f32x4){0.f, 0.f, 0.f, 0.f}; } } } while (0)
  MG_LOADA(0, pa0); MG_LOADB(0, pbx); MG_LOADG(0, gw, rc0, rc1);
  MG_STORE(0, pa0, pbx);
  MG_LOADA(1, pa1);
  __syncthreads();
  for (int g = 0; g < total; g += 2) {
    const int tile = cid + (g >> 3) * G, s = g & 7, m = s >> 1, row0 = (tile >> 3) * 128, col0 = (tile & 7) * 128;
    const bool isb = (m == 1);
    MG_LOADB(g + 1, pbx); MG_LOADA(g + 2, pa0);
    MG_COMPUTE(0);
    MG_GATE(rc0, isb);
    MG_STORE(1, pa1, pbx);
    __syncthreads();
    MG_LOADB(g + 2, pbx); MG_LOADA(g + 3, pa1);
    MG_COMPUTE(1);
    MG_GATE(rc1, isb);
    if (s == 6) {
#pragma unroll
      for (int a = 0; a < 4; ++a) {
        const int row = row0 + wr * 64 + a * 16 + fr;
#pragma unroll
        for (int n = 0; n < 2; ++n) {
          u32x2 w; w[0] = pk2(mg[a][n][0], mg[a][n][1]); w[1] = pk2(mg[a][n][2], mg[a][n][3]);
          *(u32x2*)(merged + (size_t)row * 1024 + col0 + wc * 32 + n * 16 + fq * 4) = w;
          mg[a][n] = (f32x4){0.f, 0.f, 0.f, 0.f};
        }
      }
    }
    MG_LOADG(g + 2, gw, rc0, rc1);
    MG_STORE(0, pa0, pbx);
    __syncthreads();
  }
#undef MG_LOADA
#undef MG_LOADB
#undef MG_LOADG
#undef MG_STORE
#undef MG_COMPUTE
#undef MG_GATE
}

__device__ void prep_global_a(const Params& P) {
  const int tid = ltid(), wid = tid >> 6, lane = tid & 63;
  u64* __restrict__ rowsq = (u64*)(P.ws + OFF_SMALL + S_ROWSQ);
  bf16_t* __restrict__ xb = (bf16_t*)(P.ws + OFF_XB);
  const float* __restrict__ x = P.in[0];
#pragma unroll 2
  for (int row = lbid() * 8 + wid; row < T_TOK; row += gridDim.x * 8) {
    float ss = 0.f;
#pragma unroll
    for (int i = 0; i < 2; ++i) {
      const size_t o = (size_t)row * 1024 + i * 512 + lane * 8;
      const f32x4 a = *(const f32x4*)(x + o), c = *(const f32x4*)(x + o + 4);
      u32x4 w; w[0] = pk2(a[0], a[1]); w[1] = pk2(a[2], a[3]); w[2] = pk2(c[0], c[1]); w[3] = pk2(c[2], c[3]);
      *(u32x4*)(xb + o) = w;
#pragma unroll
      for (int e = 0; e < 4; ++e) ss += a[e] * a[e] + c[e] * c[e];
    }
#pragma unroll
    for (int d = 1; d < 64; d <<= 1) ss += __shfl_xor(ss, d);
    if (lane == 0) rowsq[row] = (u64)(ss * RSQ_SCALE + 0.5f);
  }
  const size_t gt = (size_t)lbid() * 512 + tid, gn = (size_t)gridDim.x * 512;
  for (size_t i = gt; i < (size_t)6 * T_TOK; i += gn) rowsq[T_TOK + i] = 0ull;
  { u64* ssqz = (u64*)(P.ws + OFF_SMALL + S_SSQ); for (size_t i = gt; i < (size_t)4 * T_TOK; i += gn) ssqz[i] = 0ull; }
  int* ctr = (int*)(P.ws + OFF_SMALL + S_CTR);
  if (lbid() == 0 && tid < 64) ctr[tid] = 0;
  float* lam = (float*)(P.ws + OFF_SMALL + S_LAM);
  float* bb = (float*)(P.ws + OFF_SMALL + S_BB);
  for (size_t i = gt; i < (size_t)2 * 16 * 64 * 65; i += gn) {
    const int tau = (int)(i % 65), gp = (int)(i / 65), L = gp >> 10, g = (gp >> 6) & 15;
    const double are = (double)P.in[12][gp], aim = (double)P.in[13][gp], step = exp((double)P.in[19][L * 16 + g]);
    const double mag = exp(are * step * (double)tau), ang = aim * step * (double)tau;
    lam[i * 2] = (float)(mag * cos(ang)); lam[i * 2 + 1] = (float)(mag * sin(ang));
  }
  for (size_t i = gt; i < (size_t)2 * 16 * 64 * 16; i += gn) {
    const int gp = (int)(i >> 4), L = gp >> 10, g = (gp >> 6) & 15;
    const double are = (double)P.in[12][gp], aim = (double)P.in[13][gp], step = exp((double)P.in[19][L * 16 + g]);
    const double mag = exp(are * step), lr = mag * cos(aim * step), li = mag * sin(aim * step);
    const double den = are * are + aim * aim, nr = lr - 1.0;
    const double cr = (nr * are + li * aim) / den, ci = (li * are - nr * aim) / den;
    const double br = (double)P.in[14][i], bi = (double)P.in[15][i];
    bb[i * 2] = (float)(cr * br - ci * bi); bb[i * 2 + 1] = (float)(cr * bi + ci * br);
  }
}
__device__ void prep_global_b(const Params& P) {
  const float* lam = (const float*)(P.ws + OFF_SMALL + S_LAM);
  const float* bb = (const float*)(P.ws + OFF_SMALL + S_BB);
  float* KT = (float*)(P.ws + OFF_SMALL + S_KT);
  for (size_t idx = (size_t)lbid() * 512 + ltid(); idx < (size_t)2 * 16 * 64 * 256; idx += (size_t)gridDim.x * 512) {
    const int i2 = (int)(idx & 15), i = (int)(idx >> 4) & 15, tau = (int)(idx >> 8) & 63, Lg = (int)(idx >> 14);
    const float* cre = P.in[16] + ((size_t)Lg * 16 + i) * 64; const float* cim = P.in[17] + ((size_t)Lg * 16 + i) * 64;
    float acc = 0.f;
    for (int p = 0; p < 64; ++p) {
      const float lr = lam[((size_t)(Lg * 64 + p) * 65 + tau) * 2], li = lam[((size_t)(Lg * 64 + p) * 65 + tau) * 2 + 1];
      const float br = bb[((size_t)(Lg * 64 + p) * 16 + i2) * 2], bi = bb[((size_t)(Lg * 64 + p) * 16 + i2) * 2 + 1];
      const float xr = lr * br - li * bi, xi = lr * bi + li * br;
      acc += cre[p] * xr - cim[p] * xi;
    }
    KT[idx] = acc;
  }
}
__device__ void convert_p(const Params& P, int layer) {
  layer = lsg(layer);
  const float* __restrict__ src = P.in[1] + (size_t)layer * T_TOK * 256;
  bf16_t* __restrict__ dst = (bf16_t*)(P.ws + OFF_PB);
#pragma unroll 4
  for (size_t i = ((size_t)lbid() * 512 + ltid()) * 8; i < (size_t)T_TOK * 256; i += (size_t)gridDim.x * 512 * 8) {
    const f32x4 a = *(const f32x4*)(src + i), c = *(const f32x4*)(src + i + 4);
    u32x4 w; w[0] = pk2(a[0], a[1]); w[1] = pk2(a[2], a[3]); w[2] = pk2(c[0], c[1]); w[3] = pk2(c[2], c[3]);
    *(u32x4*)(dst + i) = w;
  }
}


#define XB_TMO      128
#define XB_XCNT(j)  (256  + 64 * (j))
#define XB_XSUB(j)  (1280 + 64 * (j))
#define XB_XGEN(j)  (2304 + 64 * (j))
#define XB_TOP      3328
#define XB_TOPGEN   3392
#define XCD_BAR_WORDS 3456
#define XB_SPIN_CAP (1u << 18)
DEVI unsigned xb_ld(unsigned* p) { return __hip_atomic_load(p, __ATOMIC_RELAXED, __HIP_MEMORY_SCOPE_AGENT); }
DEVI unsigned xb_add(unsigned* p, unsigned v) { return __hip_atomic_fetch_add(p, v, __ATOMIC_RELAXED, __HIP_MEMORY_SCOPE_AGENT); }
DEVI unsigned xb_xcc_id() { return (unsigned)__builtin_amdgcn_s_getreg((3 << 11) | 20) & 0xFu; }
#define XB_SPIN(cond, bar) do { unsigned _sp = 0; while (cond) { __builtin_amdgcn_s_sleep(1); \
    if ((++_sp & 255u) == 0u) { if (xb_ld(&(bar)[XB_TMO])) break; if (_sp > XB_SPIN_CAP) { atomicAdd(&(bar)[XB_TMO], 1u); break; } } } } while (0)
struct XcdBarrier { unsigned* bar; unsigned x; volatile LAS unsigned* st; };
DEVI XcdBarrier xcd_barrier_post(unsigned* bar, volatile LAS unsigned* st) {
  XcdBarrier b; b.bar = bar; b.x = xb_xcc_id(); b.st = st;
  if (threadIdx.x == 0) (void)xb_add(&bar[XB_XCNT(b.x)], 1u);
  return b;
}
DEVI void xcd_barrier_complete(unsigned* bar, unsigned x, unsigned& nloc, unsigned& nx) {
  const unsigned G = gridDim.x * gridDim.y * gridDim.z;
  unsigned sum, cnt, mine, sp = 0u;
  for (;;) {
    sum = 0u; cnt = 0u; mine = 0u;
#pragma unroll
    for (unsigned j = 0; j < 16; ++j) { const unsigned c = xb_ld(&bar[XB_XCNT(j)]); sum += c; cnt += (c > 0u) ? 1u : 0u; mine = (j == x) ? c : mine; }
    if (sum == G) break;
    __builtin_amdgcn_s_sleep(1);
    if ((++sp & 255u) == 0u) { if (xb_ld(&bar[XB_TMO])) break; if (sp > XB_SPIN_CAP) { atomicAdd(&bar[XB_TMO], 1u); break; } }
  }
  nloc = mine > 0u ? mine : 1u; nx = cnt > 0u ? cnt : 1u;
}
DEVI void xcd_barrier(unsigned* bar_, volatile LAS unsigned* st_) {
  XcdBarrier b; b.bar = bar_; b.st = st_; b.x = xb_xcc_id();
  asm volatile("s_waitcnt vmcnt(0)" ::: "memory");
  __syncthreads();
  if (ltid() == 0) {
    unsigned* bar = b.bar;
    __builtin_amdgcn_s_waitcnt(0);
    unsigned nloc = b.st[0], nx = b.st[1];
    if (nloc == 0u) { xcd_barrier_complete(bar, b.x, nloc, nx); b.st[0] = nloc; b.st[1] = nx; }
    const unsigned old = xb_add(&bar[XB_XSUB(b.x)], 1u);
    const unsigned gen = old / nloc;
    if (old + 1u == (gen + 1u) * nloc) {
      __builtin_amdgcn_fence(__ATOMIC_RELEASE, "agent");
      asm volatile("s_waitcnt vmcnt(0)" ::: "memory");
      const unsigned og = xb_add(&bar[XB_TOP], 1u);
      const unsigned tg = og / nx;
      if (og + 1u == (tg + 1u) * nx) xb_add(&bar[XB_TOPGEN], 1u);
      else XB_SPIN(xb_ld(&bar[XB_TOPGEN]) == tg, bar);
      __builtin_amdgcn_fence(__ATOMIC_ACQUIRE, "agent");
      xb_add(&bar[XB_XGEN(b.x)], 1u);
      asm volatile("s_waitcnt vmcnt(0)" ::: "memory");
    } else {
      XB_SPIN(xb_ld(&bar[XB_XGEN(b.x)]) == gen, bar);
      __builtin_amdgcn_fence(__ATOMIC_ACQUIRE, "agent");
      asm volatile("s_waitcnt vmcnt(0)" ::: "memory");
    }
  }
  __syncthreads();
}

#ifdef PROBE_A
#define TS(k) do { if (cid == 0 && ltid() == 0) ((unsigned long long*)(lptr(P.ws) + OFF_SMALL + S_BAR + 16384))[(k)] = __builtin_amdgcn_s_memrealtime(); } while (0)
#else
#define TS(k) do {} while (0)
#endif
template <int MODE>
__global__ void __launch_bounds__(512) mega(Params P) {
  extern __shared__ __attribute__((aligned(16))) unsigned char smem[];
  cg::grid_group grid = cg::this_grid();
  (void)grid;
  LAS unsigned char* lds = (LAS unsigned char*)smem;
  int* qslot = (int*)(smem + LDS_BYTES - 16);
#define PHASE_PTRS unsigned char* ws = lptr(P.ws); u64* rowsq = (u64*)(ws + OFF_SMALL + S_ROWSQ); bf16_t* xb = (bf16_t*)(ws + OFF_XB); (void)rowsq; (void)xb;
  const int G = gridDim.x, cid = lbid();

  {
    volatile LAS unsigned* stw = (volatile LAS unsigned*)(lds + LDS_BYTES - 64);
    if (threadIdx.x < 4) stw[threadIdx.x] = 0u;
    unsigned* barw = (unsigned*)(P.ws + OFF_SMALL + S_BAR);
    if (cid == 0) for (int i = threadIdx.x; i < XCD_BAR_WORDS; i += 512) barw[i] = 0u;
  }
  TS(0);
  if (MODE == 0 || MODE == 10) prep_global_a(P);
  if (MODE == 0) grid.sync();
  TS(1);
  if (MODE == 0) (void)xcd_barrier_post((unsigned*)(P.ws + OFF_SMALL + S_BAR), (volatile LAS unsigned*)(lds + LDS_BYTES - 64));
#define GRID_BAR() if (MODE == 0) xcd_barrier((unsigned*)(lptr(P.ws) + OFF_SMALL + S_BAR), (volatile LAS unsigned*)(lds + LDS_BYTES - 64))
  if (MODE == 0 || MODE == 10) { prep_global_b(P); prep_layer(P, lsg(0), smem); }
  GRID_BAR();
  TS(2);

#pragma unroll 1
  for (int layer = (MODE == 0 ? 0 : 1); layer < 2; ++layer) {
    if (MODE == 0 || MODE == 1)
    for (int rep = 0; rep < REP_A; ++rep) {
      PHASE_PTRS
      Gemm g{layer == 0 ? xb : (const bf16_t*)(ws + OFF_Y), (const bf16_t*)(ws + OFF_W + W_IN), 1024, 1024, 1024, 0, 0};
      pg8::StaticOrder S; S.init(128, 28, G, cid);
      EpiG1 E{rowsq + (size_t)(3 * layer) * T_TOK, (bf16_t*)(ws + OFF_PROJ), (bf16_t*)(ws + OFF_U), (float*)(ws + OFF_SMALL + S_DT), ws + OFF_GATES};
      pg8::gemm_phase(lds, g, S, E);
    }
    GRID_BAR();
    TS(2 + 10 * layer + 1);
    if (MODE == 21) for (int it = cid; it < 64; it += G) ssd_seq(P, layer, it, smem);
    if (MODE == 22) for (int it = cid; it < 64; it += G) hgrn2_seq(P, layer, it, smem);
    if (MODE == 23) for (int it = cid; it < 1024; it += G) attn_item(P, layer, it, smem);
    if (MODE == 0 || MODE == 2)
    {
      PHASE_PTRS
      int* q = (int*)(ws + OFF_SMALL + S_CTR) + layer * 8 + (MODE == 0 ? 0 : 32);
      int* cS5 = q + 1; int* cBuild = q + 2; int* cToep = q + 3;
      for (;;) {
        const int it = qpop(q, qslot);
        if (it >= 1696) break;
        if (it < 64) ssd_seq(P, layer, it, smem);
        else if (it < 128) hgrn2_seq(P, layer, it - 64, smem);
        else if (it < 160) {
          const int x = it - 128;
          Gemm g{(const bf16_t*)(ws + OFF_U), (const bf16_t*)(ws + OFF_MINT), UK, 1024, 1024, (size_t)512 * UK * 2, (size_t)256 * 1024 * 2};
          pg8::OneUnit S; S.u = Unit{x & 1, 0, x >> 1};
          EpiS5in E{(bf16_t*)(ws + OFF_U), (const float*)(ws + OFF_SMALL + S_LAM) + (size_t)layer * 16 * 64 * 65 * 2};
          pg8::gemm_phase(lds, g, S, E);
          dep_publish(cS5);
        }
        else if (it < 416) { toep_build(P, layer, it - 160); dep_publish(cBuild); }
        else if (it < 928) attn_item(P, layer, it - 416, smem);
        else if (it < 1056) {
          const int x = it - 928;
          dep_wait(cS5, 32); dep_wait(cBuild, 256);
          Gemm g{(const bf16_t*)(ws + OFF_U), (const bf16_t*)(ws + OFF_TOEP), UK, UK, UK, (size_t)512 * UK * 2, (size_t)1024 * UK * 2};
          pg8::OneUnit S; S.u = Unit{(x >> 2) & 1, x & 3, x >> 3};
          EpiToep E{(const bf16_t*)(ws + OFF_U), P.in[18] + layer * 256, (bf16_t*)(ws + OFF_Y)};
          pg8::gemm_phase(lds, g, S, E);
          dep_publish(cToep);
        }
        else if (it < 1568) attn_item(P, layer, it - 1056 + 512, smem);
        else {
          const int x = it - 1568;
          dep_wait(cToep, 128);
          Gemm g{(const bf16_t*)(ws + OFF_Y) + 512, (const bf16_t*)(ws + OFF_W + W_GLU), 1024, 256, 256, 0, 0};
          pg8::OneUnit S; S.u = Unit{x, 0, 0};
          EpiGLU E{(bf16_t*)(ws + OFF_Y)};
          pg8::gemm_phase(lds, g, S, E);
        }
      }
    }
    GRID_BAR();
    TS(2 + 10 * layer + 2);
    if (MODE == 0 || MODE == 5)
    for (int rep = 0; rep < REP_C; ++rep) merge_phase(P, layer, smem);
    GRID_BAR();
    TS(2 + 10 * layer + 5);
    if (MODE == 0 || MODE == 6) {
    convert_p(P, layer);
    {
      PHASE_PTRS
      Gemm g{(const bf16_t*)(ws + OFF_MERGED), (const bf16_t*)(ws + OFF_W + W_OUT), 1024, 1024, 1024, 0, 0};
      pg8::StaticOrder S; S.init(128, 4, G, cid);
      EpiRes<true> E{layer == 0 ? P.in[0] : P.out, xb, rowsq + (size_t)(3 * layer + 1) * T_TOK};
      pg8::gemm_phase(lds, g, S, E);
    }
    }
    GRID_BAR();
    TS(2 + 10 * layer + 6);
    if (MODE == 0 || MODE == 7) {
    for (int rep = 0; rep < REP_E; ++rep) {
      PHASE_PTRS
      Gemm g{xb, (const bf16_t*)(ws + OFF_W + W_FF1), 1024, 1024, 1024, 0, 0};
      pg8::StaticOrder S; S.init(128, 16, G, cid);
      EpiFF1 E{rowsq + (size_t)(3 * layer + 1) * T_TOK, (bf16_t*)(ws + OFF_HID)};
      pg8::gemm_phase(lds, g, S, E);
    }
    {
      PHASE_PTRS
      Gemm g{(const bf16_t*)(ws + OFF_PB), (const bf16_t*)(ws + OFF_W + W_PLE), 256, 256, 256, 0, 0};
      pg8::StaticOrder S; S.init(128, 4, G, cid);
      EpiPle E{(bf16_t*)(ws + OFF_PLE)};
      pg8::gemm_phase(lds, g, S, E);
    }
    }
    GRID_BAR();
    TS(2 + 10 * layer + 7);
    if (MODE == 0 || MODE == 8)
    {
      PHASE_PTRS
      Gemm g{(const bf16_t*)(ws + OFF_HID), (const bf16_t*)(ws + OFF_W + W_FF2), 4096, 4096, 4096, 0, 0};
      pg8::StaticOrder S; S.init(128, 4, G, cid);
      EpiRes<false> E{nullptr, xb, rowsq + (size_t)(3 * layer + 2) * T_TOK};
      pg8::gemm_phase(lds, g, S, E);
    }
    GRID_BAR();
    TS(2 + 10 * layer + 8);
    if (MODE == 0 || MODE == 9) {
    {
      PHASE_PTRS
      Gemm g{xb, (const bf16_t*)(ws + OFF_W + W_PG + (size_t)layer * 2 * MiB), 1024, 1024, 1024, 0, 0};
      pg8::StaticOrder S; S.init(128, 4, G, cid);
      EpiPG E{rowsq + (size_t)(3 * layer + 2) * T_TOK, (const bf16_t*)(ws + OFF_PLE), xb, P.out, (bf16_t*)(ws + OFF_Y), rowsq + (size_t)(3 * layer + 3) * T_TOK, layer == 1};
      pg8::gemm_phase(lds, g, S, E);
    }
    }
    if (MODE == 0 && layer == 0) { __syncthreads(); prep_layer(P, lsg(1), smem); }
    if (MODE == 11) prep_layer(P, lsg(1), smem);
    GRID_BAR();
    TS(2 + 10 * layer + 9);
  }
#ifdef PROBE_A
  __threadfence(); __syncthreads();
  if (cid == 0) {
    const unsigned long long* ts = (const unsigned long long*)(lptr(P.ws) + OFF_SMALL + S_BAR + 16384);
    auto dur = [&](int k) -> float {
      if (k == 99) return (float)(ts[21] - ts[0]) * 0.01f;
      if (k <= 2) return (float)(ts[k] - ts[k - 1]) * 0.01f;
      const int j = k - 2; float d = 0.f;
      for (int L = 0; L < 2; ++L) { const int hi = 2 + 10 * L + j, lo = (j == 1) ? (L == 0 ? 2 : 11) : hi - 1; d += (float)(ts[hi] - ts[lo]) * 0.01f; }
      return d; };
    const float dA = dur(PROBE_A), dB = dur(PROBE_B);
    if (ltid() == 0) P.out[0] += dA;
    for (int i = ltid(); i < (1 << 20); i += 512) P.out[1024 + i] += 0.01f * dB;
  }
#endif
}

extern "C" void kernel_launch(void* const* d_in, const int* in_sizes, int n_in, void* d_out, int out_size, void* d_ws, size_t ws_size, hipStream_t stream) {
  static int grid_blocks = 0;
  if (ws_size < WS_NEED) { fprintf(stderr, "workspace too small: %zu < %zu\n", ws_size, (size_t)WS_NEED); return; }
  if (!grid_blocks) {
    int dev = 0, cus = 0, per_cu = 0;
    hipGetDevice(&dev);
    hipDeviceGetAttribute(&cus, hipDeviceAttributeMultiprocessorCount, dev);
    hipFuncSetAttribute((const void*)mega<0>, hipFuncAttributeMaxDynamicSharedMemorySize, LDS_BYTES);
    hipOccupancyMaxActiveBlocksPerMultiprocessor(&per_cu, mega<0>, 512, LDS_BYTES);
#ifdef PROBE_MODE
    hipFuncSetAttribute((const void*)mega<PROBE_MODE>, hipFuncAttributeMaxDynamicSharedMemorySize, LDS_BYTES);
#endif
    if (per_cu < 1) per_cu = 1;
    grid_blocks = cus * per_cu;
    if (grid_blocks > 256) grid_blocks = 256;
  }
  Params P{};
  for (int i = 0; i < 32; ++i) P.in[i] = (const float*)d_in[i];
  P.out = (float*)d_out; P.ws = (unsigned char*)d_ws;
  void* args[] = {&P};
  hipError_t e = hipLaunchCooperativeKernel((void*)mega<0>, dim3(grid_blocks), dim3(512), args, LDS_BYTES, stream);
  if (e != hipSuccess) fprintf(stderr, "cooperative launch failed: %s (grid %d)\n", hipGetErrorString(e), grid_blocks);
#ifdef PROBE_MODE
  { Params P2 = P; P2.out = (float*)d_ws; hipLaunchKernelGGL(mega<PROBE_MODE>, dim3(grid_blocks), dim3(512), LDS_BYTES, stream, P2); }
#endif
}
```

```cpp
#include <hip/hip_runtime.h>
#include <hip/hip_cooperative_groups.h>
#include <cstdio>
namespace cg = cooperative_groups;

#define DEVI __device__ __forceinline__
#define LAS __attribute__((address_space(3)))
typedef unsigned short bf16_t;
typedef short bf16x8 __attribute__((ext_vector_type(8)));
typedef short bf16x4 __attribute__((ext_vector_type(4)));
typedef float f32x4 __attribute__((ext_vector_type(4)));
typedef unsigned u32x4 __attribute__((ext_vector_type(4)));
typedef unsigned u32x2 __attribute__((ext_vector_type(2)));

constexpr int T_TOK = 32768, DM = 1024, SEQ = 2048, NCH = 32;
constexpr int PW = 2560;
constexpr int UK = 1152;
constexpr float EPSF = 1e-6f;
constexpr size_t MiB = 1024ull * 1024ull;
constexpr size_t OFF_GATES = 0, OFF_HID = 0, OFF_Y = 128 * MiB, OFF_PROJ = 192 * MiB, OFF_MERGED = 192 * MiB, OFF_PLE = 256 * MiB,
                 OFF_PB = 320 * MiB, OFF_XB = 352 * MiB, OFF_TOEP = 352 * MiB, OFF_W = 416 * MiB, OFF_MINT = 456 * MiB, OFF_U = 464 * MiB,
                 OFF_SMALL = 483 * MiB, WS_NEED = 493 * MiB;
constexpr size_t W_IN = 0, W_BR = 14 * MiB, W_OUT = 16 * MiB, W_FF1 = 18 * MiB, W_FF2 = 26 * MiB, W_PLE = 34 * MiB, W_GLU = 34 * MiB + 512 * 1024,
                 W_PG = 35 * MiB  ;
constexpr size_t S_ROWSQ = 6 * MiB, S_KT = 1 * MiB, S_LAM = 3 * MiB, S_BB = 3 * MiB + 1280 * 1024, S_DT = 5 * MiB, S_CTR = 5 * MiB + 512 * 1024, S_BAR = 5 * MiB + 768 * 1024, S_SSQ = 8 * MiB;
constexpr int LDS_BYTES = 152 * 1024;
#ifndef REP_A
#define REP_A 1
#endif
#ifndef REP_B1
#define REP_B1 1
#endif
#ifndef REP_B3
#define REP_B3 1
#endif
#ifndef REP_C
#define REP_C 1
#endif
#ifndef REP_E
#define REP_E 1
#endif

struct Params { const float* in[32]; float* out; unsigned char* ws; };

DEVI int ltid() { int t = threadIdx.x; asm volatile("" : "+v"(t)); return t; }
DEVI int lbid() { int b = blockIdx.x; asm volatile("" : "+s"(b)); return b; }
DEVI unsigned char* lptr(unsigned char* p) { asm volatile("" : "+s"(p)); return p; }
DEVI int lsg(int v) { asm volatile("" : "+s"(v)); return v; }
DEVI float bf2f(unsigned v) { return __uint_as_float(v << 16); }
DEVI bf16_t f2bf(float f) { unsigned u = __float_as_uint(f); u += 0x7FFFu + ((u >> 16) & 1u); return (bf16_t)(u >> 16); }
DEVI unsigned pk2(float lo, float hi) { unsigned r; asm volatile("v_cvt_pk_bf16_f32 %0, %1, %2" : "=v"(r) : "v"(lo), "v"(hi)); return r; }
DEVI void unpack8(u32x4 w, float* f) {
#pragma unroll
  for (int i = 0; i < 4; ++i) { f[2 * i] = __uint_as_float(w[i] << 16); f[2 * i + 1] = __uint_as_float(w[i] & 0xffff0000u); }
}
DEVI u32x4 pack8(const float* f) { u32x4 w; w[0] = pk2(f[0], f[1]); w[1] = pk2(f[2], f[3]); w[2] = pk2(f[4], f[5]); w[3] = pk2(f[6], f[7]); return w; }
typedef unsigned long long u64;
constexpr float RSQ_SCALE = 16777216.0f, RSQ_INV = 1.0f / (16777216.0f * 1024.0f);
DEVI float rs_from(const u64* p, int row) { return rsqrtf((float)p[row] * RSQ_INV + EPSF); }
DEVI void rs_add(u64* p, int row, float ss) { atomicAdd(p + row, (u64)(ss * RSQ_SCALE + 0.5f)); }
#define DPP_SHR(v, n) __int_as_float(__builtin_amdgcn_update_dpp(0, __float_as_int(v), 0x110 + (n), 0xF, 0xF, false))
DEVI float wave_incl_scan(float v, int lane) {
  v += DPP_SHR(v, 1); v += DPP_SHR(v, 2); v += DPP_SHR(v, 4); v += DPP_SHR(v, 8);
  const float t0 = __int_as_float(__builtin_amdgcn_readlane(__float_as_int(v), 15));
  const float t1 = __int_as_float(__builtin_amdgcn_readlane(__float_as_int(v), 31));
  const float t2 = __int_as_float(__builtin_amdgcn_readlane(__float_as_int(v), 47));
  const int row = lane >> 4;
  return v + (row >= 1 ? t0 : 0.f) + (row >= 2 ? t1 : 0.f) + (row >= 3 ? t2 : 0.f);
}
#define DPP_MOV(v, ctrl) __int_as_float(__builtin_amdgcn_update_dpp(0, __float_as_int(v), (ctrl), 0xF, 0xF, false))
DEVI float sum8(float v) {
  v += DPP_MOV(v, 0xB1);
  v += DPP_MOV(v, 0x4E);
  v += DPP_MOV(v, 0x141);
  return v;
}
DEVI float frcp(float x) { return __builtin_amdgcn_rcpf(x); }
DEVI float sigmoidf_(float x) { return frcp(1.0f + __expf(-x)); }
DEVI float siluf_(float x) { return x * frcp(1.0f + __expf(-x)); }
DEVI float gelu_tanh(float x) { float u = 0.7978845608f * (x + 0.044715f * x * x * x); float t = 1.0f - 2.0f * frcp(1.0f + __expf(2.0f * u)); return 0.5f * x * (1.0f + t); }
DEVI f32x4 mfma16(bf16x8 a, bf16x8 b, f32x4 c) { return __builtin_amdgcn_mfma_f32_16x16x32_bf16(a, b, c, 0, 0, 0); }

namespace pg8 {
constexpr int BM = 256, BK = 64, HALF = 128, HTB = HALF * BK * 2, STAGE_BYTES = 8 * HTB, NXCD = 8, WGM = 8;
DEVI int lds_byte(int r, int c) { const int st = (r >> 4) * 2 + (c >> 5), rr = r & 15, cc = c & 31, ob = rr * 64 + cc * 2; return st * 1024 + (ob ^ (((ob >> 9) & 1) << 5)); }
DEVI void stage_rc(int b, int& R, int& C) { const int st = b / 1024, sb = b % 1024, swz = sb ^ (((sb >> 9) & 1) << 5); R = (st >> 1) * 16 + swz / 64; C = (st & 1) * 32 + (swz % 64) / 2; }
DEVI int perm32(int rho) { const int n = rho >> 4, i = rho & 15; return 8 * (i >> 2) + 4 * n + (i & 3); }
struct Unit { int pm, pn, grp; };
struct Gemm { const bf16_t* A; const bf16_t* Bt; int lda, ldb, K; size_t gsA, gsB; };
struct StaticOrder {
  int nM, nN, nwg, G, c;
  DEVI void init(int nM_, int nN_, int G_, int c_) { nM = nM_; nN = nN_; nwg = nM * nN; G = G_; c = c_; }
  DEVI bool next(int i, Unit& u) const {
    const long L = (long)i * G + c; if (L >= nwg) return false;
    int wgid = (int)L; { const int q = nwg / NXCD, r = nwg % NXCD, xcd = wgid % NXCD, off = wgid / NXCD; wgid = (xcd < r ? xcd * (q + 1) : r * (q + 1) + (xcd - r) * q) + off; }
    const int nig = WGM * nN, gid = wgid / nig, fm = gid * WGM, gsz = (nM - fm) < WGM ? (nM - fm) : WGM;
    u.pm = fm + ((wgid % nig) % gsz); u.pn = (wgid % nig) / gsz; u.grp = 0; return true;
  }
};
struct OneUnit { Unit u; DEVI bool next(int i, Unit& o) const { if (i != 0) return false; o = u; return true; } };

template <class Epi, class Sched>
DEVI void gemm_phase(LAS unsigned char* lds, const Gemm g, const Sched& S, const Epi& E) {
  int tid_ = threadIdx.x; asm volatile("" : "+v"(tid_));
  const int tid = tid_, wid = __builtin_amdgcn_readfirstlane(tid >> 6), lane = tid & 63, wr = wid >> 2, wc = wid & 3, fr = lane & 15, fq = lane >> 4;
  const int K = g.K, nt = K / BK;
  unsigned voffA[2], voffB[2];
#pragma unroll
  for (int i = 0; i < 2; ++i) { int R, C; stage_rc(tid * 16 + i * 8192, R, C); const int Rb = Epi::PERM ? ((R & ~31) + perm32(R & 31)) : R;
    voffA[i] = (unsigned)(R * g.lda + C) * 2u; voffB[i] = (unsigned)(Rb * g.ldb + C) * 2u; }
  const size_t kstep = (size_t)(BK * 2);
  const size_t hstepA = (size_t)HALF * g.lda * 2, hstepB = (size_t)HALF * g.ldb * 2;
  const unsigned ldsw = (unsigned)wid * 1024u;
  const int aoff = lds_byte(wr * 64 + fr, fq * 8), boff = lds_byte(wc * 32 + fr, fq * 8);
#define PG8_SA(b, h) (((b) * 2 + (h)) * HTB)
#define PG8_SB(b, h) ((4 + (b) * 2 + (h)) * HTB)
#define PG8_STAGE(bufoff, gbase, voff) do { _Pragma("unroll") for (int _i = 0; _i < 2; ++_i) \
    __builtin_amdgcn_global_load_lds((const unsigned*)((const char*)(gbase) + (voff)[_i]), (LAS unsigned*)(lds + (bufoff) + ldsw + _i * 8192), 16, 0, 0); } while (0)
#define PG8_LDA(dst, b, h) do { _Pragma("unroll") for (int m = 0; m < 4; ++m) _Pragma("unroll") for (int k = 0; k < 2; ++k) dst[m][k] = *(const LAS bf16x8*)(lds + PG8_SA(b, h) + aoff + m * 2048 + k * 1024); } while (0)
#define PG8_LDB(dst, b, h) do { _Pragma("unroll") for (int n = 0; n < 2; ++n) _Pragma("unroll") for (int k = 0; k < 2; ++k) dst[n][k] = *(const LAS bf16x8*)(lds + PG8_SB(b, h) + boff + n * 2048 + k * 1024); } while (0)
#define PG8_MMA(ai, bj, At, Bt) do { __builtin_amdgcn_s_setprio(1); _Pragma("unroll") for (int m = 0; m < 4; ++m) _Pragma("unroll") for (int n = 0; n < 2; ++n) _Pragma("unroll") for (int k = 0; k < 2; ++k) \
    acc[ai][bj][m][n] = __builtin_amdgcn_mfma_f32_16x16x32_bf16(Bt[n][k], At[m][k], acc[ai][bj][m][n], 0, 0, 0); __builtin_amdgcn_s_setprio(0); } while (0)
#define PG8_WAIT_V(n) asm volatile("s_waitcnt vmcnt(" #n ")" ::: "memory")
#define PG8_WAIT_L(n) asm volatile("s_waitcnt lgkmcnt(" #n ")" ::: "memory")
#define PG8_BAR __builtin_amdgcn_s_barrier()
#define PG8_SCHED __builtin_amdgcn_sched_barrier(0)
  Unit cur, nxt; int ui = 0;
  if (!S.next(0, cur)) return;
  f32x4 acc[2][2][4][2];
#pragma unroll
  for (int a = 0; a < 2; ++a)
#pragma unroll
    for (int b = 0; b < 2; ++b)
#pragma unroll
      for (int m = 0; m < 4; ++m)
#pragma unroll
        for (int n = 0; n < 2; ++n) acc[a][b][m][n] = (f32x4){0.f, 0.f, 0.f, 0.f};
  bf16x8 At[4][2], B0[2][2], B1[2][2];
  const char* cA = (const char*)g.A + (size_t)cur.grp * g.gsA + (size_t)cur.pm * 2 * hstepA;
  const char* cB = (const char*)g.Bt + (size_t)cur.grp * g.gsB + (size_t)cur.pn * 2 * hstepB;
  PG8_STAGE(PG8_SB(0, 0), cB, voffB); PG8_STAGE(PG8_SA(0, 0), cA, voffA); PG8_STAGE(PG8_SB(0, 1), cB + hstepB, voffB); PG8_STAGE(PG8_SA(0, 1), cA + hstepA, voffA);
  if (wr == 1) PG8_BAR;
  PG8_WAIT_V(4); PG8_BAR;
  PG8_STAGE(PG8_SB(1, 0), cB + kstep, voffB); PG8_STAGE(PG8_SA(1, 0), cA + kstep, voffA); PG8_STAGE(PG8_SB(1, 1), cB + hstepB + kstep, voffB);
  PG8_WAIT_V(6); PG8_BAR;
  for (;;) {
    const bool has_next = S.next(ui + 1, nxt);
    const char* nA = has_next ? (const char*)g.A + (size_t)nxt.grp * g.gsA + (size_t)nxt.pm * 2 * hstepA : cA;
    const char* nB = has_next ? (const char*)g.Bt + (size_t)nxt.grp * g.gsB + (size_t)nxt.pn * 2 * hstepB : cB;
    for (int t = 0; t < nt; t += 2) {
      const bool last = (t == nt - 2);
      const char* a1 = cA + (size_t)(t + 1) * kstep;
      const char* a2 = last ? nA : cA + (size_t)(t + 2) * kstep; const char* b2 = last ? nB : cB + (size_t)(t + 2) * kstep;
      const char* a3 = a2 + kstep; const char* b3 = b2 + kstep;
      PG8_LDB(B0, 0, 0); PG8_SCHED; PG8_LDA(At, 0, 0); PG8_STAGE(PG8_SA(1, 1), a1 + hstepA, voffA);
      PG8_WAIT_L(8); PG8_BAR; PG8_WAIT_L(0); PG8_MMA(0, 0, At, B0); PG8_BAR; PG8_SCHED;
      PG8_LDB(B1, 0, 1); PG8_STAGE(PG8_SB(0, 0), b2, voffB);
      PG8_BAR; PG8_WAIT_L(0); PG8_MMA(0, 1, At, B1); PG8_BAR;
      PG8_LDA(At, 0, 1); PG8_STAGE(PG8_SA(0, 0), a2, voffA);
      PG8_BAR; PG8_WAIT_L(0); PG8_MMA(1, 0, At, B0); PG8_BAR; PG8_SCHED;
      PG8_STAGE(PG8_SB(0, 1), b2 + hstepB, voffB);
      PG8_WAIT_V(6); PG8_BAR; PG8_MMA(1, 1, At, B1); PG8_BAR;
      PG8_LDB(B0, 1, 0); PG8_SCHED; PG8_LDA(At, 1, 0); PG8_STAGE(PG8_SA(0, 1), a2 + hstepA, voffA);
      PG8_WAIT_L(8); PG8_BAR; PG8_WAIT_L(0); PG8_MMA(0, 0, At, B0); PG8_BAR; PG8_SCHED;
      PG8_LDB(B1, 1, 1); PG8_STAGE(PG8_SB(1, 0), b3, voffB);
      PG8_BAR; PG8_WAIT_L(0); PG8_MMA(0, 1, At, B1); PG8_BAR;
      PG8_LDA(At, 1, 1); PG8_STAGE(PG8_SA(1, 0), a3, voffA);
      PG8_BAR; PG8_WAIT_L(0); PG8_MMA(1, 0, At, B0); PG8_BAR; PG8_SCHED;
      PG8_STAGE(PG8_SB(1, 1), b3 + hstepB, voffB);
      PG8_WAIT_V(6); PG8_BAR; PG8_MMA(1, 1, At, B1); PG8_BAR;
    }
    asm volatile("s_nop 7\n\ts_nop 7" ::: "memory");
    if constexpr (!Epi::AFTER_DRAIN) { E(acc, cur, wr, wc, fr, fq); }
    if (!has_next) break;
#pragma unroll
    for (int a = 0; a < 2; ++a)
#pragma unroll
      for (int b = 0; b < 2; ++b)
#pragma unroll
        for (int m = 0; m < 4; ++m)
#pragma unroll
          for (int n = 0; n < 2; ++n) acc[a][b][m][n] = (f32x4){0.f, 0.f, 0.f, 0.f};
    cur = nxt; cA = nA; cB = nB; ++ui;
  }
  PG8_WAIT_V(0);
  if (wr == 0) PG8_BAR;
  PG8_BAR;
  if constexpr (Epi::AFTER_DRAIN) { E.fused(acc, cur, wr, wc, fr, fq, lds, wid, lane); }
#undef PG8_SA
#undef PG8_SB
#undef PG8_STAGE
#undef PG8_LDA
#undef PG8_LDB
#undef PG8_MMA
#undef PG8_WAIT_V
#undef PG8_WAIT_L
#undef PG8_BAR
#undef PG8_SCHED
}
}
using pg8::Unit; using pg8::Gemm;
typedef f32x4 AccT[2][2][4][2];

struct EpiG1 {
  static constexpr bool PERM = true, AFTER_DRAIN = false;
  const u64* rowsq; bf16_t* proj; bf16_t* U; float* dt; unsigned char* gates;
  DEVI void operator()(const AccT& acc, const Unit& u, int wr, int wc, int fr, int fq) const {
    const int pn = u.pn;
    float rsv[2][4];
#pragma unroll
    for (int ai = 0; ai < 2; ++ai)
#pragma unroll
      for (int m = 0; m < 4; ++m) rsv[ai][m] = rs_from(rowsq, u.pm * 256 + ai * 128 + wr * 64 + m * 16 + fr);
#pragma unroll
    for (int ai = 0; ai < 2; ++ai)
#pragma unroll
      for (int m = 0; m < 4; ++m) {
        const int row = u.pm * 256 + ai * 128 + wr * 64 + m * 16 + fr;
        const float rs = rsv[ai][m];
#pragma unroll
        for (int bj = 0; bj < 2; ++bj) {
          const int cc = bj * 128 + wc * 32 + fq * 8;
          float v[8];
#pragma unroll
          for (int e = 0; e < 4; ++e) { v[e] = acc[ai][bj][m][0][e] * rs; v[4 + e] = acc[ai][bj][m][1][e] * rs; }
          if (pn >= 12) {
            unsigned q[8];
#pragma unroll
            for (int e = 0; e < 8; ++e) { q[e] = (unsigned)(sigmoidf_(v[e]) * 255.0f + 0.5f); q[e] = q[e] > 255u ? 255u : q[e]; }
            u32x2 w; w[0] = q[0] | (q[1] << 8) | (q[2] << 16) | (q[3] << 24); w[1] = q[4] | (q[5] << 8) | (q[6] << 16) | (q[7] << 24);
            *(u32x2*)(gates + (size_t)row * 4096 + (pn - 12) * 256 + cc) = w;
          } else if (pn == 11) {
            if (cc == 0) *(f32x4*)(dt + (size_t)row * 4) = (f32x4){v[0], v[1], v[2], v[3]};
          } else if (pn == 7) {
            const int g = cc >> 4, i0 = cc & 15;
            *(u32x4*)(U + ((size_t)(g * 512 + (row >> 6)) * UK + (row & 63) * 16 + i0)) = pack8(v);
          } else {
            const int pt = pn < 7 ? pn : pn - 1;
            *(u32x4*)(proj + (size_t)row * PW + pt * 256 + cc) = pack8(v);
          }
        }
      }
  }
};
template <bool XF32>
struct EpiRes {
  static constexpr bool PERM = true, AFTER_DRAIN = false;
  const float* xin; bf16_t* xb; u64* rsq_out;
  DEVI void operator()(const AccT& acc, const Unit& u, int wr, int wc, int fr, int fq) const {
#pragma unroll
    for (int ai = 0; ai < 2; ++ai)
#pragma unroll
    for (int mh = 0; mh < 2; ++mh) {
      f32x4 xf[4][2][2]; u32x4 xh[4][2];
#pragma unroll
      for (int m = 2 * mh; m < 2 * mh + 2; ++m)
#pragma unroll
        for (int bj = 0; bj < 2; ++bj) {
          const size_t o = (size_t)(u.pm * 256 + ai * 128 + wr * 64 + m * 16 + fr) * 1024 + u.pn * 256 + bj * 128 + wc * 32 + fq * 8;
          if (XF32) { xf[m][bj][0] = *(const f32x4*)(xin + o); xf[m][bj][1] = *(const f32x4*)(xin + o + 4); }
          else xh[m][bj] = *(const u32x4*)(xb + o);
        }
#pragma unroll
      for (int m = 2 * mh; m < 2 * mh + 2; ++m) {
        const int row = u.pm * 256 + ai * 128 + wr * 64 + m * 16 + fr;
        float ss = 0.f;
#pragma unroll
        for (int bj = 0; bj < 2; ++bj) {
          const size_t o = (size_t)row * 1024 + u.pn * 256 + bj * 128 + wc * 32 + fq * 8;
          float xo[8];
          if (XF32) {
#pragma unroll
            for (int e = 0; e < 4; ++e) { xo[e] = xf[m][bj][0][e]; xo[4 + e] = xf[m][bj][1][e]; } }
          else unpack8(xh[m][bj], xo);
          float v[8];
#pragma unroll
          for (int e = 0; e < 4; ++e) { v[e] = acc[ai][bj][m][0][e] + xo[e]; v[4 + e] = acc[ai][bj][m][1][e] + xo[4 + e]; }
          const u32x4 w = pack8(v);
          *(u32x4*)(xb + o) = w;
          float vr[8]; unpack8(w, vr);
#pragma unroll
          for (int e = 0; e < 8; ++e) ss += vr[e] * vr[e];
        }
        ss += __shfl_xor(ss, 16); ss += __shfl_xor(ss, 32);
        if (fq == 0) rs_add(rsq_out, row, ss);
      }
    }
  }
};
struct EpiFF1 {
  static constexpr bool PERM = true, AFTER_DRAIN = false;
  const u64* rowsq; bf16_t* hid;
  DEVI void operator()(const AccT& acc, const Unit& u, int wr, int wc, int fr, int fq) const {
    float rsv[2][4];
#pragma unroll
    for (int ai = 0; ai < 2; ++ai)
#pragma unroll
      for (int m = 0; m < 4; ++m) rsv[ai][m] = rs_from(rowsq, u.pm * 256 + ai * 128 + wr * 64 + m * 16 + fr);
#pragma unroll
    for (int ai = 0; ai < 2; ++ai)
#pragma unroll
      for (int m = 0; m < 4; ++m) {
        const int row = u.pm * 256 + ai * 128 + wr * 64 + m * 16 + fr;
        const float rs = rsv[ai][m];
#pragma unroll
        for (int bj = 0; bj < 2; ++bj) {
          float v[8];
#pragma unroll
          for (int e = 0; e < 4; ++e) { float a = fmaxf(acc[ai][bj][m][0][e] * rs, 0.f), b = fmaxf(acc[ai][bj][m][1][e] * rs, 0.f); v[e] = a * a; v[4 + e] = b * b; }
          *(u32x4*)(hid + (size_t)row * 4096 + u.pn * 256 + bj * 128 + wc * 32 + fq * 8) = pack8(v);
        }
      }
  }
};
struct EpiPle {
  static constexpr bool PERM = true, AFTER_DRAIN = false;
  bf16_t* ple;
  DEVI void operator()(const AccT& acc, const Unit& u, int wr, int wc, int fr, int fq) const {
#pragma unroll
    for (int ai = 0; ai < 2; ++ai)
#pragma unroll
      for (int m = 0; m < 4; ++m) {
        const int row = u.pm * 256 + ai * 128 + wr * 64 + m * 16 + fr;
#pragma unroll
        for (int bj = 0; bj < 2; ++bj) {
          float v[8];
#pragma unroll
          for (int e = 0; e < 4; ++e) { v[e] = acc[ai][bj][m][0][e]; v[4 + e] = acc[ai][bj][m][1][e]; }
          *(u32x4*)(ple + (size_t)row * 1024 + u.pn * 256 + bj * 128 + wc * 32 + fq * 8) = pack8(v);
        }
      }
  }
};
struct EpiPG {
  static constexpr bool PERM = true, AFTER_DRAIN = false;
  const u64* rowsq; const bf16_t* ple; const bf16_t* xbo; float* xout; bf16_t* xbn; u64* rsq_out; int last;
  DEVI void operator()(const AccT& acc, const Unit& u, int wr, int wc, int fr, int fq) const {
#pragma unroll
    for (int ai = 0; ai < 2; ++ai)
#pragma unroll
    for (int mh = 0; mh < 2; ++mh) {
      u32x4 xh[4][2], ph[4][2]; float rsv[4];
#pragma unroll
      for (int m = 2 * mh; m < 2 * mh + 2; ++m) {
        const int row = u.pm * 256 + ai * 128 + wr * 64 + m * 16 + fr;
        rsv[m] = rs_from(rowsq, row);
#pragma unroll
        for (int bj = 0; bj < 2; ++bj) {
          const size_t o = (size_t)row * 1024 + u.pn * 256 + bj * 128 + wc * 32 + fq * 8;
          xh[m][bj] = *(const u32x4*)(xbo + o); ph[m][bj] = *(const u32x4*)(ple + o);
        }
      }
#pragma unroll
      for (int m = 2 * mh; m < 2 * mh + 2; ++m) {
        const int row = u.pm * 256 + ai * 128 + wr * 64 + m * 16 + fr;
        const float rs = rsv[m];
        float ss = 0.f;
#pragma unroll
        for (int bj = 0; bj < 2; ++bj) {
          const size_t o = (size_t)row * 1024 + u.pn * 256 + bj * 128 + wc * 32 + fq * 8;
          float xo[8]; unpack8(xh[m][bj], xo);
          float pl[8]; unpack8(ph[m][bj], pl);
          float v[8];
#pragma unroll
          for (int e = 0; e < 4; ++e) { v[e] = xo[e] + pl[e] * sigmoidf_(acc[ai][bj][m][0][e] * rs); v[4 + e] = xo[4 + e] + pl[4 + e] * sigmoidf_(acc[ai][bj][m][1][e] * rs); }
          *(f32x4*)(xout + o) = (f32x4){v[0], v[1], v[2], v[3]}; *(f32x4*)(xout + o + 4) = (f32x4){v[4], v[5], v[6], v[7]};
          if (!last) { *(u32x4*)(xbn + o) = pack8(v);
#pragma unroll
          for (int e = 0; e < 8; ++e) ss += v[e] * v[e]; }
        }
        if (!last) { ss += __shfl_xor(ss, 16); ss += __shfl_xor(ss, 32);
        if (fq == 0) rs_add(rsq_out, row, ss); }
      }
    }
  }
};
struct EpiS5in {
  static constexpr bool PERM = false, AFTER_DRAIN = true;
  bf16_t* U; const float* lam;
  DEVI void operator()(const AccT&, const Unit&, int, int, int, int) const {}
  DEVI void fused(const AccT& acc, const Unit& u, int wr, int wc, int fr, int fq, LAS unsigned char* lds, int wid, int lane) const {
    LAS float* L = (LAS float*)lds;
#pragma unroll
    for (int ai = 0; ai < 2; ++ai)
#pragma unroll
      for (int m = 0; m < 4; ++m) {
        const int rl = ai * 128 + wr * 64 + m * 16 + fr;
#pragma unroll
        for (int n = 0; n < 2; ++n) {
          const int c = wc * 32 + n * 16 + fq * 4;
#pragma unroll
          for (int e = 0; e < 4; ++e) L[rl * 128 + c + e] = acc[ai][0][m][n][e];
        }
      }
    __syncthreads();
    const int tid = ltid(), bl = tid >> 6, p = tid & 63, g = u.grp;
    const float lr = lam[((size_t)(g * 64 + p) * 65 + 64) * 2], li = lam[((size_t)(g * 64 + p) * 65 + 64) * 2 + 1];
    float hr = 0.f, hi = 0.f;
    for (int c = 0; c < 32; ++c) {
      const int rl = bl * 32 + c;
      bf16_t* dst = U + ((size_t)(g * 512 + u.pm * 256 + rl) * UK + 1024);
      dst[p] = f2bf(hr); dst[64 + p] = f2bf(hi);
      const float er = L[rl * 128 + p], ei = L[rl * 128 + 64 + p];
      const float nr = lr * hr - li * hi + er, ni = lr * hi + li * hr + ei;
      hr = nr; hi = ni;
    }
    __syncthreads();
  }
};
struct EpiToep {
  static constexpr bool PERM = true, AFTER_DRAIN = false;
  const bf16_t* U; const float* dskip; bf16_t* Y;
  DEVI void operator()(const AccT& acc, const Unit& u, int wr, int wc, int fr, int fq) const {
    const int g = u.grp, i0 = (fq * 8) & 15;
    float dk[8];
#pragma unroll
    for (int e = 0; e < 8; ++e) dk[e] = dskip[g * 16 + i0 + e];
#pragma unroll
    for (int ai = 0; ai < 2; ++ai)
#pragma unroll
    for (int mh = 0; mh < 2; ++mh) {
      u32x4 uh[4][2];
#pragma unroll
      for (int m = 2 * mh; m < 2 * mh + 2; ++m)
#pragma unroll
        for (int bj = 0; bj < 2; ++bj) {
          const int r = u.pm * 256 + ai * 128 + wr * 64 + m * 16 + fr, cidx = u.pn * 256 + bj * 128 + wc * 32 + fq * 8;
          uh[m][bj] = *(const u32x4*)(U + ((size_t)(g * 512 + r) * UK + cidx));
        }
#pragma unroll
      for (int m = 2 * mh; m < 2 * mh + 2; ++m) {
        const int r = u.pm * 256 + ai * 128 + wr * 64 + m * 16 + fr;
#pragma unroll
        for (int bj = 0; bj < 2; ++bj) {
          const int cidx = u.pn * 256 + bj * 128 + wc * 32 + fq * 8, s = cidx >> 4;
          float uv[8]; unpack8(uh[m][bj], uv);
          float v[8];
#pragma unroll
          for (int e = 0; e < 8; ++e) { const float a = (e < 4 ? acc[ai][bj][m][0][e] : acc[ai][bj][m][1][e - 4]) + dk[e] * uv[e]; v[e] = gelu_tanh(a); }
          *(u32x4*)(Y + (size_t)(r * 64 + s) * 1024 + 512 + g * 16 + i0) = pack8(v);
        }
      }
    }
  }
};
struct EpiGLU {
  static constexpr bool PERM = true, AFTER_DRAIN = false;
  bf16_t* Y;
  DEVI void operator()(const AccT& acc, const Unit& u, int wr, int wc, int fr, int fq) const {
#pragma unroll
    for (int ai = 0; ai < 2; ++ai)
#pragma unroll
    for (int mh = 0; mh < 2; ++mh) {
      u32x4 yh[4][2];
#pragma unroll
      for (int m = 2 * mh; m < 2 * mh + 2; ++m)
#pragma unroll
        for (int bj = 0; bj < 2; ++bj)
          yh[m][bj] = *(const u32x4*)(Y + (size_t)(u.pm * 256 + ai * 128 + wr * 64 + m * 16 + fr) * 1024 + 512 + bj * 128 + wc * 32 + fq * 8);
#pragma unroll
      for (int m = 2 * mh; m < 2 * mh + 2; ++m) {
        const int row = u.pm * 256 + ai * 128 + wr * 64 + m * 16 + fr;
#pragma unroll
        for (int bj = 0; bj < 2; ++bj) {
          bf16_t* p = Y + (size_t)row * 1024 + 512 + bj * 128 + wc * 32 + fq * 8;
          float yv[8]; unpack8(yh[m][bj], yv);
          float v[8];
#pragma unroll
          for (int e = 0; e < 8; ++e) v[e] = yv[e] * sigmoidf_(e < 4 ? acc[ai][bj][m][0][e] : acc[ai][bj][m][1][e - 4]);
          *(u32x4*)p = pack8(v);
        }
      }
    }
  }
};

constexpr int TS = 72;
DEVI f32x4 mma64(const bf16_t* A, int lda, const bf16_t* Bt, int ldb, f32x4 acc, int fr, int fq) {
#pragma unroll
  for (int k = 0; k < 64; k += 32) {
    const bf16x8 a = *(const bf16x8*)(A + fr * lda + k + fq * 8);
    const bf16x8 b = *(const bf16x8*)(Bt + fr * ldb + k + fq * 8);
    acc = mfma16(a, b, acc);
  }
  return acc;
}
DEVI int qpop(int* ctr, int* slot) {
  __syncthreads();
  if (ltid() == 0) *slot = atomicAdd(ctr, 1);
  __syncthreads();
  return __builtin_amdgcn_readfirstlane(*slot);
}

DEVI void dep_publish(int* cnt) {
  asm volatile("s_waitcnt vmcnt(0)" ::: "memory");
  __syncthreads();
  if (ltid() == 0) {
    __builtin_amdgcn_fence(__ATOMIC_RELEASE, "agent");
    asm volatile("s_waitcnt vmcnt(0)" ::: "memory");
    __hip_atomic_fetch_add(cnt, 1, __ATOMIC_RELAXED, __HIP_MEMORY_SCOPE_AGENT);
  }
}
DEVI void dep_wait(int* cnt, int need) {
  if (ltid() == 0) {
    unsigned sp = 0;
    while (__hip_atomic_load(cnt, __ATOMIC_RELAXED, __HIP_MEMORY_SCOPE_AGENT) < need) { __builtin_amdgcn_s_sleep(2); if (++sp > (1u << 22)) break; }
    __builtin_amdgcn_fence(__ATOMIC_ACQUIRE, "agent");
    asm volatile("s_waitcnt vmcnt(0)" ::: "memory");
  }
  __syncthreads();
}

__device__ void hgrn2_seq(const Params& P, int layer, int item, unsigned char* smem) {
  int tid_ = threadIdx.x; asm volatile("" : "+v"(tid_));
  const int tid = tid_, wid = tid >> 6, lane = tid & 63, fr = lane & 15, fq = lane >> 4;
  const int b = item >> 2, h = item & 3, r = lane, c8 = wid * 8;
  const int r2 = tid >> 3, c82 = (tid & 7) * 8;
  float* B32 = (float*)smem;
  float* O32 = (float*)(smem + 16384);
  float* WT = (float*)(smem + 16384 + 16640);
  bf16_t* QB = (bf16_t*)(smem + 35072);
  bf16_t* QT = QB + 64 * TS;
  bf16_t* KT = QT + 64 * TS;
  bf16_t* KET = KT + 4 * 64 * TS;
  bf16_t* VT = KET + 64 * TS;
  bf16_t* SC = VT + 64 * TS;
  bf16_t* ST = SC + 64 * TS;
  const bf16_t* proj = (const bf16_t*)(P.ws + OFF_PROJ);
  bf16_t* Y = (bf16_t*)(P.ws + OFF_Y);
  float lbv[8], og[8];
#pragma unroll
  for (int i = 0; i < 8; ++i) {
    const int k = h * 64 + c8 + i;
    if (layer == 0) lbv[i] = 0.f; else { const float l0 = P.in[4][k], l1 = P.in[4][256 + k]; lbv[i] = 1.0f / (1.0f + expf(l0 - l1)); }
    og[i] = P.in[5][layer * 256 + h * 64 + c82 + i];
  }
  f32x4 sacc[2] = {(f32x4){0.f, 0.f, 0.f, 0.f}, (f32x4){0.f, 0.f, 0.f, 0.f}};
  for (int i = tid; i < 2 * 64 * TS; i += 512) ST[i] = 0;
  const bf16_t* pbase = proj + (size_t)(b * SEQ) * PW + h * 64 + c8;
  const bf16_t* gbase = proj + (size_t)(b * SEQ) * PW + 768 + h * 64 + c82;
  u32x4 nq, nz, nv, ng;
  { const bf16_t* p = pbase + (size_t)r * PW; nq = *(const u32x4*)p; nz = *(const u32x4*)(p + 256); nv = *(const u32x4*)(p + 512); ng = *(const u32x4*)(gbase + (size_t)r2 * PW); }
  __syncthreads();
  for (int c = 0; c < NCH; ++c) {
    const int t = c * 64 + r;
    float q[8], z[8], lf[8], kk[8];
    const u32x4 cv = nv, cgt = ng;
    unpack8(nq, q); unpack8(nz, z);
    if (c + 1 < NCH) { const bf16_t* p = pbase + (size_t)(t + 64) * PW; nq = *(const u32x4*)p; nz = *(const u32x4*)(p + 256); nv = *(const u32x4*)(p + 512); ng = *(const u32x4*)(gbase + (size_t)(c * 64 + 64 + r2) * PW); }
#pragma unroll
    for (int i = 0; i < 8; ++i) {
      const float e = __expf(-z[i]), inv = frcp(1.0f + e);
      const float f = lbv[i] + (1.0f - lbv[i]) * inv;
      lf[i] = __logf(fmaxf(f, 1e-37f));
      kk[i] = (1.0f - lbv[i]) * e * inv;
    }
#pragma unroll
    for (int i = 0; i < 8; ++i) lf[i] = wave_incl_scan(lf[i], lane);
#pragma unroll
    for (int i = 0; i < 8; ++i) B32[r * 64 + c8 + i] = lf[i];
    __syncthreads();
    {
      const int I = r >> 4;
      float tq[8], tb[8], vv[8];
      unpack8(cv, vv);
#pragma unroll
      for (int i = 0; i < 8; ++i) { tb[i] = q[i] * __expf(lf[i]); tq[i] = q[i] * __expf(lf[i] - B32[(I * 16) * 64 + c8 + i]); }
      *(u32x4*)(QB + r * TS + c8) = pack8(tb);
      *(u32x4*)(QT + r * TS + c8) = pack8(tq);
      float br[4][8];
#pragma unroll
      for (int I2 = 0; I2 < 4; ++I2)
#pragma unroll
        for (int i = 0; i < 8; ++i) br[I2][i] = B32[(I2 * 16) * 64 + c8 + i];
#pragma unroll
      for (int I2 = 0; I2 < 4; ++I2) {
        float tk[8];
#pragma unroll
        for (int i = 0; i < 8; ++i) tk[i] = kk[i] * __expf(fminf(br[I2][i] - lf[i], 80.f));
        if (I2 >= I) *(u32x4*)(KT + I2 * 64 * TS + r * TS + c8) = pack8(tk);
      }
#pragma unroll
      for (int i = 0; i < 8; ++i) {
        KET[(c8 + i) * TS + r] = f2bf(kk[i] * __expf(B32[63 * 64 + c8 + i] - lf[i]));
        VT[(c8 + i) * TS + r] = f2bf(vv[i]);
      }
    }
    __syncthreads();
#pragma unroll
    for (int x = 0; x < 2; ++x) {
      const int tl = wid + 8 * x, I = tl >> 2, J = tl & 3;
      f32x4 a = (f32x4){0.f, 0.f, 0.f, 0.f};
      if (J <= I) a = mma64(QT + I * 16 * TS, TS, KT + I * 64 * TS + J * 16 * TS, TS, a, fr, fq);
#pragma unroll
      for (int jj = 0; jj < 4; ++jj) {
        float v = a[jj];
        if (J > I || (J == I && (fq * 4 + jj) < fr)) v = 0.f;
        SC[(I * 16 + fq * 4 + jj) * TS + J * 16 + fr] = f2bf(v);
      }
    }
    __syncthreads();
    const bf16_t* STc = ST + (c & 1) * 64 * TS;
    bf16_t* STn = ST + ((c + 1) & 1) * 64 * TS;
#pragma unroll
    for (int x = 0; x < 2; ++x) {
      const int tb_ = wid >> 1, vb = (wid & 1) * 2 + x;
      f32x4 a = (f32x4){0.f, 0.f, 0.f, 0.f};
      a = mma64(SC + tb_ * 16 * TS, TS, VT + vb * 16 * TS, TS, a, fr, fq);
      a = mma64(QB + tb_ * 16 * TS, TS, STc + vb * 16 * TS, TS, a, fr, fq);
#pragma unroll
      for (int jj = 0; jj < 4; ++jj) O32[(tb_ * 16 + fq * 4 + jj) * 65 + vb * 16 + fr] = a[jj];
      const int kb = (wid & 1) * 2 + x;
      const float dec = __expf(B32[63 * 64 + kb * 16 + fr]);
      f32x4 s = sacc[x];
#pragma unroll
      for (int jj = 0; jj < 4; ++jj) s[jj] *= dec;
      s = mma64(VT + (wid >> 1) * 16 * TS, TS, KET + kb * 16 * TS, TS, s, fr, fq);
      sacc[x] = s;
#pragma unroll
      for (int jj = 0; jj < 4; ++jj) STn[((wid >> 1) * 16 + fq * 4 + jj) * TS + kb * 16 + fr] = f2bf(s[jj]);
    }
    __syncthreads();
    {
      float o[8], gg[8]; float ss = 0.f;
      unpack8(cgt, gg);
#pragma unroll
      for (int i = 0; i < 8; ++i) { o[i] = O32[r2 * 65 + c82 + i]; ss += o[i] * o[i]; }
      ss = sum8(ss);
      const float rs = rsqrtf(ss * (1.0f / 64.0f) + EPSF);
#pragma unroll
      for (int i = 0; i < 8; ++i) o[i] = o[i] * rs * og[i] * siluf_(gg[i]);
      *(u32x4*)(Y + (size_t)(b * SEQ + c * 64 + r2) * 1024 + h * 64 + c82) = pack8(o);
    }
  }
  __syncthreads();
}

__device__ void ssd_seq(const Params& P, int layer, int item, unsigned char* smem) {
  int tid_ = threadIdx.x; asm volatile("" : "+v"(tid_));
  const int tid = tid_, wid = tid >> 6, lane = tid & 63, fr = lane & 15, fq = lane >> 4;
  const int b = item >> 2, h = item & 3, grp = h >> 1, r = lane, cg_ = wid, c8 = wid * 8;
  const int r2 = tid >> 3, cg2 = tid & 7, c82 = cg2 * 8;
  constexpr int RS = 200;
  bf16_t* RAW = (bf16_t*)smem;
  float* O32 = (float*)smem;
  float* CW = (float*)(smem + 27136);
  float* ACUM = (float*)(smem + 27136 + 3840);
  float* DTV = ACUM + 64;
  bf16_t* XS = (bf16_t*)(smem + 27136 + 3840 + 512);
  bf16_t* CM = XS + 64 * TS;
  bf16_t* BM = CM + 64 * TS;
  bf16_t* BMT = BM + 64 * TS;
  bf16_t* CS = BMT + 64 * TS;
  bf16_t* XDTT = CS + 64 * TS;
  bf16_t* XDECT = XDTT + 64 * TS;
  bf16_t* MS = XDECT + 64 * TS;
  bf16_t* STATE = MS + 64 * TS;
  const bf16_t* proj = (const bf16_t*)(P.ws + OFF_PROJ);
  const float* dtb = (const float*)(P.ws + OFF_SMALL + S_DT);
  u64* ssq = (u64*)(P.ws + OFF_SMALL + S_SSQ) + (size_t)layer * T_TOK * 2;
  bf16_t* Y = (bf16_t*)(P.ws + OFF_Y);
  if (tid < 192) {
    const int lc = tid; const int ch = lc < 64 ? h * 64 + lc : (lc < 128 ? 256 + grp * 64 + (lc - 64) : 384 + grp * 64 + (lc - 128));
    const float* w = P.in[6] + ((size_t)layer * 512 + ch) * 4;
    CW[0 * 192 + lc] = w[0]; CW[1 * 192 + lc] = w[1]; CW[2 * 192 + lc] = w[2]; CW[3 * 192 + lc] = w[3]; CW[4 * 192 + lc] = P.in[7][layer * 512 + ch];
  }
  for (int i = tid; i < 64 * TS; i += 512) STATE[i] = 0;
  const float dtbias = P.in[8][layer * 4 + h], aneg = -expf(P.in[9][layer * 4 + h]), dsk = P.in[10][layer * 4 + h];
  f32x4 sacc[2] = {(f32x4){0.f, 0.f, 0.f, 0.f}, (f32x4){0.f, 0.f, 0.f, 0.f}};
  __syncthreads();
  u32x4 rw[4], zr; float dtr = 0.f;
#define SSD_PREFETCH(cc) do { const int t0n = b * SEQ + (cc) * 64; \
    _Pragma("unroll") for (int i = 0; i < 4; ++i) { const int idx = tid + 512 * i; rw[i] = (u32x4){0u, 0u, 0u, 0u}; \
      if (idx < 67 * 24) { const int rr = idx / 24, pc = idx - rr * 24; \
        const int col = pc < 8 ? 1280 + h * 64 + pc * 8 : (pc < 16 ? 1536 + grp * 64 + (pc - 8) * 8 : 1664 + grp * 64 + (pc - 16) * 8); \
        if ((cc) > 0 || rr >= 3) rw[i] = *(const u32x4*)(proj + (size_t)(t0n - 3 + rr) * PW + col); } } \
    if (wid == 0) dtr = dtb[(size_t)(t0n + lane) * 4 + h]; \
    zr = *(const u32x4*)(proj + (size_t)(t0n + r2) * PW + 1024 + h * 64 + c82); } while (0)
  SSD_PREFETCH(0);
  for (int c = 0; c < NCH; ++c) {
    const int t0 = b * SEQ + c * 64;
#pragma unroll
    for (int i = 0; i < 4; ++i) { const int idx = tid + 512 * i; if (idx < 67 * 24) { const int rr = idx / 24, pc = idx - rr * 24; *(u32x4*)(RAW + rr * RS + pc * 8) = rw[i]; } }
    if (wid == 0) {
      const float x0 = dtr + dtbias;
      const float dt0 = x0 > 20.f ? x0 : log1pf(__expf(x0));
      float a0 = dt0 * aneg;
      a0 = wave_incl_scan(a0, lane);
      ACUM[lane] = a0; DTV[lane] = dt0;
    }
    const u32x4 zraw = zr;
    if (c + 1 < NCH) SSD_PREFETCH(c + 1);
    __syncthreads();
#pragma unroll
    for (int q3 = 0; q3 < 3; ++q3) {
      const int lc0 = cg_ * 24 + q3 * 8;
      float accv[8];
      { const f32x4 b0 = *(const f32x4*)(CW + 4 * 192 + lc0), b1 = *(const f32x4*)(CW + 4 * 192 + lc0 + 4);
#pragma unroll
        for (int i = 0; i < 4; ++i) { accv[i] = b0[i]; accv[4 + i] = b1[i]; } }
#pragma unroll
      for (int tap = 0; tap < 4; ++tap) {
        float xv[8]; unpack8(*(const u32x4*)(RAW + (r + tap) * RS + lc0), xv);
        const f32x4 w0 = *(const f32x4*)(CW + tap * 192 + lc0), w1 = *(const f32x4*)(CW + tap * 192 + lc0 + 4);
#pragma unroll
        for (int i = 0; i < 4; ++i) { accv[i] += xv[i] * w0[i]; accv[4 + i] += xv[4 + i] * w1[i]; }
      }
#pragma unroll
      for (int i = 0; i < 8; ++i) accv[i] = siluf_(accv[i]);
      if (lc0 < 64) { *(u32x4*)(XS + r * TS + lc0) = pack8(accv); }
      else if (lc0 < 128) { const int n0 = lc0 - 64; *(u32x4*)(BM + r * TS + n0) = pack8(accv);
#pragma unroll
        for (int i = 0; i < 8; ++i) BMT[(n0 + i) * TS + r] = f2bf(accv[i]); }
      else { const int n0 = lc0 - 128; *(u32x4*)(CM + r * TS + n0) = pack8(accv); }
    }
    __syncthreads();
    {
      float xs[8], cm[8], cs[8]; unpack8(*(const u32x4*)(XS + r * TS + c8), xs); unpack8(*(const u32x4*)(CM + r * TS + c8), cm);
      const float dtv = DTV[r], dec = __expf(ACUM[63] - ACUM[r]), ea = __expf(ACUM[r]);
#pragma unroll
      for (int i = 0; i < 8; ++i) { const float xd = xs[i] * dtv; XDTT[(c8 + i) * TS + r] = f2bf(xd); XDECT[(c8 + i) * TS + r] = f2bf(xd * dec); cs[i] = cm[i] * ea; }
      *(u32x4*)(CS + r * TS + c8) = pack8(cs);
    }
#pragma unroll
    for (int x = 0; x < 2; ++x) {
      const int tl = wid + 8 * x, lb = tl >> 2, sb = tl & 3;
      f32x4 gt = (f32x4){0.f, 0.f, 0.f, 0.f};
      if (sb <= lb) gt = mma64(CM + lb * 16 * TS, TS, BM + sb * 16 * TS, TS, gt, fr, fq);
#pragma unroll
      for (int jj = 0; jj < 4; ++jj) {
        const int l = lb * 16 + fq * 4 + jj, sidx = sb * 16 + fr;
        float v = 0.f;
        if (l >= sidx) v = gt[jj] * __expf(ACUM[l] - ACUM[sidx]);
        MS[l * TS + sidx] = f2bf(v);
      }
    }
    __syncthreads();
    f32x4 snew[2];
#pragma unroll
    for (int x = 0; x < 2; ++x) {
      const int lb = wid >> 1, pb = (wid & 1) * 2 + x;
      f32x4 a = (f32x4){0.f, 0.f, 0.f, 0.f};
      a = mma64(MS + lb * 16 * TS, TS, XDTT + pb * 16 * TS, TS, a, fr, fq);
      a = mma64(CS + lb * 16 * TS, TS, STATE + pb * 16 * TS, TS, a, fr, fq);
#pragma unroll
      for (int jj = 0; jj < 4; ++jj) O32[(lb * 16 + fq * 4 + jj) * 65 + pb * 16 + fr] = a[jj];
      const int nb = (wid & 1) * 2 + x;
      const float dchunk = __expf(ACUM[63]);
      f32x4 sv = sacc[x];
#pragma unroll
      for (int jj = 0; jj < 4; ++jj) sv[jj] *= dchunk;
      sv = mma64(XDECT + (wid >> 1) * 16 * TS, TS, BMT + nb * 16 * TS, TS, sv, fr, fq);
      sacc[x] = sv; snew[x] = sv;
    }
    __syncthreads();
#pragma unroll
    for (int x = 0; x < 2; ++x) {
      const int nb = (wid & 1) * 2 + x;
#pragma unroll
      for (int jj = 0; jj < 4; ++jj) STATE[((wid >> 1) * 16 + fq * 4 + jj) * TS + nb * 16 + fr] = f2bf(snew[x][jj]);
    }
    {
      const int t = t0 + r2;
      float zz[8], xs[8], y[8];
      unpack8(zraw, zz); unpack8(*(const u32x4*)(XS + r2 * TS + c82), xs);
      float ss = 0.f;
#pragma unroll
      for (int i = 0; i < 8; ++i) y[i] = (O32[r2 * 65 + c82 + i] + dsk * xs[i]) * siluf_(zz[i]);
      const u32x4 w = pack8(y);
      float yr[8]; unpack8(w, yr);
#pragma unroll
      for (int i = 0; i < 8; ++i) ss += yr[i] * yr[i];
      ss = sum8(ss);
      if (cg2 == 0) atomicAdd(ssq + (size_t)t * 2 + grp, (u64)(ss * RSQ_SCALE + 0.5f));
      *(u32x4*)(Y + (size_t)t * 1024 + 256 + h * 64 + c82) = w;
    }
    __syncthreads();
  }
#undef SSD_PREFETCH
}

__device__ void attn_item(const Params& P, int layer, int item, unsigned char* smem) {
  int tid_ = threadIdx.x; asm volatile("" : "+v"(tid_));
  const int tid = tid_, wid = tid >> 6, lane = tid & 63, fr = lane & 15, fq = lane >> 4;
  const int cp = item & 15, h = (item >> 4) & 3, b = item >> 6;
  const int wq = wid >> 2, qb = wid & 3, r = tid >> 3, c8 = (tid & 7) * 8;
  bf16_t* KH = (bf16_t*)smem;
  bf16_t* VTT = KH + 2 * 64 * TS;
  float* BIAS = (float*)(smem + 4 * 64 * TS * 2);
  const bf16_t* proj = (const bf16_t*)(P.ws + OFF_PROJ);
  bf16_t* Y = (bf16_t*)(P.ws + OFF_Y);
  __syncthreads();
  if (tid < 257) BIAS[tid] = P.in[23][((size_t)layer * 4 + h) * 257 + tid];
  const int c0 = cp * 2, cme = c0 + wq;
  const size_t tb = (size_t)b * SEQ;
  bf16x8 qf[2];
  {
    const bf16_t* qp = proj + (tb + cme * 64 + qb * 16 + fr) * PW + 1792 + h * 64;
    float a[8], c[8]; unpack8(*(const u32x4*)(qp + fq * 8), a); unpack8(*(const u32x4*)(qp + 32 + fq * 8), c);
    float ss = 0.f;
#pragma unroll
    for (int i = 0; i < 8; ++i) ss += a[i] * a[i] + c[i] * c[i];
    ss += __shfl_xor(ss, 16); ss += __shfl_xor(ss, 32);
    const float rs = rsqrtf(ss * (1.0f / 64.0f) + EPSF) * 0.125f;
    const float* qg = P.in[21] + layer * 64;
#pragma unroll
    for (int i = 0; i < 8; ++i) { a[i] *= rs * qg[fq * 8 + i]; c[i] *= rs * qg[32 + fq * 8 + i]; }
    u32x4 wa = pack8(a), wc_ = pack8(c);
    qf[0] = *(bf16x8*)&wa; qf[1] = *(bf16x8*)&wc_;
  }
  float kgn[8];
#pragma unroll
  for (int i = 0; i < 8; ++i) kgn[i] = P.in[22][layer * 64 + c8 + i];
  f32x4 oacc[4];
#pragma unroll
  for (int d = 0; d < 4; ++d) oacc[d] = (f32x4){0.f, 0.f, 0.f, 0.f};
  float mrun = -1e30f, lrun = 0.f;
  const int cs = c0 - 8 > 0 ? c0 - 8 : 0, ce = c0 + 1;
  u32x4 nk, nv;
  { const bf16_t* kp = proj + (tb + cs * 64 + r) * PW + 2048 + h * 64 + c8; nk = *(const u32x4*)kp; nv = *(const u32x4*)(kp + 256); }
  for (int cc = cs; cc <= ce; ++cc) {
    const int buf = (cc - cs) & 1;
    {
      float kv[8], vv[8]; unpack8(nk, kv); unpack8(nv, vv);
      float ss = 0.f;
#pragma unroll
      for (int i = 0; i < 8; ++i) ss += kv[i] * kv[i];
      ss = sum8(ss);
      const float rs = rsqrtf(ss * (1.0f / 64.0f) + EPSF);
#pragma unroll
      for (int i = 0; i < 8; ++i) kv[i] *= rs * kgn[i];
      *(u32x4*)(KH + buf * 64 * TS + r * TS + c8) = pack8(kv);
#pragma unroll
      for (int i = 0; i < 8; ++i) VTT[buf * 64 * TS + (c8 + i) * TS + r] = f2bf(vv[i]);
    }
    __syncthreads();
    if (cc < ce) { const bf16_t* kp = proj + (tb + (cc + 1) * 64 + r) * PW + 2048 + h * 64 + c8; nk = *(const u32x4*)kp; nv = *(const u32x4*)(kp + 256); }
    const int j = cc - (cme - 8);
    if (j >= 0 && j <= 8) {
      const bf16_t* Kb = KH + buf * 64 * TS; const bf16_t* Vb = VTT + buf * 64 * TS;
      f32x4 s[4];
#pragma unroll
      for (int kt = 0; kt < 4; ++kt) {
        s[kt] = (f32x4){0.f, 0.f, 0.f, 0.f};
#pragma unroll
        for (int ks = 0; ks < 2; ++ks) { const bf16x8 a = *(const bf16x8*)(Kb + (kt * 16 + fr) * TS + ks * 32 + fq * 8); s[kt] = mfma16(a, qf[ks], s[kt]); }
      }
      const int qpos = qb * 16 + fr;
      float bv[4][4];
      if (j <= 5) {
        const float bc = BIAS[256];
#pragma unroll
        for (int kt = 0; kt < 4; ++kt)
#pragma unroll
          for (int jj = 0; jj < 4; ++jj) bv[kt][jj] = bc;
      } else {
#pragma unroll
        for (int kt = 0; kt < 4; ++kt)
#pragma unroll
          for (int jj = 0; jj < 4; ++jj) {
            const int kpos = j * 64 + kt * 16 + fq * 4 + jj;
            int rel = qpos + 512 - kpos; rel = rel > 128 ? 128 : (rel < -128 ? -128 : rel);
            bv[kt][jj] = BIAS[rel + 128];
          }
      }
      float mx = -1e30f;
#pragma unroll
      for (int kt = 0; kt < 4; ++kt)
#pragma unroll
        for (int jj = 0; jj < 4; ++jj) { const float v = s[kt][jj] + bv[kt][jj]; s[kt][jj] = v; mx = fmaxf(mx, v); }
      mx = fmaxf(mx, __shfl_xor(mx, 16)); mx = fmaxf(mx, __shfl_xor(mx, 32));
      const float mnew = fmaxf(mrun, mx), alpha = __expf(mrun - mnew);
      mrun = mnew;
      float ps = 0.f;
#pragma unroll
      for (int kt = 0; kt < 4; ++kt)
#pragma unroll
        for (int jj = 0; jj < 4; ++jj) { const float p = __expf(s[kt][jj] - mnew); s[kt][jj] = p; ps += p; }
      lrun = lrun * alpha + ps;
      bf16x8 pb[2];
#pragma unroll
      for (int k2 = 0; k2 < 2; ++k2) {
        u32x4 w; w[0] = pk2(s[2 * k2][0], s[2 * k2][1]); w[1] = pk2(s[2 * k2][2], s[2 * k2][3]); w[2] = pk2(s[2 * k2 + 1][0], s[2 * k2 + 1][1]); w[3] = pk2(s[2 * k2 + 1][2], s[2 * k2 + 1][3]);
        pb[k2] = *(bf16x8*)&w;
      }
#pragma unroll
      for (int d = 0; d < 4; ++d) {
#pragma unroll
        for (int e = 0; e < 4; ++e) oacc[d][e] *= alpha;
#pragma unroll
        for (int k2 = 0; k2 < 2; ++k2) {
          const bf16_t* vp = Vb + (d * 16 + fr) * TS + k2 * 32 + fq * 4;
          const u32x2 lo = *(const u32x2*)vp, hi = *(const u32x2*)(vp + 16);
          u32x4 w; w[0] = lo[0]; w[1] = lo[1]; w[2] = hi[0]; w[3] = hi[1];
          oacc[d] = mfma16(*(bf16x8*)&w, pb[k2], oacc[d]);
        }
      }
    }
  }
  lrun += __shfl_xor(lrun, 16); lrun += __shfl_xor(lrun, 32);
  const float il = frcp(lrun);
  bf16_t* yp = Y + (tb + cme * 64 + qb * 16 + fr) * 1024 + 768 + h * 64;
#pragma unroll
  for (int d = 0; d < 4; ++d) {
    u32x2 w; w[0] = pk2(oacc[d][0] * il, oacc[d][1] * il); w[1] = pk2(oacc[d][2] * il, oacc[d][3] * il);
    *(u32x2*)(yp + d * 16 + fq * 4) = w;
  }
}

__device__ void toep_build(const Params& P, int layer, int item) {
  item = lsg(item); layer = lsg(layer);
  const int g = item >> 4, nb = item & 15;
  const float* __restrict__ KTb = (const float*)(P.ws + OFF_SMALL + S_KT) + (size_t)(layer * 16 + g) * 64 * 256;
  const float* __restrict__ lam = (const float*)(P.ws + OFF_SMALL + S_LAM) + (size_t)(layer * 16 + g) * 64 * 65 * 2;
  const float* __restrict__ Cre = P.in[16] + (size_t)(layer * 16 + g) * 16 * 64;
  const float* __restrict__ Cim = P.in[17] + (size_t)(layer * 16 + g) * 16 * 64;
  bf16_t* __restrict__ dst = (bf16_t*)(P.ws + OFF_TOEP) + (size_t)g * 1024 * UK;
  const int tid = ltid();
#pragma unroll 3
  for (int idx = tid; idx < 64 * 144; idx += 512) {
    const int n = nb * 64 + idx / 144, k0 = (idx % 144) * 8;
    const int t = n >> 4, i = n & 15;
    float v[8];
    if (k0 < 1024) {
      const int sidx = k0 >> 4, i2 = k0 & 15;
      if (t >= sidx) {
        const f32x4 a0 = *(const f32x4*)(KTb + ((t - sidx) * 16 + i) * 16 + i2), a1 = *(const f32x4*)(KTb + ((t - sidx) * 16 + i) * 16 + i2 + 4);
#pragma unroll
        for (int e = 0; e < 4; ++e) { v[e] = a0[e]; v[4 + e] = a1[e]; }
      } else {
#pragma unroll
        for (int e = 0; e < 8; ++e) v[e] = 0.f;
      }
    } else {
      const int kk0 = k0 - 1024, part = kk0 >> 6, p0 = kk0 & 63;
#pragma unroll
      for (int e = 0; e < 8; ++e) {
        const int p = p0 + e;
        const float lr = lam[(p * 65 + t + 1) * 2], li = lam[(p * 65 + t + 1) * 2 + 1];
        const float cr = Cre[i * 64 + p], ci = Cim[i * 64 + p];
        v[e] = part == 0 ? (cr * lr - ci * li) : -(cr * li + ci * lr);
      }
    }
    *(u32x4*)(dst + (size_t)n * UK + k0) = pack8(v);
  }
}

struct WDesc { const float* src; const float* scale; bf16_t* dst; int ld, K, n0, k0, sc, nv; };
DEVI WDesc wdesc(const Params& P, int layer, int tl) {
  unsigned char* W = P.ws + OFF_W;
  WDesc d; int x = tl; d.nv = 64;
  if (x < 1792) {
    const int nt64 = x >> 4, kt = x & 15, pn = nt64 >> 2, sub = nt64 & 3;
    int sc;
    if (pn < 4) sc = pn * 256 + sub * 64; else if (pn == 4) sc = 1024 + sub * 64; else if (pn < 7) sc = 1280 + (pn - 5) * 256 + sub * 64;
    else if (pn == 7) sc = 1796 + sub * 64; else if (pn < 11) sc = 2052 + (pn - 8) * 256 + sub * 64;
    else if (pn == 11) { sc = 1792; d.nv = sub == 0 ? 4 : 0; } else sc = 2820 + (pn - 12) * 256 + sub * 64;
    d.src = P.in[3] + (size_t)layer * 1024 * 6916; d.ld = 6916; d.K = 1024; d.dst = (bf16_t*)(W + W_IN); d.scale = P.in[2] + layer * 1024; d.n0 = nt64 * 64; d.k0 = kt * 64; d.sc = sc; return d;
  }
  x -= 1792;
  if (x < 256) { const int m = x >> 6, y = x & 63, nt = y >> 2, kt = y & 3;
    d.src = P.in[24] + ((size_t)layer * 4 + m) * 256 * 1024; d.ld = 1024; d.K = 256; d.dst = (bf16_t*)(W + W_BR) + (size_t)m * 1024 * 256; d.scale = m == 1 ? P.in[11] + layer * 256 : nullptr; d.n0 = nt * 64; d.k0 = kt * 64; d.sc = nt * 64; return d; }
  x -= 256;
  if (x < 256) { const int nt = x >> 4, kt = x & 15;
    d.src = P.in[25] + (size_t)layer * 1024 * 1024; d.ld = 1024; d.K = 1024; d.dst = (bf16_t*)(W + W_OUT); d.scale = nullptr; d.n0 = nt * 64; d.k0 = kt * 64; d.sc = nt * 64; return d; }
  x -= 256;
  if (x < 1024) { const int nt = x >> 4, kt = x & 15;
    d.src = P.in[27] + (size_t)layer * 1024 * 4096; d.ld = 4096; d.K = 1024; d.dst = (bf16_t*)(W + W_FF1); d.scale = P.in[26] + layer * 1024; d.n0 = nt * 64; d.k0 = kt * 64; d.sc = nt * 64; return d; }
  x -= 1024;
  if (x < 1024) { const int nt = x >> 6, kt = x & 63;
    d.src = P.in[28] + (size_t)layer * 4096 * 1024; d.ld = 1024; d.K = 4096; d.dst = (bf16_t*)(W + W_FF2); d.scale = nullptr; d.n0 = nt * 64; d.k0 = kt * 64; d.sc = nt * 64; return d; }
  x -= 1024;
  if (x < 64) { const int nt = x >> 2, kt = x & 3;
    d.src = P.in[29] + (size_t)layer * 256 * 1024; d.ld = 1024; d.K = 256; d.dst = (bf16_t*)(W + W_PLE); d.scale = nullptr; d.n0 = nt * 64; d.k0 = kt * 64; d.sc = nt * 64; return d; }
  x -= 64;
  if (x < 256) { const int nt = x >> 4, kt = x & 15;
    d.src = P.in[31] + (size_t)layer * 1024 * 1024; d.ld = 1024; d.K = 1024; d.dst = (bf16_t*)(W + W_PG + (size_t)layer * 2 * MiB); d.scale = P.in[30] + layer * 1024; d.n0 = nt * 64; d.k0 = kt * 64; d.sc = nt * 64; return d; }
  x -= 256;
  { const int nt = x >> 2, kt = x & 3;
    d.src = P.in[20] + (size_t)layer * 256 * 256; d.ld = 256; d.K = 256; d.dst = (bf16_t*)(W + W_GLU); d.scale = nullptr; d.n0 = nt * 64; d.k0 = kt * 64; d.sc = nt * 64; return d; }
}
DEVI void wload(const WDesc& d, int tid, float* v) {
#pragma unroll
  for (int i = 0; i < 8; ++i) {
    const int idx = tid + 512 * i, kk = idx >> 6, nn = idx & 63;
    float x = 0.f;
    if (nn < d.nv) { x = d.src[(size_t)(d.k0 + kk) * d.ld + d.sc + nn]; if (d.scale) x *= d.scale[d.k0 + kk]; }
    v[i] = x;
  }
}
__device__ void prep_layer(const Params& P, int layer, unsigned char* smem) {
  layer = lsg(layer);
  float* tile = (float*)smem;
  const int tid = ltid(), G = gridDim.x;
  float cur[8], nxt[8];
  int tl = lbid();
  WDesc dc{};
  if (tl < 4688) { dc = wdesc(P, layer, tl); wload(dc, tid, cur); }
  for (; tl < 4688; tl += G) {
    WDesc dn{}; const bool has = tl + G < 4688;
    if (has) { dn = wdesc(P, layer, tl + G); wload(dn, tid, nxt); }
    __syncthreads();
#pragma unroll
    for (int i = 0; i < 8; ++i) { const int idx = tid + 512 * i, kk = idx >> 6, nn = idx & 63; tile[kk * 65 + nn] = cur[i]; }
    __syncthreads();
#pragma unroll
    for (int i = 0; i < 4; ++i) {
      const int idx = tid + 512 * i, nn = idx >> 5, kp = (idx & 31) * 2;
      *(unsigned*)(dc.dst + (size_t)(dc.n0 + nn) * dc.K + dc.k0 + kp) = pk2(tile[kp * 65 + nn], tile[(kp + 1) * 65 + nn]);
    }
    if (has) {
#pragma unroll
      for (int i = 0; i < 8; ++i) cur[i] = nxt[i];
      dc = dn;
    }
  }
  const float* __restrict__ lamL = (const float*)(P.ws + OFF_SMALL + S_LAM) + (size_t)layer * 16 * 64 * 65 * 2;
  const float* __restrict__ bbL = (const float*)(P.ws + OFF_SMALL + S_BB) + (size_t)layer * 16 * 64 * 16 * 2;
  bf16_t* __restrict__ mint = (bf16_t*)(P.ws + OFF_MINT);
#pragma unroll 4
  for (size_t idx = (size_t)lbid() * 512 + ltid(); idx < (size_t)16 * 256 * 512; idx += (size_t)gridDim.x * 512) {
    const int k0 = (int)(idx & 511) * 2, n = (int)(idx >> 9) & 255, g = (int)(idx >> 17);
    float v[2] = {0.f, 0.f};
    if (n < 128) {
      const int p = n & 63;
#pragma unroll
      for (int e = 0; e < 2; ++e) {
        const int k = k0 + e, s = k >> 4, i2 = k & 15;
        const float lr = lamL[((size_t)(g * 64 + p) * 65 + (63 - s)) * 2], li = lamL[((size_t)(g * 64 + p) * 65 + (63 - s)) * 2 + 1];
        const float br = bbL[((size_t)(g * 64 + p) * 16 + i2) * 2], bi = bbL[((size_t)(g * 64 + p) * 16 + i2) * 2 + 1];
        v[e] = n < 64 ? (lr * br - li * bi) : (lr * bi + li * br);
      }
    }
    *(unsigned*)(mint + ((size_t)(g * 256 + n) * 1024 + k0)) = pk2(v[0], v[1]);
  }
}

__device__ void merge_phase(const Params& P, int layer, unsigned char* smem) {
  int tid_ = threadIdx.x; asm volatile("" : "+v"(tid_));
  const int tid = tid_, wid = tid >> 6, lane = tid & 63, fr = lane & 15, fq = lane >> 4, wr = wid >> 2, wc = wid & 3;
  constexpr int LS = 136, BUFE = 2 * 128 * LS;
  bf16_t* L0 = (bf16_t*)smem;
  const bf16_t* Y = (const bf16_t*)(P.ws + OFF_Y);
  const bf16_t* Wb = (const bf16_t*)(P.ws + OFF_W + W_BR);
  const unsigned char* gates = P.ws + OFF_GATES;
  bf16_t* merged = (bf16_t*)(P.ws + OFF_MERGED);
  const int cid = lbid(), G = gridDim.x;
  const int ntile = (2048 - cid + G - 1) / G, total = ntile * 8;
  const u64* ssq = (const u64*)(P.ws + OFF_SMALL + S_SSQ) + (size_t)lsg(layer) * T_TOK * 2;
  u32x4 pa0[4], pa1[4], pbx[4];
  unsigned gw[4][2];
  float rc0[4], rc1[4];
  f32x4 mg[4][2], acc[4][2];
#pragma unroll
  for (int a = 0; a < 4; ++a)
#pragma unroll
    for (int n = 0; n < 2; ++n) { mg[a][n] = (f32x4){0.f, 0.f, 0.f, 0.f}; acc[a][n] = (f32x4){0.f, 0.f, 0.f, 0.f}; }
#define MG_LOADA(g_, pa) do { const int gc_ = (g_) < total ? (g_) : total - 1; \
    const int tile_ = cid + (gc_ >> 3) * G, s_ = gc_ & 7, m_ = s_ >> 1, kh_ = s_ & 1, r0_ = (tile_ >> 3) * 128; \
    _Pragma("unroll") for (int i = 0; i < 4; ++i) { const int idx = tid + 512 * i, rr = idx >> 4, pc = idx & 15; \
      pa[i] = *(const u32x4*)(Y + (size_t)(r0_ + rr) * 1024 + m_ * 256 + kh_ * 128 + pc * 8); } } while (0)
#define MG_LOADB(g_, pb) do { const int gc_ = (g_) < total ? (g_) : total - 1; \
    const int tile_ = cid + (gc_ >> 3) * G, s_ = gc_ & 7, m_ = s_ >> 1, kh_ = s_ & 1, c0_ = (tile_ & 7) * 128; \
    _Pragma("unroll") for (int i = 0; i < 4; ++i) { const int idx = tid + 512 * i, rr = idx >> 4, pc = idx & 15; \
      pb[i] = *(const u32x4*)(Wb + ((size_t)m_ * 1024 + c0_ + rr) * 256 + kh_ * 128 + pc * 8); } } while (0)
#define MG_LOADG(g_, gq, r0v, r1v) do { const int gc_ = (g_) < total ? (g_) : total - 2; \
    const int tile_ = cid + (gc_ >> 3) * G, m_ = (gc_ & 7) >> 1, r0_ = (tile_ >> 3) * 128, c0_ = (tile_ & 7) * 128; \
    _Pragma("unroll") for (int a = 0; a < 4; ++a) { const int row_ = r0_ + wr * 64 + a * 16 + fr; \
      _Pragma("unroll") for (int n = 0; n < 2; ++n) gq[a][n] = *(const unsigned*)(gates + (size_t)row_ * 4096 + m_ * 1024 + c0_ + wc * 32 + n * 16 + fq * 4); \
      r0v[a] = (float)ssq[(size_t)row_ * 2]; r1v[a] = (float)ssq[(size_t)row_ * 2 + 1]; } } while (0)
#define MG_STORE(buf_, pa, pb) do { bf16_t* A_ = L0 + (buf_) * BUFE; bf16_t* B_ = A_ + 128 * LS; \
    _Pragma("unroll") for (int i = 0; i < 4; ++i) { const int idx = tid + 512 * i, rr = idx >> 4, pc = idx & 15; \
      *(u32x4*)(A_ + rr * LS + pc * 8) = pa[i]; *(u32x4*)(B_ + rr * LS + pc * 8) = pb[i]; } } while (0)
#define MG_COMPUTE(buf) do { const bf16_t* As = L0 + (buf) * BUFE; const bf16_t* Bs = As + 128 * LS; \
    _Pragma("unroll") for (int k = 0; k < 4; ++k) { \
      bf16x8 af[4], bfr[2]; \
      _Pragma("unroll") for (int a = 0; a < 4; ++a) af[a] = *(const bf16x8*)(As + (wr * 64 + a * 16 + fr) * LS + k * 32 + fq * 8); \
      _Pragma("unroll") for (int n = 0; n < 2; ++n) bfr[n] = *(const bf16x8*)(Bs + (wc * 32 + n * 16 + fr) * LS + k * 32 + fq * 8); \
      _Pragma("unroll") for (int a = 0; a < 4; ++a) _Pragma("unroll") for (int n = 0; n < 2; ++n) acc[a][n] = mfma16(bfr[n], af[a], acc[a][n]); } } while (0)
#define MG_GATE(rv, isb) do { \
    _Pragma("unroll") for (int a = 0; a < 4; ++a) { \
      const float rsq_ = rsqrtf(rv[a] * (1.0f / (16777216.0f * 128.0f)) + EPSF) * (1.0f / 255.0f); \
      const float rs1 = (isb) ? rsq_ : (1.0f / 255.0f); \
      _Pragma("unroll") for (int n = 0; n < 2; ++n) { \
        _Pragma("unroll") for (int e = 0; e < 4; ++e) mg[a][n][e] += acc[a][n][e] * ((float)((gw[a][n] >> (8 * e)) & 255u) * rs1); \
        acc[a][n] = (f32x4){0.f, 0.f, 0.f, 0.f}; } } } while (0)
  MG_LOADA(0, pa0); MG_LOADB(0, pbx); MG_LOADG(0, gw, rc0, rc1);
  MG_STORE(0, pa0, pbx);
  MG_LOADA(1, pa1);
  __syncthreads();
  for (int g = 0; g < total; g += 2) {
    const int tile = cid + (g >> 3) * G, s = g & 7, m = s >> 1, row0 = (tile >> 3) * 128, col0 = (tile & 7) * 128;
    const bool isb = (m == 1);
    MG_LOADB(g + 1, pbx); MG_LOADA(g + 2, pa0);
    MG_COMPUTE(0);
    MG_GATE(rc0, isb);
    MG_STORE(1, pa1, pbx);
    __syncthreads();
    MG_LOADB(g + 2, pbx); MG_LOADA(g + 3, pa1);
    MG_COMPUTE(1);
    MG_GATE(rc1, isb);
    if (s == 6) {
#pragma unroll
      for (int a = 0; a < 4; ++a) {
        const int row = row0 + wr * 64 + a * 16 + fr;
#pragma unroll
        for (int n = 0; n < 2; ++n) {
          u32x2 w; w[0] = pk2(mg[a][n][0], mg[a][n][1]); w[1] = pk2(mg[a][n][2], mg[a][n][3]);
          *(u32x2*)(merged + (size_t)row * 1024 + col0 + wc * 32 + n * 16 + fq * 4) = w;
          mg[a][n] = (f32x4){0.f, 0.f, 0.f, 0.f};
        }
      }
    }
    MG_LOADG(g + 2, gw, rc0, rc1);
    MG_STORE(0, pa0, pbx);
    __syncthreads();
  }
#undef MG_LOADA
#undef MG_LOADB
#undef MG_LOADG
#undef MG_STORE
#undef MG_COMPUTE
#undef MG_GATE
}

__device__ void prep_global_a(const Params& P) {
  const int tid = ltid(), wid = tid >> 6, lane = tid & 63;
  u64* __restrict__ rowsq = (u64*)(P.ws + OFF_SMALL + S_ROWSQ);
  bf16_t* __restrict__ xb = (bf16_t*)(P.ws + OFF_XB);
  const float* __restrict__ x = P.in[0];
#pragma unroll 2
  for (int row = lbid() * 8 + wid; row < T_TOK; row += gridDim.x * 8) {
    float ss = 0.f;
#pragma unroll
    for (int i = 0; i < 2; ++i) {
      const size_t o = (size_t)row * 1024 + i * 512 + lane * 8;
      const f32x4 a = *(const f32x4*)(x + o), c = *(const f32x4*)(x + o + 4);
      u32x4 w; w[0] = pk2(a[0], a[1]); w[1] = pk2(a[2], a[3]); w[2] = pk2(c[0], c[1]); w[3] = pk2(c[2], c[3]);
      *(u32x4*)(xb + o) = w;
#pragma unroll
      for (int e = 0; e < 4; ++e) ss += a[e] * a[e] + c[e] * c[e];
    }
#pragma unroll
    for (int d = 1; d < 64; d <<= 1) ss += __shfl_xor(ss, d);
    if (lane == 0) rowsq[row] = (u64)(ss * RSQ_SCALE + 0.5f);
  }
  const size_t gt = (size_t)lbid() * 512 + tid, gn = (size_t)gridDim.x * 512;
  for (size_t i = gt; i < (size_t)6 * T_TOK; i += gn) rowsq[T_TOK + i] = 0ull;
  { u64* ssqz = (u64*)(P.ws + OFF_SMALL + S_SSQ); for (size_t i = gt; i < (size_t)4 * T_TOK; i += gn) ssqz[i] = 0ull; }
  int* ctr = (int*)(P.ws + OFF_SMALL + S_CTR);
  if (lbid() == 0 && tid < 64) ctr[tid] = 0;
  float* lam = (float*)(P.ws + OFF_SMALL + S_LAM);
  float* bb = (float*)(P.ws + OFF_SMALL + S_BB);
  for (size_t i = gt; i < (size_t)2 * 16 * 64 * 65; i += gn) {
    const int tau = (int)(i % 65), gp = (int)(i / 65), L = gp >> 10, g = (gp >> 6) & 15;
    const double are = (double)P.in[12][gp], aim = (double)P.in[13][gp], step = exp((double)P.in[19][L * 16 + g]);
    const double mag = exp(are * step * (double)tau), ang = aim * step * (double)tau;
    lam[i * 2] = (float)(mag * cos(ang)); lam[i * 2 + 1] = (float)(mag * sin(ang));
  }
  for (size_t i = gt; i < (size_t)2 * 16 * 64 * 16; i += gn) {
    const int gp = (int)(i >> 4), L = gp >> 10, g = (gp >> 6) & 15;
    const double are = (double)P.in[12][gp], aim = (double)P.in[13][gp], step = exp((double)P.in[19][L * 16 + g]);
    const double mag = exp(are * step), lr = mag * cos(aim * step), li = mag * sin(aim * step);
    const double den = are * are + aim * aim, nr = lr - 1.0;
    const double cr = (nr * are + li * aim) / den, ci = (li * are - nr * aim) / den;
    const double br = (double)P.in[14][i], bi = (double)P.in[15][i];
    bb[i * 2] = (float)(cr * br - ci * bi); bb[i * 2 + 1] = (float)(cr * bi + ci * br);
  }
}
__device__ void prep_global_b(const Params& P) {
  const float* lam = (const float*)(P.ws + OFF_SMALL + S_LAM);
  const float* bb = (const float*)(P.ws + OFF_SMALL + S_BB);
  float* KT = (float*)(P.ws + OFF_SMALL + S_KT);
  for (size_t idx = (size_t)lbid() * 512 + ltid(); idx < (size_t)2 * 16 * 64 * 256; idx += (size_t)gridDim.x * 512) {
    const int i2 = (int)(idx & 15), i = (int)(idx >> 4) & 15, tau = (int)(idx >> 8) & 63, Lg = (int)(idx >> 14);
    const float* cre = P.in[16] + ((size_t)Lg * 16 + i) * 64; const float* cim = P.in[17] + ((size_t)Lg * 16 + i) * 64;
    float acc = 0.f;
    for (int p = 0; p < 64; ++p) {
      const float lr = lam[((size_t)(Lg * 64 + p) * 65 + tau) * 2], li = lam[((size_t)(Lg * 64 + p) * 65 + tau) * 2 + 1];
      const float br = bb[((size_t)(Lg * 64 + p) * 16 + i2) * 2], bi = bb[((size_t)(Lg * 64 + p) * 16 + i2) * 2 + 1];
      const float xr = lr * br - li * bi, xi = lr * bi + li * br;
      acc += cre[p] * xr - cim[p] * xi;
    }
    KT[idx] = acc;
  }
}
__device__ void convert_p(const Params& P, int layer) {
  layer = lsg(layer);
  const float* __restrict__ src = P.in[1] + (size_t)layer * T_TOK * 256;
  bf16_t* __restrict__ dst = (bf16_t*)(P.ws + OFF_PB);
#pragma unroll 4
  for (size_t i = ((size_t)lbid() * 512 + ltid()) * 8; i < (size_t)T_TOK * 256; i += (size_t)gridDim.x * 512 * 8) {
    const f32x4 a = *(const f32x4*)(src + i), c = *(const f32x4*)(src + i + 4);
    u32x4 w; w[0] = pk2(a[0], a[1]); w[1] = pk2(a[2], a[3]); w[2] = pk2(c[0], c[1]); w[3] = pk2(c[2], c[3]);
    *(u32x4*)(dst + i) = w;
  }
}


#define XB_TMO      128
#define XB_XCNT(j)  (256  + 64 * (j))
#define XB_XSUB(j)  (1280 + 64 * (j))
#define XB_XGEN(j)  (2304 + 64 * (j))
#define XB_TOP      3328
#define XB_TOPGEN   3392
#define XCD_BAR_WORDS 3456
#define XB_SPIN_CAP (1u << 18)
DEVI unsigned xb_ld(unsigned* p) { return __hip_atomic_load(p, __ATOMIC_RELAXED, __HIP_MEMORY_SCOPE_AGENT); }
DEVI unsigned xb_add(unsigned* p, unsigned v) { return __hip_atomic_fetch_add(p, v, __ATOMIC_RELAXED, __HIP_MEMORY_SCOPE_AGENT); }
DEVI unsigned xb_xcc_id() { return (unsigned)__builtin_amdgcn_s_getreg((3 << 11) | 20) & 0xFu; }
#define XB_SPIN(cond, bar) do { unsigned _sp = 0; while (cond) { __builtin_amdgcn_s_sleep(1); \
    if ((++_sp & 255u) == 0u) { if (xb_ld(&(bar)[XB_TMO])) break; if (_sp > XB_SPIN_CAP) { atomicAdd(&(bar)[XB_TMO], 1u); break; } } } } while (0)
struct XcdBarrier { unsigned* bar; unsigned x; volatile LAS unsigned* st; };
DEVI XcdBarrier xcd_barrier_post(unsigned* bar, volatile LAS unsigned* st) {
  XcdBarrier b; b.bar = bar; b.x = xb_xcc_id(); b.st = st;
  if (threadIdx.x == 0) (void)xb_add(&bar[XB_XCNT(b.x)], 1u);
  return b;
}
DEVI void xcd_barrier_complete(unsigned* bar, unsigned x, unsigned& nloc, unsigned& nx) {
  const unsigned G = gridDim.x * gridDim.y * gridDim.z;
  unsigned sum, cnt, mine, sp = 0u;
  for (;;) {
    sum = 0u; cnt = 0u; mine = 0u;
#pragma unroll
    for (unsigned j = 0; j < 16; ++j) { const unsigned c = xb_ld(&bar[XB_XCNT(j)]); sum += c; cnt += (c > 0u) ? 1u : 0u; mine = (j == x) ? c : mine; }
    if (sum == G) break;
    __builtin_amdgcn_s_sleep(1);
    if ((++sp & 255u) == 0u) { if (xb_ld(&bar[XB_TMO])) break; if (sp > XB_SPIN_CAP) { atomicAdd(&bar[XB_TMO], 1u); break; } }
  }
  nloc = mine > 0u ? mine : 1u; nx = cnt > 0u ? cnt : 1u;
}
DEVI void xcd_barrier(unsigned* bar_, volatile LAS unsigned* st_) {
  XcdBarrier b; b.bar = bar_; b.st = st_; b.x = xb_xcc_id();
  asm volatile("s_waitcnt vmcnt(0)" ::: "memory");
  __syncthreads();
  if (ltid() == 0) {
    unsigned* bar = b.bar;
    __builtin_amdgcn_s_waitcnt(0);
    unsigned nloc = b.st[0], nx = b.st[1];
    if (nloc == 0u) { xcd_barrier_complete(bar, b.x, nloc, nx); b.st[0] = nloc; b.st[1] = nx; }
    const unsigned old = xb_add(&bar[XB_XSUB(b.x)], 1u);
    const unsigned gen = old / nloc;
    if (old + 1u == (gen + 1u) * nloc) {
      __builtin_amdgcn_fence(__ATOMIC_RELEASE, "agent");
      asm volatile("s_waitcnt vmcnt(0)" ::: "memory");
      const unsigned og = xb_add(&bar[XB_TOP], 1u);
      const unsigned tg = og / nx;
      if (og + 1u == (tg + 1u) * nx) xb_add(&bar[XB_TOPGEN], 1u);
      else XB_SPIN(xb_ld(&bar[XB_TOPGEN]) == tg, bar);
      __builtin_amdgcn_fence(__ATOMIC_ACQUIRE, "agent");
      xb_add(&bar[XB_XGEN(b.x)], 1u);
      asm volatile("s_waitcnt vmcnt(0)" ::: "memory");
    } else {
      XB_SPIN(xb_ld(&bar[XB_XGEN(b.x)]) == gen, bar);
      __builtin_amdgcn_fence(__ATOMIC_ACQUIRE, "agent");
      asm volatile("s_waitcnt vmcnt(0)" ::: "memory");
    }
  }
  __syncthreads();
}

#ifdef PROBE_A
#define TS(k) do { if (cid == 0 && ltid() == 0) ((unsigned long long*)(lptr(P.ws) + OFF_SMALL + S_BAR + 16384))[(k)] = __builtin_amdgcn_s_memrealtime(); } while (0)
#else
#define TS(k) do {} while (0)
#endif
template <int MODE>
__global__ void __launch_bounds__(512) mega(Params P) {
  extern __shared__ __attribute__((aligned(16))) unsigned char smem[];
  cg::grid_group grid = cg::this_grid();
  (void)grid;
  LAS unsigned char* lds = (LAS unsigned char*)smem;
  int* qslot = (int*)(smem + LDS_BYTES - 16);
#define PHASE_PTRS unsigned char* ws = lptr(P.ws); u64* rowsq = (u64*)(ws + OFF_SMALL + S_ROWSQ); bf16_t* xb = (bf16_t*)(ws + OFF_XB); (void)rowsq; (void)xb;
  const int G = gridDim.x, cid = lbid();

  {
    volatile LAS unsigned* stw = (volatile LAS unsigned*)(lds + LDS_BYTES - 64);
    if (threadIdx.x < 4) stw[threadIdx.x] = 0u;
    unsigned* barw = (unsigned*)(P.ws + OFF_SMALL + S_BAR);
    if (cid == 0) for (int i = threadIdx.x; i < XCD_BAR_WORDS; i += 512) barw[i] = 0u;
  }
  TS(0);
  if (MODE == 0 || MODE == 10) prep_global_a(P);
  if (MODE == 0) grid.sync();
  TS(1);
  if (MODE == 0) (void)xcd_barrier_post((unsigned*)(P.ws + OFF_SMALL + S_BAR), (volatile LAS unsigned*)(lds + LDS_BYTES - 64));
#define GRID_BAR() if (MODE == 0) xcd_barrier((unsigned*)(lptr(P.ws) + OFF_SMALL + S_BAR), (volatile LAS unsigned*)(lds + LDS_BYTES - 64))
  if (MODE == 0 || MODE == 10) { prep_global_b(P); prep_layer(P, lsg(0), smem); }
  GRID_BAR();
  TS(2);

#pragma unroll 1
  for (int layer = (MODE == 0 ? 0 : 1); layer < 2; ++layer) {
    if (MODE == 0 || MODE == 1)
    for (int rep = 0; rep < REP_A; ++rep) {
      PHASE_PTRS
      Gemm g{layer == 0 ? xb : (const bf16_t*)(ws + OFF_Y), (const bf16_t*)(ws + OFF_W + W_IN), 1024, 1024, 1024, 0, 0};
      pg8::StaticOrder S; S.init(128, 28, G, cid);
      EpiG1 E{rowsq + (size_t)(3 * layer) * T_TOK, (bf16_t*)(ws + OFF_PROJ), (bf16_t*)(ws + OFF_U), (float*)(ws + OFF_SMALL + S_DT), ws + OFF_GATES};
      pg8::gemm_phase(lds, g, S, E);
    }
    GRID_BAR();
    TS(2 + 10 * layer + 1);
    if (MODE == 21) for (int it = cid; it < 64; it += G) ssd_seq(P, layer, it, smem);
    if (MODE == 22) for (int it = cid; it < 64; it += G) hgrn2_seq(P, layer, it, smem);
    if (MODE == 23) for (int it = cid; it < 1024; it += G) attn_item(P, layer, it, smem);
    if (MODE == 0 || MODE == 2)
    {
      PHASE_PTRS
      int* q = (int*)(ws + OFF_SMALL + S_CTR) + layer * 8 + (MODE == 0 ? 0 : 32);
      int* cS5 = q + 1; int* cBuild = q + 2; int* cToep = q + 3;
      for (;;) {
        const int it = qpop(q, qslot);
        if (it >= 1696) break;
        if (it < 64) ssd_seq(P, layer, it, smem);
        else if (it < 128) hgrn2_seq(P, layer, it - 64, smem);
        else if (it < 160) {
          const int x = it - 128;
          Gemm g{(const bf16_t*)(ws + OFF_U), (const bf16_t*)(ws + OFF_MINT), UK, 1024, 1024, (size_t)512 * UK * 2, (size_t)256 * 1024 * 2};
          pg8::OneUnit S; S.u = Unit{x & 1, 0, x >> 1};
          EpiS5in E{(bf16_t*)(ws + OFF_U), (const float*)(ws + OFF_SMALL + S_LAM) + (size_t)layer * 16 * 64 * 65 * 2};
          pg8::gemm_phase(lds, g, S, E);
          dep_publish(cS5);
        }
        else if (it < 416) { toep_build(P, layer, it - 160); dep_publish(cBuild); }
        else if (it < 928) attn_item(P, layer, it - 416, smem);
        else if (it < 1056) {
          const int x = it - 928;
          dep_wait(cS5, 32); dep_wait(cBuild, 256);
          Gemm g{(const bf16_t*)(ws + OFF_U), (const bf16_t*)(ws + OFF_TOEP), UK, UK, UK, (size_t)512 * UK * 2, (size_t)1024 * UK * 2};
          pg8::OneUnit S; S.u = Unit{(x >> 2) & 1, x & 3, x >> 3};
          EpiToep E{(const bf16_t*)(ws + OFF_U), P.in[18] + layer * 256, (bf16_t*)(ws + OFF_Y)};
          pg8::gemm_phase(lds, g, S, E);
          dep_publish(cToep);
        }
        else if (it < 1568) attn_item(P, layer, it - 1056 + 512, smem);
        else {
          const int x = it - 1568;
          dep_wait(cToep, 128);
          Gemm g{(const bf16_t*)(ws + OFF_Y) + 512, (const bf16_t*)(ws + OFF_W + W_GLU), 1024, 256, 256, 0, 0};
          pg8::OneUnit S; S.u = Unit{x, 0, 0};
          EpiGLU E{(bf16_t*)(ws + OFF_Y)};
          pg8::gemm_phase(lds, g, S, E);
        }
      }
    }
    GRID_BAR();
    TS(2 + 10 * layer + 2);
    if (MODE == 0 || MODE == 5)
    for (int rep = 0; rep < REP_C; ++rep) merge_phase(P, layer, smem);
    GRID_BAR();
    TS(2 + 10 * layer + 5);
    if (MODE == 0 || MODE == 6) {
    convert_p(P, layer);
    {
      PHASE_PTRS
      Gemm g{(const bf16_t*)(ws + OFF_MERGED), (const bf16_t*)(ws + OFF_W + W_OUT), 1024, 1024, 1024, 0, 0};
      pg8::StaticOrder S; S.init(128, 4, G, cid);
      EpiRes<true> E{layer == 0 ? P.in[0] : P.out, xb, rowsq + (size_t)(3 * layer + 1) * T_TOK};
      pg8::gemm_phase(lds, g, S, E);
    }
    }
    GRID_BAR();
    TS(2 + 10 * layer + 6);
    if (MODE == 0 || MODE == 7) {
    for (int rep = 0; rep < REP_E; ++rep) {
      PHASE_PTRS
      Gemm g{xb, (const bf16_t*)(ws + OFF_W + W_FF1), 1024, 1024, 1024, 0, 0};
      pg8::StaticOrder S; S.init(128, 16, G, cid);
      EpiFF1 E{rowsq + (size_t)(3 * layer + 1) * T_TOK, (bf16_t*)(ws + OFF_HID)};
      pg8::gemm_phase(lds, g, S, E);
    }
    {
      PHASE_PTRS
      Gemm g{(const bf16_t*)(ws + OFF_PB), (const bf16_t*)(ws + OFF_W + W_PLE), 256, 256, 256, 0, 0};
      pg8::StaticOrder S; S.init(128, 4, G, cid);
      EpiPle E{(bf16_t*)(ws + OFF_PLE)};
      pg8::gemm_phase(lds, g, S, E);
    }
    }
    GRID_BAR();
    TS(2 + 10 * layer + 7);
    if (MODE == 0 || MODE == 8)
    {
      PHASE_PTRS
      Gemm g{(const bf16_t*)(ws + OFF_HID), (const bf16_t*)(ws + OFF_W + W_FF2), 4096, 4096, 4096, 0, 0};
      pg8::StaticOrder S; S.init(128, 4, G, cid);
      EpiRes<false> E{nullptr, xb, rowsq + (size_t)(3 * layer + 2) * T_TOK};
      pg8::gemm_phase(lds, g, S, E);
    }
    GRID_BAR();
    TS(2 + 10 * layer + 8);
    if (MODE == 0 || MODE == 9) {
    {
      PHASE_PTRS
      Gemm g{xb, (const bf16_t*)(ws + OFF_W + W_PG + (size_t)layer * 2 * MiB), 1024, 1024, 1024, 0, 0};
      pg8::StaticOrder S; S.init(128, 4, G, cid);
      EpiPG E{rowsq + (size_t)(3 * layer + 2) * T_TOK, (const bf16_t*)(ws + OFF_PLE), xb, P.out, (bf16_t*)(ws + OFF_Y), rowsq + (size_t)(3 * layer + 3) * T_TOK, layer == 1};
      pg8::gemm_phase(lds, g, S, E);
    }
    }
    if (MODE == 0 && layer == 0) { __syncthreads(); prep_layer(P, lsg(1), smem); }
    if (MODE == 11) prep_layer(P, lsg(1), smem);
    GRID_BAR();
    TS(2 + 10 * layer + 9);
  }
#ifdef PROBE_A
  __threadfence(); __syncthreads();
  if (cid == 0) {
    const unsigned long long* ts = (const unsigned long long*)(lptr(P.ws) + OFF_SMALL + S_BAR + 16384);
    auto dur = [&](int k) -> float {
      if (k == 99) return (float)(ts[21] - ts[0]) * 0.01f;
      if (k <= 2) return (float)(ts[k] - ts[k - 1]) * 0.01f;
      const int j = k - 2; float d = 0.f;
      for (int L = 0; L < 2; ++L) { const int hi = 2 + 10 * L + j, lo = (j == 1) ? (L == 0 ? 2 : 11) : hi - 1; d += (float)(ts[hi] - ts[lo]) * 0.01f; }
      return d; };
    const float dA = dur(PROBE_A), dB = dur(PROBE_B);
    if (ltid() == 0) P.out[0] += dA;
    for (int i = ltid(); i < (1 << 20); i += 512) P.out[1024 + i] += 0.01f * dB;
  }
#endif
}

extern "C" void kernel_launch(void* const* d_in, const int* in_sizes, int n_in, void* d_out, int out_size, void* d_ws, size_t ws_size, hipStream_t stream) {
  static int grid_blocks = 0;
  if (ws_size < WS_NEED) { fprintf(stderr, "workspace too small: %zu < %zu\n", ws_size, (size_t)WS_NEED); return; }
  if (!grid_blocks) {
    int dev = 0, cus = 0, per_cu = 0;
    hipGetDevice(&dev);
    hipDeviceGetAttribute(&cus, hipDeviceAttributeMultiprocessorCount, dev);
    hipFuncSetAttribute((const void*)mega<0>, hipFuncAttributeMaxDynamicSharedMemorySize, LDS_BYTES);
    hipOccupancyMaxActiveBlocksPerMultiprocessor(&per_cu, mega<0>, 512, LDS_BYTES);
#ifdef PROBE_MODE
    hipFuncSetAttribute((const void*)mega<PROBE_MODE>, hipFuncAttributeMaxDynamicSharedMemorySize, LDS_BYTES);
#endif
    if (per_cu < 1) per_cu = 1;
    grid_blocks = cus * per_cu;
    if (grid_blocks > 256) grid_blocks = 256;
  }
  Params P{};
  for (int i = 0; i < 32; ++i) P.in[i] = (const float*)d_in[i];
  P.out = (float*)d_out; P.ws = (unsigned char*)d_ws;
  void* args[] = {&P};
  hipError_t e = hipLaunchCooperativeKernel((void*)mega<0>, dim3(grid_blocks), dim3(512), args, LDS_BYTES, stream);
  if (e != hipSuccess) fprintf(stderr, "cooperative launch failed: %s (grid %d)\n", hipGetErrorString(e), grid_blocks);
#ifdef PROBE_MODE
  { Params P2 = P; P2.out = (float*)d_ws; hipLaunchKernelGGL(mega<PROBE_MODE>, dim3(grid_blocks), dim3(512), LDS_BYTES, stream, P2); }
#endif
}
```

```cpp
#include <hip/hip_runtime.h>
#include <hip/hip_cooperative_groups.h>
#include <cstdio>
namespace cg = cooperative_groups;

#define DEVI __device__ __forceinline__
#define LAS __attribute__((address_space(3)))
typedef unsigned short bf16_t;
typedef short bf16x8 __attribute__((ext_vector_type(8)));
typedef short bf16x4 __attribute__((ext_vector_type(4)));
typedef float f32x4 __attribute__((ext_vector_type(4)));
typedef unsigned u32x4 __attribute__((ext_vector_type(4)));
typedef unsigned u32x2 __attribute__((ext_vector_type(2)));

constexpr int T_TOK = 32768, DM = 1024, SEQ = 2048, NCH = 32;
constexpr int PW = 2560;
constexpr int UK = 1152;
constexpr float EPSF = 1e-6f;
constexpr size_t MiB = 1024ull * 1024ull;
constexpr size_t OFF_GATES = 0, OFF_HID = 0, OFF_Y = 128 * MiB, OFF_PROJ = 192 * MiB, OFF_MERGED = 192 * MiB, OFF_PLE = 256 * MiB,
                 OFF_PB = 320 * MiB, OFF_XB = 352 * MiB, OFF_TOEP = 352 * MiB, OFF_W = 416 * MiB, OFF_MINT = 456 * MiB, OFF_U = 464 * MiB,
                 OFF_SMALL = 483 * MiB, WS_NEED = 493 * MiB;
constexpr size_t W_IN = 0, W_BR = 14 * MiB, W_OUT = 16 * MiB, W_FF1 = 18 * MiB, W_FF2 = 26 * MiB, W_PLE = 34 * MiB, W_GLU = 34 * MiB + 512 * 1024,
                 W_PG = 35 * MiB  ;
constexpr size_t S_ROWSQ = 6 * MiB, S_KT = 1 * MiB, S_LAM = 3 * MiB, S_BB = 3 * MiB + 1280 * 1024, S_DT = 5 * MiB, S_CTR = 5 * MiB + 512 * 1024, S_BAR = 5 * MiB + 768 * 1024, S_SSQ = 8 * MiB;
constexpr int LDS_BYTES = 152 * 1024;
#ifndef REP_A
#define REP_A 1
#endif
#ifndef REP_B1
#define REP_B1 1
#endif
#ifndef REP_B3
#define REP_B3 1
#endif
#ifndef REP_C
#define REP_C 1
#endif
#ifndef REP_E
#define REP_E 1
#endif

struct Params { const float* in[32]; float* out; unsigned char* ws; };

DEVI int ltid() { int t = threadIdx.x; asm volatile("" : "+v"(t)); return t; }
DEVI int lbid() { int b = blockIdx.x; asm volatile("" : "+s"(b)); return b; }
DEVI unsigned char* lptr(unsigned char* p) { asm volatile("" : "+s"(p)); return p; }
DEVI int lsg(int v) { asm volatile("" : "+s"(v)); return v; }
DEVI float bf2f(unsigned v) { return __uint_as_float(v << 16); }
DEVI bf16_t f2bf(float f) { unsigned u = __float_as_uint(f); u += 0x7FFFu + ((u >> 16) & 1u); return (bf16_t)(u >> 16); }
DEVI unsigned pk2(float lo, float hi) { unsigned r; asm volatile("v_cvt_pk_bf16_f32 %0, %1, %2" : "=v"(r) : "v"(lo), "v"(hi)); return r; }
DEVI void unpack8(u32x4 w, float* f) {
#pragma unroll
  for (int i = 0; i < 4; ++i) { f[2 * i] = __uint_as_float(w[i] << 16); f[2 * i + 1] = __uint_as_float(w[i] & 0xffff0000u); }
}
DEVI u32x4 pack8(const float* f) { u32x4 w; w[0] = pk2(f[0], f[1]); w[1] = pk2(f[2], f[3]); w[2] = pk2(f[4], f[5]); w[3] = pk2(f[6], f[7]); return w; }
typedef unsigned long long u64;
constexpr float RSQ_SCALE = 16777216.0f, RSQ_INV = 1.0f / (16777216.0f * 1024.0f);
DEVI float rs_from(const u64* p, int row) { return rsqrtf((float)p[row] * RSQ_INV + EPSF); }
DEVI void rs_add(u64* p, int row, float ss) { atomicAdd(p + row, (u64)(ss * RSQ_SCALE + 0.5f)); }
#define DPP_SHR(v, n) __int_as_float(__builtin_amdgcn_update_dpp(0, __float_as_int(v), 0x110 + (n), 0xF, 0xF, false))
DEVI float wave_incl_scan(float v, int lane) {
  v += DPP_SHR(v, 1); v += DPP_SHR(v, 2); v += DPP_SHR(v, 4); v += DPP_SHR(v, 8);
  const float t0 = __int_as_float(__builtin_amdgcn_readlane(__float_as_int(v), 15));
  const float t1 = __int_as_float(__builtin_amdgcn_readlane(__float_as_int(v), 31));
  const float t2 = __int_as_float(__builtin_amdgcn_readlane(__float_as_int(v), 47));
  const int row = lane >> 4;
  return v + (row >= 1 ? t0 : 0.f) + (row >= 2 ? t1 : 0.f) + (row >= 3 ? t2 : 0.f);
}
#define DPP_MOV(v, ctrl) __int_as_float(__builtin_amdgcn_update_dpp(0, __float_as_int(v), (ctrl), 0xF, 0xF, false))
DEVI float sum8(float v) {
  v += DPP_MOV(v, 0xB1);
  v += DPP_MOV(v, 0x4E);
  v += DPP_MOV(v, 0x141);
  return v;
}
DEVI float frcp(float x) { return __builtin_amdgcn_rcpf(x); }
DEVI float sigmoidf_(float x) { return frcp(1.0f + __expf(-x)); }
DEVI float siluf_(float x) { return x * frcp(1.0f + __expf(-x)); }
DEVI float gelu_tanh(float x) { float u = 0.7978845608f * (x + 0.044715f * x * x * x); float t = 1.0f - 2.0f * frcp(1.0f + __expf(2.0f * u)); return 0.5f * x * (1.0f + t); }
DEVI f32x4 mfma16(bf16x8 a, bf16x8 b, f32x4 c) { return __builtin_amdgcn_mfma_f32_16x16x32_bf16(a, b, c, 0, 0, 0); }

namespace pg8 {
constexpr int BM = 256, BK = 64, HALF = 128, HTB = HALF * BK * 2, STAGE_BYTES = 8 * HTB, NXCD = 8, WGM = 8;
DEVI int lds_byte(int r, int c) { const int st = (r >> 4) * 2 + (c >> 5), rr = r & 15, cc = c & 31, ob = rr * 64 + cc * 2; return st * 1024 + (ob ^ (((ob >> 9) & 1) << 5)); }
DEVI void stage_rc(int b, int& R, int& C) { const int st = b / 1024, sb = b % 1024, swz = sb ^ (((sb >> 9) & 1) << 5); R = (st >> 1) * 16 + swz / 64; C = (st & 1) * 32 + (swz % 64) / 2; }
DEVI int perm32(int rho) { const int n = rho >> 4, i = rho & 15; return 8 * (i >> 2) + 4 * n + (i & 3); }
struct Unit { int pm, pn, grp; };
struct Gemm { const bf16_t* A; const bf16_t* Bt; int lda, ldb, K; size_t gsA, gsB; };
struct StaticOrder {
  int nM, nN, nwg, G, c;
  DEVI void init(int nM_, int nN_, int G_, int c_) { nM = nM_; nN = nN_; nwg = nM * nN; G = G_; c = c_; }
  DEVI bool next(int i, Unit& u) const {
    const long L = (long)i * G + c; if (L >= nwg) return false;
    int wgid = (int)L; { const int q = nwg / NXCD, r = nwg % NXCD, xcd = wgid % NXCD, off = wgid / NXCD; wgid = (xcd < r ? xcd * (q + 1) : r * (q + 1) + (xcd - r) * q) + off; }
    const int nig = WGM * nN, gid = wgid / nig, fm = gid * WGM, gsz = (nM - fm) < WGM ? (nM - fm) : WGM;
    u.pm = fm + ((wgid % nig) % gsz); u.pn = (wgid % nig) / gsz; u.grp = 0; return true;
  }
};
struct OneUnit { Unit u; DEVI bool next(int i, Unit& o) const { if (i != 0) return false; o = u; return true; } };

template <class Epi, class Sched>
DEVI void gemm_phase(LAS unsigned char* lds, const Gemm g, const Sched& S, const Epi& E) {
  int tid_ = threadIdx.x; asm volatile("" : "+v"(tid_));
  const int tid = tid_, wid = __builtin_amdgcn_readfirstlane(tid >> 6), lane = tid & 63, wr = wid >> 2, wc = wid & 3, fr = lane & 15, fq = lane >> 4;
  const int K = g.K, nt = K / BK;
  unsigned voffA[2], voffB[2];
#pragma unroll
  for (int i = 0; i < 2; ++i) { int R, C; stage_rc(tid * 16 + i * 8192, R, C); const int Rb = Epi::PERM ? ((R & ~31) + perm32(R & 31)) : R;
    voffA[i] = (unsigned)(R * g.lda + C) * 2u; voffB[i] = (unsigned)(Rb * g.ldb + C) * 2u; }
  const size_t kstep = (size_t)(BK * 2);
  const size_t hstepA = (size_t)HALF * g.lda * 2, hstepB = (size_t)HALF * g.ldb * 2;
  const unsigned ldsw = (unsigned)wid * 1024u;
  const int aoff = lds_byte(wr * 64 + fr, fq * 8), boff = lds_byte(wc * 32 + fr, fq * 8);
#define PG8_SA(b, h) (((b) * 2 + (h)) * HTB)
#define PG8_SB(b, h) ((4 + (b) * 2 + (h)) * HTB)
#define PG8_STAGE(bufoff, gbase, voff) do { _Pragma("unroll") for (int _i = 0; _i < 2; ++_i) \
    __builtin_amdgcn_global_load_lds((const unsigned*)((const char*)(gbase) + (voff)[_i]), (LAS unsigned*)(lds + (bufoff) + ldsw + _i * 8192), 16, 0, 0); } while (0)
#define PG8_LDA(dst, b, h) do { _Pragma("unroll") for (int m = 0; m < 4; ++m) _Pragma("unroll") for (int k = 0; k < 2; ++k) dst[m][k] = *(const LAS bf16x8*)(lds + PG8_SA(b, h) + aoff + m * 2048 + k * 1024); } while (0)
#define PG8_LDB(dst, b, h) do { _Pragma("unroll") for (int n = 0; n < 2; ++n) _Pragma("unroll") for (int k = 0; k < 2; ++k) dst[n][k] = *(const LAS bf16x8*)(lds + PG8_SB(b, h) + boff + n * 2048 + k * 1024); } while (0)
#define PG8_MMA(ai, bj, At, Bt) do { __builtin_amdgcn_s_setprio(1); _Pragma("unroll") for (int m = 0; m < 4; ++m) _Pragma("unroll") for (int n = 0; n < 2; ++n) _Pragma("unroll") for (int k = 0; k < 2; ++k) \
    acc[ai][bj][m][n] = __builtin_amdgcn_mfma_f32_16x16x32_bf16(Bt[n][k], At[m][k], acc[ai][bj][m][n], 0, 0, 0); __builtin_amdgcn_s_setprio(0); } while (0)
#define PG8_WAIT_V(n) asm volatile("s_waitcnt vmcnt(" #n ")" ::: "memory")
#define PG8_WAIT_L(n) asm volatile("s_waitcnt lgkmcnt(" #n ")" ::: "memory")
#define PG8_BAR __builtin_amdgcn_s_barrier()
#define PG8_SCHED __builtin_amdgcn_sched_barrier(0)
  Unit cur, nxt; int ui = 0;
  if (!S.next(0, cur)) return;
  f32x4 acc[2][2][4][2];
#pragma unroll
  for (int a = 0; a < 2; ++a)
#pragma unroll
    for (int b = 0; b < 2; ++b)
#pragma unroll
      for (int m = 0; m < 4; ++m)
#pragma unroll
        for (int n = 0; n < 2; ++n) acc[a][b][m][n] = (f32x4){0.f, 0.f, 0.f, 0.f};
  bf16x8 At[4][2], B0[2][2], B1[2][2];
  const char* cA = (const char*)g.A + (size_t)cur.grp * g.gsA + (size_t)cur.pm * 2 * hstepA;
  const char* cB = (const char*)g.Bt + (size_t)cur.grp * g.gsB + (size_t)cur.pn * 2 * hstepB;
  PG8_STAGE(PG8_SB(0, 0), cB, voffB); PG8_STAGE(PG8_SA(0, 0), cA, voffA); PG8_STAGE(PG8_SB(0, 1), cB + hstepB, voffB); PG8_STAGE(PG8_SA(0, 1), cA + hstepA, voffA);
  if (wr == 1) PG8_BAR;
  PG8_WAIT_V(4); PG8_BAR;
  PG8_STAGE(PG8_SB(1, 0), cB + kstep, voffB); PG8_STAGE(PG8_SA(1, 0), cA + kstep, voffA); PG8_STAGE(PG8_SB(1, 1), cB + hstepB + kstep, voffB);
  PG8_WAIT_V(6); PG8_BAR;
  for (;;) {
    const bool has_next = S.next(ui + 1, nxt);
    const char* nA = has_next ? (const char*)g.A + (size_t)nxt.grp * g.gsA + (size_t)nxt.pm * 2 * hstepA : cA;
    const char* nB = has_next ? (const char*)g.Bt + (size_t)nxt.grp * g.gsB + (size_t)nxt.pn * 2 * hstepB : cB;
    for (int t = 0; t < nt; t += 2) {
      const bool last = (t == nt - 2);
      const char* a1 = cA + (size_t)(t + 1) * kstep;
      const char* a2 = last ? nA : cA + (size_t)(t + 2) * kstep; const char* b2 = last ? nB : cB + (size_t)(t + 2) * kstep;
      const char* a3 = a2 + kstep; const char* b3 = b2 + kstep;
      PG8_LDB(B0, 0, 0); PG8_SCHED; PG8_LDA(At, 0, 0); PG8_STAGE(PG8_SA(1, 1), a1 + hstepA, voffA);
      PG8_WAIT_L(8); PG8_BAR; PG8_WAIT_L(0); PG8_MMA(0, 0, At, B0); PG8_BAR; PG8_SCHED;
      PG8_LDB(B1, 0, 1); PG8_STAGE(PG8_SB(0, 0), b2, voffB);
      PG8_BAR; PG8_WAIT_L(0); PG8_MMA(0, 1, At, B1); PG8_BAR;
      PG8_LDA(At, 0, 1); PG8_STAGE(PG8_SA(0, 0), a2, voffA);
      PG8_BAR; PG8_WAIT_L(0); PG8_MMA(1, 0, At, B0); PG8_BAR; PG8_SCHED;
      PG8_STAGE(PG8_SB(0, 1), b2 + hstepB, voffB);
      PG8_WAIT_V(6); PG8_BAR; PG8_MMA(1, 1, At, B1); PG8_BAR;
      PG8_LDB(B0, 1, 0); PG8_SCHED; PG8_LDA(At, 1, 0); PG8_STAGE(PG8_SA(0, 1), a2 + hstepA, voffA);
      PG8_WAIT_L(8); PG8_BAR; PG8_WAIT_L(0); PG8_MMA(0, 0, At, B0); PG8_BAR; PG8_SCHED;
      PG8_LDB(B1, 1, 1); PG8_STAGE(PG8_SB(1, 0), b3, voffB);
      PG8_BAR; PG8_WAIT_L(0); PG8_MMA(0, 1, At, B1); PG8_BAR;
      PG8_LDA(At, 1, 1); PG8_STAGE(PG8_SA(1, 0), a3, voffA);
      PG8_BAR; PG8_WAIT_L(0); PG8_MMA(1, 0, At, B0); PG8_BAR; PG8_SCHED;
      PG8_STAGE(PG8_SB(1, 1), b3 + hstepB, voffB);
      PG8_WAIT_V(6); PG8_BAR; PG8_MMA(1, 1, At, B1); PG8_BAR;
    }
    asm volatile("s_nop 7\n\ts_nop 7" ::: "memory");
    if constexpr (!Epi::AFTER_DRAIN) { E(acc, cur, wr, wc, fr, fq); }
    if (!has_next) break;
#pragma unroll
    for (int a = 0; a < 2; ++a)
#pragma unroll
      for (int b = 0; b < 2; ++b)
#pragma unroll
        for (int m = 0; m < 4; ++m)
#pragma unroll
          for (int n = 0; n < 2; ++n) acc[a][b][m][n] = (f32x4){0.f, 0.f, 0.f, 0.f};
    cur = nxt; cA = nA; cB = nB; ++ui;
  }
  PG8_WAIT_V(0);
  if (wr == 0) PG8_BAR;
  PG8_BAR;
  if constexpr (Epi::AFTER_DRAIN) { E.fused(acc, cur, wr, wc, fr, fq, lds, wid, lane); }
#undef PG8_SA
#undef PG8_SB
#undef PG8_STAGE
#undef PG8_LDA
#undef PG8_LDB
#undef PG8_MMA
#undef PG8_WAIT_V
#undef PG8_WAIT_L
#undef PG8_BAR
#undef PG8_SCHED
}
}
using pg8::Unit; using pg8::Gemm;
typedef f32x4 AccT[2][2][4][2];

struct EpiG1 {
  static constexpr bool PERM = true, AFTER_DRAIN = false;
  const u64* rowsq; bf16_t* proj; bf16_t* U; float* dt; unsigned char* gates;
  DEVI void operator()(const AccT& acc, const Unit& u, int wr, int wc, int fr, int fq) const {
    const int pn = u.pn;
    float rsv[2][4];
#pragma unroll
    for (int ai = 0; ai < 2; ++ai)
#pragma unroll
      for (int m = 0; m < 4; ++m) rsv[ai][m] = rs_from(rowsq, u.pm * 256 + ai * 128 + wr * 64 + m * 16 + fr);
#pragma unroll
    for (int ai = 0; ai < 2; ++ai)
#pragma unroll
      for (int m = 0; m < 4; ++m) {
        const int row = u.pm * 256 + ai * 128 + wr * 64 + m * 16 + fr;
        const float rs = rsv[ai][m];
#pragma unroll
        for (int bj = 0; bj < 2; ++bj) {
          const int cc = bj * 128 + wc * 32 + fq * 8;
          float v[8];
#pragma unroll
          for (int e = 0; e < 4; ++e) { v[e] = acc[ai][bj][m][0][e] * rs; v[4 + e] = acc[ai][bj][m][1][e] * rs; }
          if (pn >= 12) {
            u32x2 w; w[0] = 0u; w[1] = 0u;
#pragma unroll
            for (int e = 0; e < 4; ++e) { w[0] = __builtin_amdgcn_cvt_pk_u8_f32(sigmoidf_(v[e]) * 255.0f, e, w[0]); w[1] = __builtin_amdgcn_cvt_pk_u8_f32(sigmoidf_(v[4 + e]) * 255.0f, e, w[1]); }
            *(u32x2*)(gates + (size_t)row * 4096 + (pn - 12) * 256 + cc) = w;
          } else if (pn == 11) {
            if (cc == 0) *(f32x4*)(dt + (size_t)row * 4) = (f32x4){v[0], v[1], v[2], v[3]};
          } else if (pn == 7) {
            const int g = cc >> 4, i0 = cc & 15;
            *(u32x4*)(U + ((size_t)(g * 512 + (row >> 6)) * UK + (row & 63) * 16 + i0)) = pack8(v);
          } else {
            const int pt = pn < 7 ? pn : pn - 1;
            *(u32x4*)(proj + (size_t)row * PW + pt * 256 + cc) = pack8(v);
          }
        }
      }
  }
};
template <bool XF32>
struct EpiRes {
  static constexpr bool PERM = true, AFTER_DRAIN = false;
  const float* xin; bf16_t* xb; u64* rsq_out;
  DEVI void operator()(const AccT& acc, const Unit& u, int wr, int wc, int fr, int fq) const {
#pragma unroll
    for (int ai = 0; ai < 2; ++ai)
#pragma unroll
    for (int mh = 0; mh < 2; ++mh) {
      f32x4 xf[4][2][2]; u32x4 xh[4][2];
#pragma unroll
      for (int m = 2 * mh; m < 2 * mh + 2; ++m)
#pragma unroll
        for (int bj = 0; bj < 2; ++bj) {
          const size_t o = (size_t)(u.pm * 256 + ai * 128 + wr * 64 + m * 16 + fr) * 1024 + u.pn * 256 + bj * 128 + wc * 32 + fq * 8;
          if (XF32) { xf[m][bj][0] = *(const f32x4*)(xin + o); xf[m][bj][1] = *(const f32x4*)(xin + o + 4); }
          else xh[m][bj] = *(const u32x4*)(xb + o);
        }
#pragma unroll
      for (int m = 2 * mh; m < 2 * mh + 2; ++m) {
        const int row = u.pm * 256 + ai * 128 + wr * 64 + m * 16 + fr;
        float ss = 0.f;
#pragma unroll
        for (int bj = 0; bj < 2; ++bj) {
          const size_t o = (size_t)row * 1024 + u.pn * 256 + bj * 128 + wc * 32 + fq * 8;
          float xo[8];
          if (XF32) {
#pragma unroll
            for (int e = 0; e < 4; ++e) { xo[e] = xf[m][bj][0][e]; xo[4 + e] = xf[m][bj][1][e]; } }
          else unpack8(xh[m][bj], xo);
          float v[8];
#pragma unroll
          for (int e = 0; e < 4; ++e) { v[e] = acc[ai][bj][m][0][e] + xo[e]; v[4 + e] = acc[ai][bj][m][1][e] + xo[4 + e]; }
          const u32x4 w = pack8(v);
          *(u32x4*)(xb + o) = w;
          float vr[8]; unpack8(w, vr);
#pragma unroll
          for (int e = 0; e < 8; ++e) ss += vr[e] * vr[e];
        }
        ss += __shfl_xor(ss, 16); ss += __shfl_xor(ss, 32);
        if (fq == 0) rs_add(rsq_out, row, ss);
      }
    }
  }
};
struct EpiFF1 {
  static constexpr bool PERM = true, AFTER_DRAIN = false;
  const u64* rowsq; bf16_t* hid;
  DEVI void operator()(const AccT& acc, const Unit& u, int wr, int wc, int fr, int fq) const {
    float rsv[2][4];
#pragma unroll
    for (int ai = 0; ai < 2; ++ai)
#pragma unroll
      for (int m = 0; m < 4; ++m) rsv[ai][m] = rs_from(rowsq, u.pm * 256 + ai * 128 + wr * 64 + m * 16 + fr);
#pragma unroll
    for (int ai = 0; ai < 2; ++ai)
#pragma unroll
      for (int m = 0; m < 4; ++m) {
        const int row = u.pm * 256 + ai * 128 + wr * 64 + m * 16 + fr;
        const float rs = rsv[ai][m];
#pragma unroll
        for (int bj = 0; bj < 2; ++bj) {
          float v[8];
#pragma unroll
          for (int e = 0; e < 4; ++e) { float a = fmaxf(acc[ai][bj][m][0][e] * rs, 0.f), b = fmaxf(acc[ai][bj][m][1][e] * rs, 0.f); v[e] = a * a; v[4 + e] = b * b; }
          *(u32x4*)(hid + (size_t)row * 4096 + u.pn * 256 + bj * 128 + wc * 32 + fq * 8) = pack8(v);
        }
      }
  }
};
struct EpiPle {
  static constexpr bool PERM = true, AFTER_DRAIN = false;
  bf16_t* ple;
  DEVI void operator()(const AccT& acc, const Unit& u, int wr, int wc, int fr, int fq) const {
#pragma unroll
    for (int ai = 0; ai < 2; ++ai)
#pragma unroll
      for (int m = 0; m < 4; ++m) {
        const int row = u.pm * 256 + ai * 128 + wr * 64 + m * 16 + fr;
#pragma unroll
        for (int bj = 0; bj < 2; ++bj) {
          float v[8];
#pragma unroll
          for (int e = 0; e < 4; ++e) { v[e] = acc[ai][bj][m][0][e]; v[4 + e] = acc[ai][bj][m][1][e]; }
          *(u32x4*)(ple + (size_t)row * 1024 + u.pn * 256 + bj * 128 + wc * 32 + fq * 8) = pack8(v);
        }
      }
  }
};
struct EpiPG {
  static constexpr bool PERM = true, AFTER_DRAIN = false;
  const u64* rowsq; const bf16_t* ple; const bf16_t* xbo; float* xout; bf16_t* xbn; u64* rsq_out; int last;
  DEVI void operator()(const AccT& acc, const Unit& u, int wr, int wc, int fr, int fq) const {
#pragma unroll
    for (int ai = 0; ai < 2; ++ai)
#pragma unroll
    for (int mh = 0; mh < 2; ++mh) {
      u32x4 xh[4][2], ph[4][2]; float rsv[4];
#pragma unroll
      for (int m = 2 * mh; m < 2 * mh + 2; ++m) {
        const int row = u.pm * 256 + ai * 128 + wr * 64 + m * 16 + fr;
        rsv[m] = rs_from(rowsq, row);
#pragma unroll
        for (int bj = 0; bj < 2; ++bj) {
          const size_t o = (size_t)row * 1024 + u.pn * 256 + bj * 128 + wc * 32 + fq * 8;
          xh[m][bj] = *(const u32x4*)(xbo + o); ph[m][bj] = *(const u32x4*)(ple + o);
        }
      }
#pragma unroll
      for (int m = 2 * mh; m < 2 * mh + 2; ++m) {
        const int row = u.pm * 256 + ai * 128 + wr * 64 + m * 16 + fr;
        const float rs = rsv[m];
        float ss = 0.f;
#pragma unroll
        for (int bj = 0; bj < 2; ++bj) {
          const size_t o = (size_t)row * 1024 + u.pn * 256 + bj * 128 + wc * 32 + fq * 8;
          float xo[8]; unpack8(xh[m][bj], xo);
          float pl[8]; unpack8(ph[m][bj], pl);
          float v[8];
#pragma unroll
          for (int e = 0; e < 4; ++e) { v[e] = xo[e] + pl[e] * sigmoidf_(acc[ai][bj][m][0][e] * rs); v[4 + e] = xo[4 + e] + pl[4 + e] * sigmoidf_(acc[ai][bj][m][1][e] * rs); }
          *(f32x4*)(xout + o) = (f32x4){v[0], v[1], v[2], v[3]}; *(f32x4*)(xout + o + 4) = (f32x4){v[4], v[5], v[6], v[7]};
          if (!last) { *(u32x4*)(xbn + o) = pack8(v);
#pragma unroll
          for (int e = 0; e < 8; ++e) ss += v[e] * v[e]; }
        }
        if (!last) { ss += __shfl_xor(ss, 16); ss += __shfl_xor(ss, 32);
        if (fq == 0) rs_add(rsq_out, row, ss); }
      }
    }
  }
};
struct EpiS5in {
  static constexpr bool PERM = false, AFTER_DRAIN = true;
  bf16_t* U; const float* lam;
  DEVI void operator()(const AccT&, const Unit&, int, int, int, int) const {}
  DEVI void fused(const AccT& acc, const Unit& u, int wr, int wc, int fr, int fq, LAS unsigned char* lds, int wid, int lane) const {
    LAS float* L = (LAS float*)lds;
#pragma unroll
    for (int ai = 0; ai < 2; ++ai)
#pragma unroll
      for (int m = 0; m < 4; ++m) {
        const int rl = ai * 128 + wr * 64 + m * 16 + fr;
#pragma unroll
        for (int n = 0; n < 2; ++n) {
          const int c = wc * 32 + n * 16 + fq * 4;
#pragma unroll
          for (int e = 0; e < 4; ++e) L[rl * 128 + c + e] = acc[ai][0][m][n][e];
        }
      }
    __syncthreads();
    const int tid = ltid(), bl = tid >> 6, p = tid & 63, g = u.grp;
    const float lr = lam[((size_t)(g * 64 + p) * 65 + 64) * 2], li = lam[((size_t)(g * 64 + p) * 65 + 64) * 2 + 1];
    float hr = 0.f, hi = 0.f;
    for (int c = 0; c < 32; ++c) {
      const int rl = bl * 32 + c;
      bf16_t* dst = U + ((size_t)(g * 512 + u.pm * 256 + rl) * UK + 1024);
      dst[p] = f2bf(hr); dst[64 + p] = f2bf(hi);
      const float er = L[rl * 128 + p], ei = L[rl * 128 + 64 + p];
      const float nr = lr * hr - li * hi + er, ni = lr * hi + li * hr + ei;
      hr = nr; hi = ni;
    }
    __syncthreads();
  }
};
struct EpiToep {
  static constexpr bool PERM = true, AFTER_DRAIN = false;
  const bf16_t* U; const float* dskip; bf16_t* Y;
  DEVI void operator()(const AccT& acc, const Unit& u, int wr, int wc, int fr, int fq) const {
    const int g = u.grp, i0 = (fq * 8) & 15;
    float dk[8];
#pragma unroll
    for (int e = 0; e < 8; ++e) dk[e] = dskip[g * 16 + i0 + e];
#pragma unroll
    for (int ai = 0; ai < 2; ++ai)
#pragma unroll
    for (int mh = 0; mh < 2; ++mh) {
      u32x4 uh[4][2];
#pragma unroll
      for (int m = 2 * mh; m < 2 * mh + 2; ++m)
#pragma unroll
        for (int bj = 0; bj < 2; ++bj) {
          const int r = u.pm * 256 + ai * 128 + wr * 64 + m * 16 + fr, cidx = u.pn * 256 + bj * 128 + wc * 32 + fq * 8;
          uh[m][bj] = *(const u32x4*)(U + ((size_t)(g * 512 + r) * UK + cidx));
        }
#pragma unroll
      for (int m = 2 * mh; m < 2 * mh + 2; ++m) {
        const int r = u.pm * 256 + ai * 128 + wr * 64 + m * 16 + fr;
#pragma unroll
        for (int bj = 0; bj < 2; ++bj) {
          const int cidx = u.pn * 256 + bj * 128 + wc * 32 + fq * 8, s = cidx >> 4;
          float uv[8]; unpack8(uh[m][bj], uv);
          float v[8];
#pragma unroll
          for (int e = 0; e < 8; ++e) { const float a = (e < 4 ? acc[ai][bj][m][0][e] : acc[ai][bj][m][1][e - 4]) + dk[e] * uv[e]; v[e] = gelu_tanh(a); }
          *(u32x4*)(Y + (size_t)(r * 64 + s) * 1024 + 512 + g * 16 + i0) = pack8(v);
        }
      }
    }
  }
};
struct EpiGLU {
  static constexpr bool PERM = true, AFTER_DRAIN = false;
  bf16_t* Y;
  DEVI void operator()(const AccT& acc, const Unit& u, int wr, int wc, int fr, int fq) const {
#pragma unroll
    for (int ai = 0; ai < 2; ++ai)
#pragma unroll
    for (int mh = 0; mh < 2; ++mh) {
      u32x4 yh[4][2];
#pragma unroll
      for (int m = 2 * mh; m < 2 * mh + 2; ++m)
#pragma unroll
        for (int bj = 0; bj < 2; ++bj)
          yh[m][bj] = *(const u32x4*)(Y + (size_t)(u.pm * 256 + ai * 128 + wr * 64 + m * 16 + fr) * 1024 + 512 + bj * 128 + wc * 32 + fq * 8);
#pragma unroll
      for (int m = 2 * mh; m < 2 * mh + 2; ++m) {
        const int row = u.pm * 256 + ai * 128 + wr * 64 + m * 16 + fr;
#pragma unroll
        for (int bj = 0; bj < 2; ++bj) {
          bf16_t* p = Y + (size_t)row * 1024 + 512 + bj * 128 + wc * 32 + fq * 8;
          float yv[8]; unpack8(yh[m][bj], yv);
          float v[8];
#pragma unroll
          for (int e = 0; e < 8; ++e) v[e] = yv[e] * sigmoidf_(e < 4 ? acc[ai][bj][m][0][e] : acc[ai][bj][m][1][e - 4]);
          *(u32x4*)p = pack8(v);
        }
      }
    }
  }
};

constexpr int TS = 72;
DEVI f32x4 mma64(const bf16_t* A, int lda, const bf16_t* Bt, int ldb, f32x4 acc, int fr, int fq) {
#pragma unroll
  for (int k = 0; k < 64; k += 32) {
    const bf16x8 a = *(const bf16x8*)(A + fr * lda + k + fq * 8);
    const bf16x8 b = *(const bf16x8*)(Bt + fr * ldb + k + fq * 8);
    acc = mfma16(a, b, acc);
  }
  return acc;
}
DEVI int qpop(int* ctr, int* slot) {
  __syncthreads();
  if (ltid() == 0) *slot = atomicAdd(ctr, 1);
  __syncthreads();
  return __builtin_amdgcn_readfirstlane(*slot);
}

DEVI void dep_publish(int* cnt) {
  asm volatile("s_waitcnt vmcnt(0)" ::: "memory");
  __syncthreads();
  if (ltid() == 0) {
    __builtin_amdgcn_fence(__ATOMIC_RELEASE, "agent");
    asm volatile("s_waitcnt vmcnt(0)" ::: "memory");
    __hip_atomic_fetch_add(cnt, 1, __ATOMIC_RELAXED, __HIP_MEMORY_SCOPE_AGENT);
  }
}
DEVI void dep_wait(int* cnt, int need) {
  if (ltid() == 0) {
    unsigned sp = 0;
    while (__hip_atomic_load(cnt, __ATOMIC_RELAXED, __HIP_MEMORY_SCOPE_AGENT) < need) { __builtin_amdgcn_s_sleep(2); if (++sp > (1u << 22)) break; }
    __builtin_amdgcn_fence(__ATOMIC_ACQUIRE, "agent");
    asm volatile("s_waitcnt vmcnt(0)" ::: "memory");
  }
  __syncthreads();
}

__device__ void hgrn2_seq(const Params& P, int layer, int item, unsigned char* smem) {
  int tid_ = threadIdx.x; asm volatile("" : "+v"(tid_));
  const int tid = tid_, wid = tid >> 6, lane = tid & 63, fr = lane & 15, fq = lane >> 4;
  const int b = item >> 2, h = item & 3, r = lane, c8 = wid * 8;
  const int r2 = tid >> 3, c82 = (tid & 7) * 8;
  float* B32 = (float*)smem;
  float* O32 = (float*)(smem + 16384);
  float* WT = (float*)(smem + 16384 + 16640);
  bf16_t* QB = (bf16_t*)(smem + 35072);
  bf16_t* QT = QB + 64 * TS;
  bf16_t* KT = QT + 64 * TS;
  bf16_t* KET = KT + 4 * 64 * TS;
  bf16_t* VT = KET + 64 * TS;
  bf16_t* SC = VT + 64 * TS;
  bf16_t* ST = SC + 64 * TS;
  const bf16_t* proj = (const bf16_t*)(P.ws + OFF_PROJ);
  bf16_t* Y = (bf16_t*)(P.ws + OFF_Y);
  float lbv[8], og[8];
#pragma unroll
  for (int i = 0; i < 8; ++i) {
    const int k = h * 64 + c8 + i;
    if (layer == 0) lbv[i] = 0.f; else { const float l0 = P.in[4][k], l1 = P.in[4][256 + k]; lbv[i] = 1.0f / (1.0f + expf(l0 - l1)); }
    og[i] = P.in[5][layer * 256 + h * 64 + c82 + i];
  }
  f32x4 sacc[2] = {(f32x4){0.f, 0.f, 0.f, 0.f}, (f32x4){0.f, 0.f, 0.f, 0.f}};
  for (int i = tid; i < 2 * 64 * TS; i += 512) ST[i] = 0;
  const bf16_t* pbase = proj + (size_t)(b * SEQ) * PW + h * 64 + c8;
  const bf16_t* gbase = proj + (size_t)(b * SEQ) * PW + 768 + h * 64 + c82;
  u32x4 nq, nz, nv, ng;
  { const bf16_t* p = pbase + (size_t)r * PW; nq = *(const u32x4*)p; nz = *(const u32x4*)(p + 256); nv = *(const u32x4*)(p + 512); ng = *(const u32x4*)(gbase + (size_t)r2 * PW); }
  __syncthreads();
  for (int c = 0; c < NCH; ++c) {
    const int t = c * 64 + r;
    float q[8], z[8], lf[8], kk[8];
    const u32x4 cv = nv, cgt = ng;
    unpack8(nq, q); unpack8(nz, z);
    if (c + 1 < NCH) { const bf16_t* p = pbase + (size_t)(t + 64) * PW; nq = *(const u32x4*)p; nz = *(const u32x4*)(p + 256); nv = *(const u32x4*)(p + 512); ng = *(const u32x4*)(gbase + (size_t)(c * 64 + 64 + r2) * PW); }
#pragma unroll
    for (int i = 0; i < 8; ++i) {
      const float e = __expf(-z[i]), inv = frcp(1.0f + e);
      const float f = lbv[i] + (1.0f - lbv[i]) * inv;
      lf[i] = __logf(fmaxf(f, 1e-37f));
      kk[i] = (1.0f - lbv[i]) * e * inv;
    }
#pragma unroll
    for (int i = 0; i < 8; ++i) lf[i] = wave_incl_scan(lf[i], lane);
#pragma unroll
    for (int i = 0; i < 8; ++i) B32[r * 64 + c8 + i] = lf[i];
    __syncthreads();
    {
      const int I = r >> 4;
      float tq[8], tb[8], vv[8];
      unpack8(cv, vv);
#pragma unroll
      for (int i = 0; i < 8; ++i) { tb[i] = q[i] * __expf(lf[i]); tq[i] = q[i] * __expf(lf[i] - B32[(I * 16) * 64 + c8 + i]); }
      *(u32x4*)(QB + r * TS + c8) = pack8(tb);
      *(u32x4*)(QT + r * TS + c8) = pack8(tq);
      float br[4][8];
#pragma unroll
      for (int I2 = 0; I2 < 4; ++I2)
#pragma unroll
        for (int i = 0; i < 8; ++i) br[I2][i] = B32[(I2 * 16) * 64 + c8 + i];
#pragma unroll
      for (int I2 = 0; I2 < 4; ++I2) {
        float tk[8];
#pragma unroll
        for (int i = 0; i < 8; ++i) tk[i] = kk[i] * __expf(fminf(br[I2][i] - lf[i], 80.f));
        if (I2 >= I) *(u32x4*)(KT + I2 * 64 * TS + r * TS + c8) = pack8(tk);
      }
#pragma unroll
      for (int i = 0; i < 8; ++i) {
        KET[(c8 + i) * TS + r] = f2bf(kk[i] * __expf(B32[63 * 64 + c8 + i] - lf[i]));
        VT[(c8 + i) * TS + r] = f2bf(vv[i]);
      }
    }
    __syncthreads();
#pragma unroll
    for (int x = 0; x < 2; ++x) {
      const int tl = wid + 8 * x, I = tl >> 2, J = tl & 3;
      f32x4 a = (f32x4){0.f, 0.f, 0.f, 0.f};
      if (J <= I) a = mma64(QT + I * 16 * TS, TS, KT + I * 64 * TS + J * 16 * TS, TS, a, fr, fq);
#pragma unroll
      for (int jj = 0; jj < 4; ++jj) {
        float v = a[jj];
        if (J > I || (J == I && (fq * 4 + jj) < fr)) v = 0.f;
        SC[(I * 16 + fq * 4 + jj) * TS + J * 16 + fr] = f2bf(v);
      }
    }
    __syncthreads();
    const bf16_t* STc = ST + (c & 1) * 64 * TS;
    bf16_t* STn = ST + ((c + 1) & 1) * 64 * TS;
#pragma unroll
    for (int x = 0; x < 2; ++x) {
      const int tb_ = wid >> 1, vb = (wid & 1) * 2 + x;
      f32x4 a = (f32x4){0.f, 0.f, 0.f, 0.f};
      a = mma64(SC + tb_ * 16 * TS, TS, VT + vb * 16 * TS, TS, a, fr, fq);
      a = mma64(QB + tb_ * 16 * TS, TS, STc + vb * 16 * TS, TS, a, fr, fq);
#pragma unroll
      for (int jj = 0; jj < 4; ++jj) O32[(tb_ * 16 + fq * 4 + jj) * 65 + vb * 16 + fr] = a[jj];
      const int kb = (wid & 1) * 2 + x;
      const float dec = __expf(B32[63 * 64 + kb * 16 + fr]);
      f32x4 s = sacc[x];
#pragma unroll
      for (int jj = 0; jj < 4; ++jj) s[jj] *= dec;
      s = mma64(VT + (wid >> 1) * 16 * TS, TS, KET + kb * 16 * TS, TS, s, fr, fq);
      sacc[x] = s;
#pragma unroll
      for (int jj = 0; jj < 4; ++jj) STn[((wid >> 1) * 16 + fq * 4 + jj) * TS + kb * 16 + fr] = f2bf(s[jj]);
    }
    __syncthreads();
    {
      float o[8], gg[8]; float ss = 0.f;
      unpack8(cgt, gg);
#pragma unroll
      for (int i = 0; i < 8; ++i) { o[i] = O32[r2 * 65 + c82 + i]; ss += o[i] * o[i]; }
      ss = sum8(ss);
      const float rs = rsqrtf(ss * (1.0f / 64.0f) + EPSF);
#pragma unroll
      for (int i = 0; i < 8; ++i) o[i] = o[i] * rs * og[i] * siluf_(gg[i]);
      *(u32x4*)(Y + (size_t)(b * SEQ + c * 64 + r2) * 1024 + h * 64 + c82) = pack8(o);
    }
  }
  __syncthreads();
}

__device__ void ssd_seq(const Params& P, int layer, int item, unsigned char* smem) {
  int tid_ = threadIdx.x; asm volatile("" : "+v"(tid_));
  const int tid = tid_, wid = tid >> 6, lane = tid & 63, fr = lane & 15, fq = lane >> 4;
  const int b = item >> 2, h = item & 3, grp = h >> 1, r = lane, cg_ = wid, c8 = wid * 8;
  const int r2 = tid >> 3, cg2 = tid & 7, c82 = cg2 * 8;
  constexpr int RS = 200;
  bf16_t* RAW = (bf16_t*)smem;
  float* O32 = (float*)smem;
  float* CW = (float*)(smem + 27136);
  float* ACUM = (float*)(smem + 27136 + 3840);
  float* DTV = ACUM + 64;
  bf16_t* XS = (bf16_t*)(smem + 27136 + 3840 + 512);
  bf16_t* CM = XS + 64 * TS;
  bf16_t* BM = CM + 64 * TS;
  bf16_t* BMT = BM + 64 * TS;
  bf16_t* CS = BMT + 64 * TS;
  bf16_t* XDTT = CS + 64 * TS;
  bf16_t* XDECT = XDTT + 64 * TS;
  bf16_t* MS = XDECT + 64 * TS;
  bf16_t* STATE = MS + 64 * TS;
  const bf16_t* proj = (const bf16_t*)(P.ws + OFF_PROJ);
  const float* dtb = (const float*)(P.ws + OFF_SMALL + S_DT);
  u64* ssq = (u64*)(P.ws + OFF_SMALL + S_SSQ) + (size_t)layer * T_TOK * 2;
  bf16_t* Y = (bf16_t*)(P.ws + OFF_Y);
  if (tid < 192) {
    const int lc = tid; const int ch = lc < 64 ? h * 64 + lc : (lc < 128 ? 256 + grp * 64 + (lc - 64) : 384 + grp * 64 + (lc - 128));
    const float* w = P.in[6] + ((size_t)layer * 512 + ch) * 4;
    CW[0 * 192 + lc] = w[0]; CW[1 * 192 + lc] = w[1]; CW[2 * 192 + lc] = w[2]; CW[3 * 192 + lc] = w[3]; CW[4 * 192 + lc] = P.in[7][layer * 512 + ch];
  }
  for (int i = tid; i < 64 * TS; i += 512) STATE[i] = 0;
  const float dtbias = P.in[8][layer * 4 + h], aneg = -expf(P.in[9][layer * 4 + h]), dsk = P.in[10][layer * 4 + h];
  f32x4 sacc[2] = {(f32x4){0.f, 0.f, 0.f, 0.f}, (f32x4){0.f, 0.f, 0.f, 0.f}};
  __syncthreads();
  u32x4 rw[4], zr; float dtr = 0.f;
#define SSD_PREFETCH(cc) do { const int t0n = b * SEQ + (cc) * 64; \
    _Pragma("unroll") for (int i = 0; i < 4; ++i) { const int idx = tid + 512 * i; rw[i] = (u32x4){0u, 0u, 0u, 0u}; \
      if (idx < 67 * 24) { const int rr = idx / 24, pc = idx - rr * 24; \
        const int col = pc < 8 ? 1280 + h * 64 + pc * 8 : (pc < 16 ? 1536 + grp * 64 + (pc - 8) * 8 : 1664 + grp * 64 + (pc - 16) * 8); \
        if ((cc) > 0 || rr >= 3) rw[i] = *(const u32x4*)(proj + (size_t)(t0n - 3 + rr) * PW + col); } } \
    if (wid == 0) dtr = dtb[(size_t)(t0n + lane) * 4 + h]; \
    zr = *(const u32x4*)(proj + (size_t)(t0n + r2) * PW + 1024 + h * 64 + c82); } while (0)
  SSD_PREFETCH(0);
  for (int c = 0; c < NCH; ++c) {
    const int t0 = b * SEQ + c * 64;
#pragma unroll
    for (int i = 0; i < 4; ++i) { const int idx = tid + 512 * i; if (idx < 67 * 24) { const int rr = idx / 24, pc = idx - rr * 24; *(u32x4*)(RAW + rr * RS + pc * 8) = rw[i]; } }
    if (wid == 0) {
      const float x0 = dtr + dtbias;
      const float dt0 = x0 > 20.f ? x0 : log1pf(__expf(x0));
      float a0 = dt0 * aneg;
      a0 = wave_incl_scan(a0, lane);
      ACUM[lane] = a0; DTV[lane] = dt0;
    }
    const u32x4 zraw = zr;
    if (c + 1 < NCH) SSD_PREFETCH(c + 1);
    __syncthreads();
#pragma unroll
    for (int q3 = 0; q3 < 3; ++q3) {
      const int lc0 = cg_ * 24 + q3 * 8;
      float accv[8];
      { const f32x4 b0 = *(const f32x4*)(CW + 4 * 192 + lc0), b1 = *(const f32x4*)(CW + 4 * 192 + lc0 + 4);
#pragma unroll
        for (int i = 0; i < 4; ++i) { accv[i] = b0[i]; accv[4 + i] = b1[i]; } }
#pragma unroll
      for (int tap = 0; tap < 4; ++tap) {
        float xv[8]; unpack8(*(const u32x4*)(RAW + (r + tap) * RS + lc0), xv);
        const f32x4 w0 = *(const f32x4*)(CW + tap * 192 + lc0), w1 = *(const f32x4*)(CW + tap * 192 + lc0 + 4);
#pragma unroll
        for (int i = 0; i < 4; ++i) { accv[i] += xv[i] * w0[i]; accv[4 + i] += xv[4 + i] * w1[i]; }
      }
#pragma unroll
      for (int i = 0; i < 8; ++i) accv[i] = siluf_(accv[i]);
      if (lc0 < 64) { *(u32x4*)(XS + r * TS + lc0) = pack8(accv); }
      else if (lc0 < 128) { const int n0 = lc0 - 64; *(u32x4*)(BM + r * TS + n0) = pack8(accv);
#pragma unroll
        for (int i = 0; i < 8; ++i) BMT[(n0 + i) * TS + r] = f2bf(accv[i]); }
      else { const int n0 = lc0 - 128; *(u32x4*)(CM + r * TS + n0) = pack8(accv); }
    }
    __syncthreads();
    {
      float xs[8], cm[8], cs[8]; unpack8(*(const u32x4*)(XS + r * TS + c8), xs); unpack8(*(const u32x4*)(CM + r * TS + c8), cm);
      const float dtv = DTV[r], dec = __expf(ACUM[63] - ACUM[r]), ea = __expf(ACUM[r]);
#pragma unroll
      for (int i = 0; i < 8; ++i) { const float xd = xs[i] * dtv; XDTT[(c8 + i) * TS + r] = f2bf(xd); XDECT[(c8 + i) * TS + r] = f2bf(xd * dec); cs[i] = cm[i] * ea; }
      *(u32x4*)(CS + r * TS + c8) = pack8(cs);
    }
#pragma unroll
    for (int x = 0; x < 2; ++x) {
      const int tl = wid + 8 * x, lb = tl >> 2, sb = tl & 3;
      f32x4 gt = (f32x4){0.f, 0.f, 0.f, 0.f};
      if (sb <= lb) gt = mma64(CM + lb * 16 * TS, TS, BM + sb * 16 * TS, TS, gt, fr, fq);
#pragma unroll
      for (int jj = 0; jj < 4; ++jj) {
        const int l = lb * 16 + fq * 4 + jj, sidx = sb * 16 + fr;
        float v = 0.f;
        if (l >= sidx) v = gt[jj] * __expf(ACUM[l] - ACUM[sidx]);
        MS[l * TS + sidx] = f2bf(v);
      }
    }
    __syncthreads();
    f32x4 snew[2];
#pragma unroll
    for (int x = 0; x < 2; ++x) {
      const int lb = wid >> 1, pb = (wid & 1) * 2 + x;
      f32x4 a = (f32x4){0.f, 0.f, 0.f, 0.f};
      a = mma64(MS + lb * 16 * TS, TS, XDTT + pb * 16 * TS, TS, a, fr, fq);
      a = mma64(CS + lb * 16 * TS, TS, STATE + pb * 16 * TS, TS, a, fr, fq);
#pragma unroll
      for (int jj = 0; jj < 4; ++jj) O32[(lb * 16 + fq * 4 + jj) * 65 + pb * 16 + fr] = a[jj];
      const int nb = (wid & 1) * 2 + x;
      const float dchunk = __expf(ACUM[63]);
      f32x4 sv = sacc[x];
#pragma unroll
      for (int jj = 0; jj < 4; ++jj) sv[jj] *= dchunk;
      sv = mma64(XDECT + (wid >> 1) * 16 * TS, TS, BMT + nb * 16 * TS, TS, sv, fr, fq);
      sacc[x] = sv; snew[x] = sv;
    }
    __syncthreads();
#pragma unroll
    for (int x = 0; x < 2; ++x) {
      const int nb = (wid & 1) * 2 + x;
#pragma unroll
      for (int jj = 0; jj < 4; ++jj) STATE[((wid >> 1) * 16 + fq * 4 + jj) * TS + nb * 16 + fr] = f2bf(snew[x][jj]);
    }
    {
      const int t = t0 + r2;
      float zz[8], xs[8], y[8];
      unpack8(zraw, zz); unpack8(*(const u32x4*)(XS + r2 * TS + c82), xs);
      float ss = 0.f;
#pragma unroll
      for (int i = 0; i < 8; ++i) y[i] = (O32[r2 * 65 + c82 + i] + dsk * xs[i]) * siluf_(zz[i]);
      const u32x4 w = pack8(y);
      float yr[8]; unpack8(w, yr);
#pragma unroll
      for (int i = 0; i < 8; ++i) ss += yr[i] * yr[i];
      ss = sum8(ss);
      if (cg2 == 0) atomicAdd(ssq + (size_t)t * 2 + grp, (u64)(ss * RSQ_SCALE + 0.5f));
      *(u32x4*)(Y + (size_t)t * 1024 + 256 + h * 64 + c82) = w;
    }
    __syncthreads();
  }
#undef SSD_PREFETCH
}

__device__ void attn_item(const Params& P, int layer, int item, unsigned char* smem) {
  int tid_ = threadIdx.x; asm volatile("" : "+v"(tid_));
  const int tid = tid_, wid = tid >> 6, lane = tid & 63, fr = lane & 15, fq = lane >> 4;
  const int cp = item & 15, h = (item >> 4) & 3, b = item >> 6;
  const int wq = wid >> 2, qb = wid & 3, r = tid >> 3, c8 = (tid & 7) * 8;
  bf16_t* KH = (bf16_t*)smem;
  bf16_t* VTT = KH + 2 * 64 * TS;
  float* BIAS = (float*)(smem + 4 * 64 * TS * 2);
  const bf16_t* proj = (const bf16_t*)(P.ws + OFF_PROJ);
  bf16_t* Y = (bf16_t*)(P.ws + OFF_Y);
  __syncthreads();
  if (tid < 257) BIAS[tid] = P.in[23][((size_t)layer * 4 + h) * 257 + tid];
  const int c0 = cp * 2, cme = c0 + wq;
  const size_t tb = (size_t)b * SEQ;
  bf16x8 qf[2];
  {
    const bf16_t* qp = proj + (tb + cme * 64 + qb * 16 + fr) * PW + 1792 + h * 64;
    float a[8], c[8]; unpack8(*(const u32x4*)(qp + fq * 8), a); unpack8(*(const u32x4*)(qp + 32 + fq * 8), c);
    float ss = 0.f;
#pragma unroll
    for (int i = 0; i < 8; ++i) ss += a[i] * a[i] + c[i] * c[i];
    ss += __shfl_xor(ss, 16); ss += __shfl_xor(ss, 32);
    const float rs = rsqrtf(ss * (1.0f / 64.0f) + EPSF) * 0.125f;
    const float* qg = P.in[21] + layer * 64;
#pragma unroll
    for (int i = 0; i < 8; ++i) { a[i] *= rs * qg[fq * 8 + i]; c[i] *= rs * qg[32 + fq * 8 + i]; }
    u32x4 wa = pack8(a), wc_ = pack8(c);
    qf[0] = *(bf16x8*)&wa; qf[1] = *(bf16x8*)&wc_;
  }
  float kgn[8];
#pragma unroll
  for (int i = 0; i < 8; ++i) kgn[i] = P.in[22][layer * 64 + c8 + i];
  f32x4 oacc[4];
#pragma unroll
  for (int d = 0; d < 4; ++d) oacc[d] = (f32x4){0.f, 0.f, 0.f, 0.f};
  float mrun = -1e30f, lrun = 0.f;
  const int cs = c0 - 8 > 0 ? c0 - 8 : 0, ce = c0 + 1;
  u32x4 nk, nv;
  { const bf16_t* kp = proj + (tb + cs * 64 + r) * PW + 2048 + h * 64 + c8; nk = *(const u32x4*)kp; nv = *(const u32x4*)(kp + 256); }
  for (int cc = cs; cc <= ce; ++cc) {
    const int buf = (cc - cs) & 1;
    {
      float kv[8], vv[8]; unpack8(nk, kv); unpack8(nv, vv);
      float ss = 0.f;
#pragma unroll
      for (int i = 0; i < 8; ++i) ss += kv[i] * kv[i];
      ss = sum8(ss);
      const float rs = rsqrtf(ss * (1.0f / 64.0f) + EPSF);
#pragma unroll
      for (int i = 0; i < 8; ++i) kv[i] *= rs * kgn[i];
      *(u32x4*)(KH + buf * 64 * TS + r * TS + c8) = pack8(kv);
#pragma unroll
      for (int i = 0; i < 8; ++i) VTT[buf * 64 * TS + (c8 + i) * TS + r] = f2bf(vv[i]);
    }
    __syncthreads();
    if (cc < ce) { const bf16_t* kp = proj + (tb + (cc + 1) * 64 + r) * PW + 2048 + h * 64 + c8; nk = *(const u32x4*)kp; nv = *(const u32x4*)(kp + 256); }
    const int j = cc - (cme - 8);
    if (j >= 0 && j <= 8) {
      const bf16_t* Kb = KH + buf * 64 * TS; const bf16_t* Vb = VTT + buf * 64 * TS;
      f32x4 s[4];
#pragma unroll
      for (int kt = 0; kt < 4; ++kt) {
        s[kt] = (f32x4){0.f, 0.f, 0.f, 0.f};
#pragma unroll
        for (int ks = 0; ks < 2; ++ks) { const bf16x8 a = *(const bf16x8*)(Kb + (kt * 16 + fr) * TS + ks * 32 + fq * 8); s[kt] = mfma16(a, qf[ks], s[kt]); }
      }
      const int qpos = qb * 16 + fr;
      float bv[4][4];
      if (j <= 5) {
        const float bc = BIAS[256];
#pragma unroll
        for (int kt = 0; kt < 4; ++kt)
#pragma unroll
          for (int jj = 0; jj < 4; ++jj) bv[kt][jj] = bc;
      } else {
#pragma unroll
        for (int kt = 0; kt < 4; ++kt)
#pragma unroll
          for (int jj = 0; jj < 4; ++jj) {
            const int kpos = j * 64 + kt * 16 + fq * 4 + jj;
            int rel = qpos + 512 - kpos; rel = rel > 128 ? 128 : (rel < -128 ? -128 : rel);
            bv[kt][jj] = BIAS[rel + 128];
          }
      }
      float mx = -1e30f;
#pragma unroll
      for (int kt = 0; kt < 4; ++kt)
#pragma unroll
        for (int jj = 0; jj < 4; ++jj) { const float v = s[kt][jj] + bv[kt][jj]; s[kt][jj] = v; mx = fmaxf(mx, v); }
      mx = fmaxf(mx, __shfl_xor(mx, 16)); mx = fmaxf(mx, __shfl_xor(mx, 32));
      const float mnew = fmaxf(mrun, mx), alpha = __expf(mrun - mnew);
      mrun = mnew;
      float ps = 0.f;
#pragma unroll
      for (int kt = 0; kt < 4; ++kt)
#pragma unroll
        for (int jj = 0; jj < 4; ++jj) { const float p = __expf(s[kt][jj] - mnew); s[kt][jj] = p; ps += p; }
      lrun = lrun * alpha + ps;
      bf16x8 pb[2];
#pragma unroll
      for (int k2 = 0; k2 < 2; ++k2) {
        u32x4 w; w[0] = pk2(s[2 * k2][0], s[2 * k2][1]); w[1] = pk2(s[2 * k2][2], s[2 * k2][3]); w[2] = pk2(s[2 * k2 + 1][0], s[2 * k2 + 1][1]); w[3] = pk2(s[2 * k2 + 1][2], s[2 * k2 + 1][3]);
        pb[k2] = *(bf16x8*)&w;
      }
#pragma unroll
      for (int d = 0; d < 4; ++d) {
#pragma unroll
        for (int e = 0; e < 4; ++e) oacc[d][e] *= alpha;
#pragma unroll
        for (int k2 = 0; k2 < 2; ++k2) {
          const bf16_t* vp = Vb + (d * 16 + fr) * TS + k2 * 32 + fq * 4;
          const u32x2 lo = *(const u32x2*)vp, hi = *(const u32x2*)(vp + 16);
          u32x4 w; w[0] = lo[0]; w[1] = lo[1]; w[2] = hi[0]; w[3] = hi[1];
          oacc[d] = mfma16(*(bf16x8*)&w, pb[k2], oacc[d]);
        }
      }
    }
  }
  lrun += __shfl_xor(lrun, 16); lrun += __shfl_xor(lrun, 32);
  const float il = frcp(lrun);
  bf16_t* yp = Y + (tb + cme * 64 + qb * 16 + fr) * 1024 + 768 + h * 64;
#pragma unroll
  for (int d = 0; d < 4; ++d) {
    u32x2 w; w[0] = pk2(oacc[d][0] * il, oacc[d][1] * il); w[1] = pk2(oacc[d][2] * il, oacc[d][3] * il);
    *(u32x2*)(yp + d * 16 + fq * 4) = w;
  }
}

__device__ void toep_build(const Params& P, int layer, int item) {
  item = lsg(item); layer = lsg(layer);
  const int g = item >> 4, nb = item & 15;
  const float* __restrict__ KTb = (const float*)(P.ws + OFF_SMALL + S_KT) + (size_t)(layer * 16 + g) * 64 * 256;
  const float* __restrict__ lam = (const float*)(P.ws + OFF_SMALL + S_LAM) + (size_t)(layer * 16 + g) * 64 * 65 * 2;
  const float* __restrict__ Cre = P.in[16] + (size_t)(layer * 16 + g) * 16 * 64;
  const float* __restrict__ Cim = P.in[17] + (size_t)(layer * 16 + g) * 16 * 64;
  bf16_t* __restrict__ dst = (bf16_t*)(P.ws + OFF_TOEP) + (size_t)g * 1024 * UK;
  const int tid = ltid();
#pragma unroll 3
  for (int idx = tid; idx < 64 * 144; idx += 512) {
    const int n = nb * 64 + idx / 144, k0 = (idx % 144) * 8;
    const int t = n >> 4, i = n & 15;
    float v[8];
    if (k0 < 1024) {
      const int sidx = k0 >> 4, i2 = k0 & 15;
      if (t >= sidx) {
        const f32x4 a0 = *(const f32x4*)(KTb + ((t - sidx) * 16 + i) * 16 + i2), a1 = *(const f32x4*)(KTb + ((t - sidx) * 16 + i) * 16 + i2 + 4);
#pragma unroll
        for (int e = 0; e < 4; ++e) { v[e] = a0[e]; v[4 + e] = a1[e]; }
      } else {
#pragma unroll
        for (int e = 0; e < 8; ++e) v[e] = 0.f;
      }
    } else {
      const int kk0 = k0 - 1024, part = kk0 >> 6, p0 = kk0 & 63;
#pragma unroll
      for (int e = 0; e < 8; ++e) {
        const int p = p0 + e;
        const float lr = lam[(p * 65 + t + 1) * 2], li = lam[(p * 65 + t + 1) * 2 + 1];
        const float cr = Cre[i * 64 + p], ci = Cim[i * 64 + p];
        v[e] = part == 0 ? (cr * lr - ci * li) : -(cr * li + ci * lr);
      }
    }
    *(u32x4*)(dst + (size_t)n * UK + k0) = pack8(v);
  }
}

struct WDesc { const float* src; const float* scale; bf16_t* dst; int ld, K, n0, k0, sc, nv; };
DEVI WDesc wdesc(const Params& P, int layer, int tl) {
  unsigned char* W = P.ws + OFF_W;
  WDesc d; int x = tl; d.nv = 64;
  if (x < 1792) {
    const int nt64 = x >> 4, kt = x & 15, pn = nt64 >> 2, sub = nt64 & 3;
    int sc;
    if (pn < 4) sc = pn * 256 + sub * 64; else if (pn == 4) sc = 1024 + sub * 64; else if (pn < 7) sc = 1280 + (pn - 5) * 256 + sub * 64;
    else if (pn == 7) sc = 1796 + sub * 64; else if (pn < 11) sc = 2052 + (pn - 8) * 256 + sub * 64;
    else if (pn == 11) { sc = 1792; d.nv = sub == 0 ? 4 : 0; } else sc = 2820 + (pn - 12) * 256 + sub * 64;
    d.src = P.in[3] + (size_t)layer * 1024 * 6916; d.ld = 6916; d.K = 1024; d.dst = (bf16_t*)(W + W_IN); d.scale = P.in[2] + layer * 1024; d.n0 = nt64 * 64; d.k0 = kt * 64; d.sc = sc; return d;
  }
  x -= 1792;
  if (x < 256) { const int m = x >> 6, y = x & 63, nt = y >> 2, kt = y & 3;
    d.src = P.in[24] + ((size_t)layer * 4 + m) * 256 * 1024; d.ld = 1024; d.K = 256; d.dst = (bf16_t*)(W + W_BR) + (size_t)m * 1024 * 256; d.scale = m == 1 ? P.in[11] + layer * 256 : nullptr; d.n0 = nt * 64; d.k0 = kt * 64; d.sc = nt * 64; return d; }
  x -= 256;
  if (x < 256) { const int nt = x >> 4, kt = x & 15;
    d.src = P.in[25] + (size_t)layer * 1024 * 1024; d.ld = 1024; d.K = 1024; d.dst = (bf16_t*)(W + W_OUT); d.scale = nullptr; d.n0 = nt * 64; d.k0 = kt * 64; d.sc = nt * 64; return d; }
  x -= 256;
  if (x < 1024) { const int nt = x >> 4, kt = x & 15;
    d.src = P.in[27] + (size_t)layer * 1024 * 4096; d.ld = 4096; d.K = 1024; d.dst = (bf16_t*)(W + W_FF1); d.scale = P.in[26] + layer * 1024; d.n0 = nt * 64; d.k0 = kt * 64; d.sc = nt * 64; return d; }
  x -= 1024;
  if (x < 1024) { const int nt = x >> 6, kt = x & 63;
    d.src = P.in[28] + (size_t)layer * 4096 * 1024; d.ld = 1024; d.K = 4096; d.dst = (bf16_t*)(W + W_FF2); d.scale = nullptr; d.n0 = nt * 64; d.k0 = kt * 64; d.sc = nt * 64; return d; }
  x -= 1024;
  if (x < 64) { const int nt = x >> 2, kt = x & 3;
    d.src = P.in[29] + (size_t)layer * 256 * 1024; d.ld = 1024; d.K = 256; d.dst = (bf16_t*)(W + W_PLE); d.scale = nullptr; d.n0 = nt * 64; d.k0 = kt * 64; d.sc = nt * 64; return d; }
  x -= 64;
  if (x < 256) { const int nt = x >> 4, kt = x & 15;
    d.src = P.in[31] + (size_t)layer * 1024 * 1024; d.ld = 1024; d.K = 1024; d.dst = (bf16_t*)(W + W_PG + (size_t)layer * 2 * MiB); d.scale = P.in[30] + layer * 1024; d.n0 = nt * 64; d.k0 = kt * 64; d.sc = nt * 64; return d; }
  x -= 256;
  { const int nt = x >> 2, kt = x & 3;
    d.src = P.in[20] + (size_t)layer * 256 * 256; d.ld = 256; d.K = 256; d.dst = (bf16_t*)(W + W_GLU); d.scale = nullptr; d.n0 = nt * 64; d.k0 = kt * 64; d.sc = nt * 64; return d; }
}
DEVI void wload(const WDesc& d, int tid, float* v) {
#pragma unroll
  for (int i = 0; i < 8; ++i) {
    const int idx = tid + 512 * i, kk = idx >> 6, nn = idx & 63;
    float x = 0.f;
    if (nn < d.nv) { x = d.src[(size_t)(d.k0 + kk) * d.ld + d.sc + nn]; if (d.scale) x *= d.scale[d.k0 + kk]; }
    v[i] = x;
  }
}
__device__ void prep_layer(const Params& P, int layer, unsigned char* smem) {
  layer = lsg(layer);
  float* tile = (float*)smem;
  const int tid = ltid(), G = gridDim.x;
  float cur[8], nxt[8];
  int tl = lbid();
  WDesc dc{};
  if (tl < 4688) { dc = wdesc(P, layer, tl); wload(dc, tid, cur); }
  for (; tl < 4688; tl += G) {
    WDesc dn{}; const bool has = tl + G < 4688;
    if (has) { dn = wdesc(P, layer, tl + G); wload(dn, tid, nxt); }
    __syncthreads();
#pragma unroll
    for (int i = 0; i < 8; ++i) { const int idx = tid + 512 * i, kk = idx >> 6, nn = idx & 63; tile[kk * 65 + nn] = cur[i]; }
    __syncthreads();
#pragma unroll
    for (int i = 0; i < 4; ++i) {
      const int idx = tid + 512 * i, nn = idx >> 5, kp = (idx & 31) * 2;
      *(unsigned*)(dc.dst + (size_t)(dc.n0 + nn) * dc.K + dc.k0 + kp) = pk2(tile[kp * 65 + nn], tile[(kp + 1) * 65 + nn]);
    }
    if (has) {
#pragma unroll
      for (int i = 0; i < 8; ++i) cur[i] = nxt[i];
      dc = dn;
    }
  }
  const float* __restrict__ lamL = (const float*)(P.ws + OFF_SMALL + S_LAM) + (size_t)layer * 16 * 64 * 65 * 2;
  const float* __restrict__ bbL = (const float*)(P.ws + OFF_SMALL + S_BB) + (size_t)layer * 16 * 64 * 16 * 2;
  bf16_t* __restrict__ mint = (bf16_t*)(P.ws + OFF_MINT);
#pragma unroll 4
  for (size_t idx = (size_t)lbid() * 512 + ltid(); idx < (size_t)16 * 256 * 512; idx += (size_t)gridDim.x * 512) {
    const int k0 = (int)(idx & 511) * 2, n = (int)(idx >> 9) & 255, g = (int)(idx >> 17);
    float v[2] = {0.f, 0.f};
    if (n < 128) {
      const int p = n & 63;
#pragma unroll
      for (int e = 0; e < 2; ++e) {
        const int k = k0 + e, s = k >> 4, i2 = k & 15;
        const float lr = lamL[((size_t)(g * 64 + p) * 65 + (63 - s)) * 2], li = lamL[((size_t)(g * 64 + p) * 65 + (63 - s)) * 2 + 1];
        const float br = bbL[((size_t)(g * 64 + p) * 16 + i2) * 2], bi = bbL[((size_t)(g * 64 + p) * 16 + i2) * 2 + 1];
        v[e] = n < 64 ? (lr * br - li * bi) : (lr * bi + li * br);
      }
    }
    *(unsigned*)(mint + ((size_t)(g * 256 + n) * 1024 + k0)) = pk2(v[0], v[1]);
  }
}

__device__ void merge_phase(const Params& P, int layer, unsigned char* smem) {
  int tid_ = threadIdx.x; asm volatile("" : "+v"(tid_));
  const int tid = tid_, wid = tid >> 6, lane = tid & 63, fr = lane & 15, fq = lane >> 4, wr = wid >> 2, wc = wid & 3;
  constexpr int LS = 136, BUFE = 2 * 128 * LS;
  bf16_t* L0 = (bf16_t*)smem;
  const bf16_t* Y = (const bf16_t*)(P.ws + OFF_Y);
  const bf16_t* Wb = (const bf16_t*)(P.ws + OFF_W + W_BR);
  const unsigned char* gates = P.ws + OFF_GATES;
  bf16_t* merged = (bf16_t*)(P.ws + OFF_MERGED);
  const int cid = lbid(), G = gridDim.x;
  const int ntile = (2048 - cid + G - 1) / G, total = ntile * 8;
  const u64* ssq = (const u64*)(P.ws + OFF_SMALL + S_SSQ) + (size_t)lsg(layer) * T_TOK * 2;
  u32x4 pa0[4], pa1[4], pbx[4];
  unsigned gw[4][2];
  float rc0[4], rc1[4];
  f32x4 mg[4][2], acc[4][2];
#pragma unroll
  for (int a = 0; a < 4; ++a)
#pragma unroll
    for (int n = 0; n < 2; ++n) { mg[a][n] = (f32x4){0.f, 0.f, 0.f, 0.f}; acc[a][n] = (f32x4){0.f, 0.f, 0.f, 0.f}; }
#define MG_LOADA(g_, pa) do { const int gc_ = (g_) < total ? (g_) : total - 1; \
    const int tile_ = cid + (gc_ >> 3) * G, s_ = gc_ & 7, m_ = s_ >> 1, kh_ = s_ & 1, r0_ = (tile_ >> 3) * 128; \
    _Pragma("unroll") for (int i = 0; i < 4; ++i) { const int idx = tid + 512 * i, rr = idx >> 4, pc = idx & 15; \
      pa[i] = *(const u32x4*)(Y + (size_t)(r0_ + rr) * 1024 + m_ * 256 + kh_ * 128 + pc * 8); } } while (0)
#define MG_LOADB(g_, pb) do { const int gc_ = (g_) < total ? (g_) : total - 1; \
    const int tile_ = cid + (gc_ >> 3) * G, s_ = gc_ & 7, m_ = s_ >> 1, kh_ = s_ & 1, c0_ = (tile_ & 7) * 128; \
    _Pragma("unroll") for (int i = 0; i < 4; ++i) { const int idx = tid + 512 * i, rr = idx >> 4, pc = idx & 15; \
      pb[i] = *(const u32x4*)(Wb + ((size_t)m_ * 1024 + c0_ + rr) * 256 + kh_ * 128 + pc * 8); } } while (0)
#define MG_LOADG(g_, gq, r0v, r1v) do { const int gc_ = (g_) < total ? (g_) : total - 2; \
    const int tile_ = cid + (gc_ >> 3) * G, m_ = (gc_ & 7) >> 1, r0_ = (tile_ >> 3) * 128, c0_ = (tile_ & 7) * 128; \
    _Pragma("unroll") for (int a = 0; a < 4; ++a) { const int row_ = r0_ + wr * 64 + a * 16 + fr; \
      _Pragma("unroll") for (int n = 0; n < 2; ++n) gq[a][n] = *(const unsigned*)(gates + (size_t)row_ * 4096 + m_ * 1024 + c0_ + wc * 32 + n * 16 + fq * 4); \
      r0v[a] = (float)ssq[(size_t)row_ * 2]; r1v[a] = (float)ssq[(size_t)row_ * 2 + 1]; } } while (0)
#define MG_STORE(buf_, pa, pb) do { bf16_t* A_ = L0 + (buf_) * BUFE; bf16_t* B_ = A_ + 128 * LS; \
    _Pragma("unroll") for (int i = 0; i < 4; ++i) { const int idx = tid + 512 * i, rr = idx >> 4, pc = idx & 15; \
      *(u32x4*)(A_ + rr * LS + pc * 8) = pa[i]; *(u32x4*)(B_ + rr * LS + pc * 8) = pb[i]; } } while (0)
#define MG_COMPUTE(buf) do { const bf16_t* As = L0 + (buf) * BUFE; const bf16_t* Bs = As + 128 * LS; \
    _Pragma("unroll") for (int k = 0; k < 4; ++k) { \
      bf16x8 af[4], bfr[2]; \
      _Pragma("unroll") for (int a = 0; a < 4; ++a) af[a] = *(const bf16x8*)(As + (wr * 64 + a * 16 + fr) * LS + k * 32 + fq * 8); \
      _Pragma("unroll") for (int n = 0; n < 2; ++n) bfr[n] = *(const bf16x8*)(Bs + (wc * 32 + n * 16 + fr) * LS + k * 32 + fq * 8); \
      _Pragma("unroll") for (int a = 0; a < 4; ++a) _Pragma("unroll") for (int n = 0; n < 2; ++n) acc[a][n] = mfma16(bfr[n], af[a], acc[a][n]); } } while (0)
#define MG_GATE(rv, isb) do { \
    _Pragma("unroll") for (int a = 0; a < 4; ++a) { \
      const float rsq_ = rsqrtf(rv[a] * (1.0f / (16777216.0f * 128.0f)) + EPSF) * (1.0f / 255.0f); \
      const float rs1 = (isb) ? rsq_ : (1.0f / 255.0f); \
      _Pragma("unroll") for (int n = 0; n < 2; ++n) { \
        _Pragma("unroll") for (int e = 0; e < 4; ++e) mg[a][n][e] += acc[a][n][e] * ((float)((gw[a][n] >> (8 * e)) & 255u) * rs1); \
        acc[a][n] = (f32x4){0.f, 0.f, 0.f, 0.f}; } } } while (0)
  MG_LOADA(0, pa0); MG_LOADB(0, pbx); MG_LOADG(0, gw, rc0, rc1);
  MG_STORE(0, pa0, pbx);
  MG_LOADA(1, pa1);
  __syncthreads();
  for (int g = 0; g < total; g += 2) {
    const int tile = cid + (g >> 3) * G, s = g & 7, m = s >> 1, row0 = (tile >> 3) * 128, col0 = (tile & 7) * 128;
    const bool isb = (m == 1);
    MG_LOADB(g + 1, pbx); MG_LOADA(g + 2, pa0);
    MG_COMPUTE(0);
    MG_GATE(rc0, isb);
    MG_STORE(1, pa1, pbx);
    __syncthreads();
    MG_LOADB(g + 2, pbx); MG_LOADA(g + 3, pa1);
    MG_COMPUTE(1);
    MG_GATE(rc1, isb);
    if (s == 6) {
#pragma unroll
      for (int a = 0; a < 4; ++a) {
        const int row = row0 + wr * 64 + a * 16 + fr;
#pragma unroll
        for (int n = 0; n < 2; ++n) {
          u32x2 w; w[0] = pk2(mg[a][n][0], mg[a][n][1]); w[1] = pk2(mg[a][n][2], mg[a][n][3]);
          *(u32x2*)(merged + (size_t)row * 1024 + col0 + wc * 32 + n * 16 + fq * 4) = w;
          mg[a][n] = (f32x4){0.f, 0.f, 0.f, 0.f};
        }
      }
    }
    MG_LOADG(g + 2, gw, rc0, rc1);
    MG_STORE(0, pa0, pbx);
    __syncthreads();
  }
#undef MG_LOADA
#undef MG_LOADB
#undef MG_LOADG
#undef MG_STORE
#undef MG_COMPUTE
#undef MG_GATE
}

__device__ void prep_global_a(const Params& P) {
  const int tid = ltid(), wid = tid >> 6, lane = tid & 63;
  u64* __restrict__ rowsq = (u64*)(P.ws + OFF_SMALL + S_ROWSQ);
  bf16_t* __restrict__ xb = (bf16_t*)(P.ws + OFF_XB);
  const float* __restrict__ x = P.in[0];
#pragma unroll 2
  for (int row = lbid() * 8 + wid; row < T_TOK; row += gridDim.x * 8) {
    float ss = 0.f;
#pragma unroll
    for (int i = 0; i < 2; ++i) {
      const size_t o = (size_t)row * 1024 + i * 512 + lane * 8;
      const f32x4 a = *(const f32x4*)(x + o), c = *(const f32x4*)(x + o + 4);
      u32x4 w; w[0] = pk2(a[0], a[1]); w[1] = pk2(a[2], a[3]); w[2] = pk2(c[0], c[1]); w[3] = pk2(c[2], c[3]);
      *(u32x4*)(xb + o) = w;
#pragma unroll
      for (int e = 0; e < 4; ++e) ss += a[e] * a[e] + c[e] * c[e];
    }
#pragma unroll
    for (int d = 1; d < 64; d <<= 1) ss += __shfl_xor(ss, d);
    if (lane == 0) rowsq[row] = (u64)(ss * RSQ_SCALE + 0.5f);
  }
  const size_t gt = (size_t)lbid() * 512 + tid, gn = (size_t)gridDim.x * 512;
  for (size_t i = gt; i < (size_t)6 * T_TOK; i += gn) rowsq[T_TOK + i] = 0ull;
  { u64* ssqz = (u64*)(P.ws + OFF_SMALL + S_SSQ); for (size_t i = gt; i < (size_t)4 * T_TOK; i += gn) ssqz[i] = 0ull; }
  int* ctr = (int*)(P.ws + OFF_SMALL + S_CTR);
  if (lbid() == 0 && tid < 64) ctr[tid] = 0;
  float* lam = (float*)(P.ws + OFF_SMALL + S_LAM);
  float* bb = (float*)(P.ws + OFF_SMALL + S_BB);
  for (size_t i = gt; i < (size_t)2 * 16 * 64 * 65; i += gn) {
    const int tau = (int)(i % 65), gp = (int)(i / 65), L = gp >> 10, g = (gp >> 6) & 15;
    const double are = (double)P.in[12][gp], aim = (double)P.in[13][gp], step = exp((double)P.in[19][L * 16 + g]);
    const double mag = exp(are * step * (double)tau), ang = aim * step * (double)tau;
    lam[i * 2] = (float)(mag * cos(ang)); lam[i * 2 + 1] = (float)(mag * sin(ang));
  }
  for (size_t i = gt; i < (size_t)2 * 16 * 64 * 16; i += gn) {
    const int gp = (int)(i >> 4), L = gp >> 10, g = (gp >> 6) & 15;
    const double are = (double)P.in[12][gp], aim = (double)P.in[13][gp], step = exp((double)P.in[19][L * 16 + g]);
    const double mag = exp(are * step), lr = mag * cos(aim * step), li = mag * sin(aim * step);
    const double den = are * are + aim * aim, nr = lr - 1.0;
    const double cr = (nr * are + li * aim) / den, ci = (li * are - nr * aim) / den;
    const double br = (double)P.in[14][i], bi = (double)P.in[15][i];
    bb[i * 2] = (float)(cr * br - ci * bi); bb[i * 2 + 1] = (float)(cr * bi + ci * br);
  }
}
__device__ void prep_global_b(const Params& P) {
  const float* lam = (const float*)(P.ws + OFF_SMALL + S_LAM);
  const float* bb = (const float*)(P.ws + OFF_SMALL + S_BB);
  float* KT = (float*)(P.ws + OFF_SMALL + S_KT);
  for (size_t idx = (size_t)lbid() * 512 + ltid(); idx < (size_t)2 * 16 * 64 * 256; idx += (size_t)gridDim.x * 512) {
    const int i2 = (int)(idx & 15), i = (int)(idx >> 4) & 15, tau = (int)(idx >> 8) & 63, Lg = (int)(idx >> 14);
    const float* cre = P.in[16] + ((size_t)Lg * 16 + i) * 64; const float* cim = P.in[17] + ((size_t)Lg * 16 + i) * 64;
    float acc = 0.f;
    for (int p = 0; p < 64; ++p) {
      const float lr = lam[((size_t)(Lg * 64 + p) * 65 + tau) * 2], li = lam[((size_t)(Lg * 64 + p) * 65 + tau) * 2 + 1];
      const float br = bb[((size_t)(Lg * 64 + p) * 16 + i2) * 2], bi = bb[((size_t)(Lg * 64 + p) * 16 + i2) * 2 + 1];
      const float xr = lr * br - li * bi, xi = lr * bi + li * br;
      acc += cre[p] * xr - cim[p] * xi;
    }
    KT[idx] = acc;
  }
}
__device__ void convert_p(const Params& P, int layer) {
  layer = lsg(layer);
  const float* __restrict__ src = P.in[1] + (size_t)layer * T_TOK * 256;
  bf16_t* __restrict__ dst = (bf16_t*)(P.ws + OFF_PB);
#pragma unroll 4
  for (size_t i = ((size_t)lbid() * 512 + ltid()) * 8; i < (size_t)T_TOK * 256; i += (size_t)gridDim.x * 512 * 8) {
    const f32x4 a = *(const f32x4*)(src + i), c = *(const f32x4*)(src + i + 4);
    u32x4 w; w[0] = pk2(a[0], a[1]); w[1] = pk2(a[2], a[3]); w[2] = pk2(c[0], c[1]); w[3] = pk2(c[2], c[3]);
    *(u32x4*)(dst + i) = w;
  }
}


#define XB_TMO      128
#define XB_XCNT(j)  (256  + 64 * (j))
#define XB_XSUB(j)  (1280 + 64 * (j))
#define XB_XGEN(j)  (2304 + 64 * (j))
#define XB_TOP      3328
#define XB_TOPGEN   3392
#define XCD_BAR_WORDS 3456
#define XB_SPIN_CAP (1u << 18)
DEVI unsigned xb_ld(unsigned* p) { return __hip_atomic_load(p, __ATOMIC_RELAXED, __HIP_MEMORY_SCOPE_AGENT); }
DEVI unsigned xb_add(unsigned* p, unsigned v) { return __hip_atomic_fetch_add(p, v, __ATOMIC_RELAXED, __HIP_MEMORY_SCOPE_AGENT); }
DEVI unsigned xb_xcc_id() { return (unsigned)__builtin_amdgcn_s_getreg((3 << 11) | 20) & 0xFu; }
#define XB_SPIN(cond, bar) do { unsigned _sp = 0; while (cond) { __builtin_amdgcn_s_sleep(1); \
    if ((++_sp & 255u) == 0u) { if (xb_ld(&(bar)[XB_TMO])) break; if (_sp > XB_SPIN_CAP) { atomicAdd(&(bar)[XB_TMO], 1u); break; } } } } while (0)
struct XcdBarrier { unsigned* bar; unsigned x; volatile LAS unsigned* st; };
DEVI XcdBarrier xcd_barrier_post(unsigned* bar, volatile LAS unsigned* st) {
  XcdBarrier b; b.bar = bar; b.x = xb_xcc_id(); b.st = st;
  if (threadIdx.x == 0) (void)xb_add(&bar[XB_XCNT(b.x)], 1u);
  return b;
}
DEVI void xcd_barrier_complete(unsigned* bar, unsigned x, unsigned& nloc, unsigned& nx) {
  const unsigned G = gridDim.x * gridDim.y * gridDim.z;
  unsigned sum, cnt, mine, sp = 0u;
  for (;;) {
    sum = 0u; cnt = 0u; mine = 0u;
#pragma unroll
    for (unsigned j = 0; j < 16; ++j) { const unsigned c = xb_ld(&bar[XB_XCNT(j)]); sum += c; cnt += (c > 0u) ? 1u : 0u; mine = (j == x) ? c : mine; }
    if (sum == G) break;
    __builtin_amdgcn_s_sleep(1);
    if ((++sp & 255u) == 0u) { if (xb_ld(&bar[XB_TMO])) break; if (sp > XB_SPIN_CAP) { atomicAdd(&bar[XB_TMO], 1u); break; } }
  }
  nloc = mine > 0u ? mine : 1u; nx = cnt > 0u ? cnt : 1u;
}
DEVI void xcd_barrier(unsigned* bar_, volatile LAS unsigned* st_) {
  XcdBarrier b; b.bar = bar_; b.st = st_; b.x = xb_xcc_id();
  asm volatile("s_waitcnt vmcnt(0)" ::: "memory");
  __syncthreads();
  if (ltid() == 0) {
    unsigned* bar = b.bar;
    __builtin_amdgcn_s_waitcnt(0);
    unsigned nloc = b.st[0], nx = b.st[1];
    if (nloc == 0u) { xcd_barrier_complete(bar, b.x, nloc, nx); b.st[0] = nloc; b.st[1] = nx; }
    const unsigned old = xb_add(&bar[XB_XSUB(b.x)], 1u);
    const unsigned gen = old / nloc;
    if (old + 1u == (gen + 1u) * nloc) {
      __builtin_amdgcn_fence(__ATOMIC_RELEASE, "agent");
      asm volatile("s_waitcnt vmcnt(0)" ::: "memory");
      const unsigned og = xb_add(&bar[XB_TOP], 1u);
      const unsigned tg = og / nx;
      if (og + 1u == (tg + 1u) * nx) xb_add(&bar[XB_TOPGEN], 1u);
      else XB_SPIN(xb_ld(&bar[XB_TOPGEN]) == tg, bar);
      __builtin_amdgcn_fence(__ATOMIC_ACQUIRE, "agent");
      xb_add(&bar[XB_XGEN(b.x)], 1u);
      asm volatile("s_waitcnt vmcnt(0)" ::: "memory");
    } else {
      XB_SPIN(xb_ld(&bar[XB_XGEN(b.x)]) == gen, bar);
      __builtin_amdgcn_fence(__ATOMIC_ACQUIRE, "agent");
      asm volatile("s_waitcnt vmcnt(0)" ::: "memory");
    }
  }
  __syncthreads();
}

#ifdef PROBE_A
#define TS(k) do { if (cid == 0 && ltid() == 0) ((unsigned long long*)(lptr(P.ws) + OFF_SMALL + S_BAR + 16384))[(k)] = __builtin_amdgcn_s_memrealtime(); } while (0)
#else
#define TS(k) do {} while (0)
#endif
template <int MODE>
__global__ void __launch_bounds__(512) mega(Params P) {
  extern __shared__ __attribute__((aligned(16))) unsigned char smem[];
  cg::grid_group grid = cg::this_grid();
  (void)grid;
  LAS unsigned char* lds = (LAS unsigned char*)smem;
  int* qslot = (int*)(smem + LDS_BYTES - 16);
#define PHASE_PTRS unsigned char* ws = lptr(P.ws); u64* rowsq = (u64*)(ws + OFF_SMALL + S_ROWSQ); bf16_t* xb = (bf16_t*)(ws + OFF_XB); (void)rowsq; (void)xb;
  const int G = gridDim.x, cid = lbid();

  {
    volatile LAS unsigned* stw = (volatile LAS unsigned*)(lds + LDS_BYTES - 64);
    if (threadIdx.x < 4) stw[threadIdx.x] = 0u;
    unsigned* barw = (unsigned*)(P.ws + OFF_SMALL + S_BAR);
    if (cid == 0) for (int i = threadIdx.x; i < XCD_BAR_WORDS; i += 512) barw[i] = 0u;
  }
  TS(0);
  if (MODE == 0 || MODE == 10) prep_global_a(P);
  if (MODE == 0) grid.sync();
  TS(1);
  if (MODE == 0) (void)xcd_barrier_post((unsigned*)(P.ws + OFF_SMALL + S_BAR), (volatile LAS unsigned*)(lds + LDS_BYTES - 64));
#define GRID_BAR() if (MODE == 0) xcd_barrier((unsigned*)(lptr(P.ws) + OFF_SMALL + S_BAR), (volatile LAS unsigned*)(lds + LDS_BYTES - 64))
  if (MODE == 0 || MODE == 10) { prep_global_b(P); prep_layer(P, lsg(0), smem); }
  GRID_BAR();
  TS(2);

#pragma unroll 1
  for (int layer = (MODE == 0 ? 0 : 1); layer < 2; ++layer) {
    if (MODE == 0 || MODE == 1)
    for (int rep = 0; rep < REP_A; ++rep) {
      PHASE_PTRS
      Gemm g{layer == 0 ? xb : (const bf16_t*)(ws + OFF_Y), (const bf16_t*)(ws + OFF_W + W_IN), 1024, 1024, 1024, 0, 0};
      pg8::StaticOrder S; S.init(128, 28, G, cid);
      EpiG1 E{rowsq + (size_t)(3 * layer) * T_TOK, (bf16_t*)(ws + OFF_PROJ), (bf16_t*)(ws + OFF_U), (float*)(ws + OFF_SMALL + S_DT), ws + OFF_GATES};
      pg8::gemm_phase(lds, g, S, E);
    }
    GRID_BAR();
    TS(2 + 10 * layer + 1);
    if (MODE == 21) for (int it = cid; it < 64; it += G) ssd_seq(P, layer, it, smem);
    if (MODE == 22) for (int it = cid; it < 64; it += G) hgrn2_seq(P, layer, it, smem);
    if (MODE == 23) for (int it = cid; it < 1024; it += G) attn_item(P, layer, it, smem);
    if (MODE == 0 || MODE == 2)
    {
      PHASE_PTRS
      int* q = (int*)(ws + OFF_SMALL + S_CTR) + layer * 8 + (MODE == 0 ? 0 : 32);
      int* cS5 = q + 1; int* cBuild = q + 2; int* cToep = q + 3;
      for (;;) {
        const int it = qpop(q, qslot);
        if (it >= 1696) break;
        if (it < 64) ssd_seq(P, layer, it, smem);
        else if (it < 128) hgrn2_seq(P, layer, it - 64, smem);
        else if (it < 160) {
          const int x = it - 128;
          Gemm g{(const bf16_t*)(ws + OFF_U), (const bf16_t*)(ws + OFF_MINT), UK, 1024, 1024, (size_t)512 * UK * 2, (size_t)256 * 1024 * 2};
          pg8::OneUnit S; S.u = Unit{x & 1, 0, x >> 1};
          EpiS5in E{(bf16_t*)(ws + OFF_U), (const float*)(ws + OFF_SMALL + S_LAM) + (size_t)layer * 16 * 64 * 65 * 2};
          pg8::gemm_phase(lds, g, S, E);
          dep_publish(cS5);
        }
        else if (it < 416) { toep_build(P, layer, it - 160); dep_publish(cBuild); }
        else if (it < 928) attn_item(P, layer, it - 416, smem);
        else if (it < 1056) {
          const int x = it - 928;
          dep_wait(cS5, 32); dep_wait(cBuild, 256);
          Gemm g{(const bf16_t*)(ws + OFF_U), (const bf16_t*)(ws + OFF_TOEP), UK, UK, UK, (size_t)512 * UK * 2, (size_t)1024 * UK * 2};
          pg8::OneUnit S; S.u = Unit{(x >> 2) & 1, x & 3, x >> 3};
          EpiToep E{(const bf16_t*)(ws + OFF_U), P.in[18] + layer * 256, (bf16_t*)(ws + OFF_Y)};
          pg8::gemm_phase(lds, g, S, E);
          dep_publish(cToep);
        }
        else if (it < 1568) attn_item(P, layer, it - 1056 + 512, smem);
        else {
          const int x = it - 1568;
          dep_wait(cToep, 128);
          Gemm g{(const bf16_t*)(ws + OFF_Y) + 512, (const bf16_t*)(ws + OFF_W + W_GLU), 1024, 256, 256, 0, 0};
          pg8::OneUnit S; S.u = Unit{x, 0, 0};
          EpiGLU E{(bf16_t*)(ws + OFF_Y)};
          pg8::gemm_phase(lds, g, S, E);
        }
      }
    }
    GRID_BAR();
    TS(2 + 10 * layer + 2);
    if (MODE == 0 || MODE == 5)
    for (int rep = 0; rep < REP_C; ++rep) merge_phase(P, layer, smem);
    GRID_BAR();
    TS(2 + 10 * layer + 5);
    if (MODE == 0 || MODE == 6) {
    convert_p(P, layer);
    {
      PHASE_PTRS
      Gemm g{(const bf16_t*)(ws + OFF_MERGED), (const bf16_t*)(ws + OFF_W + W_OUT), 1024, 1024, 1024, 0, 0};
      pg8::StaticOrder S; S.init(128, 4, G, cid);
      EpiRes<true> E{layer == 0 ? P.in[0] : P.out, xb, rowsq + (size_t)(3 * layer + 1) * T_TOK};
      pg8::gemm_phase(lds, g, S, E);
    }
    }
    GRID_BAR();
    TS(2 + 10 * layer + 6);
    if (MODE == 0 || MODE == 7) {
    for (int rep = 0; rep < REP_E; ++rep) {
      PHASE_PTRS
      Gemm g{xb, (const bf16_t*)(ws + OFF_W + W_FF1), 1024, 1024, 1024, 0, 0};
      pg8::StaticOrder S; S.init(128, 16, G, cid);
      EpiFF1 E{rowsq + (size_t)(3 * layer + 1) * T_TOK, (bf16_t*)(ws + OFF_HID)};
      pg8::gemm_phase(lds, g, S, E);
    }
    {
      PHASE_PTRS
      Gemm g{(const bf16_t*)(ws + OFF_PB), (const bf16_t*)(ws + OFF_W + W_PLE), 256, 256, 256, 0, 0};
      pg8::StaticOrder S; S.init(128, 4, G, cid);
      EpiPle E{(bf16_t*)(ws + OFF_PLE)};
      pg8::gemm_phase(lds, g, S, E);
    }
    }
    GRID_BAR();
    TS(2 + 10 * layer + 7);
    if (MODE == 0 || MODE == 8)
    {
      PHASE_PTRS
      Gemm g{(const bf16_t*)(ws + OFF_HID), (const bf16_t*)(ws + OFF_W + W_FF2), 4096, 4096, 4096, 0, 0};
      pg8::StaticOrder S; S.init(128, 4, G, cid);
      EpiRes<false> E{nullptr, xb, rowsq + (size_t)(3 * layer + 2) * T_TOK};
      pg8::gemm_phase(lds, g, S, E);
    }
    GRID_BAR();
    TS(2 + 10 * layer + 8);
    if (MODE == 0 || MODE == 9) {
    {
      PHASE_PTRS
      Gemm g{xb, (const bf16_t*)(ws + OFF_W + W_PG + (size_t)layer * 2 * MiB), 1024, 1024, 1024, 0, 0};
      pg8::StaticOrder S; S.init(128, 4, G, cid);
      EpiPG E{rowsq + (size_t)(3 * layer + 2) * T_TOK, (const bf16_t*)(ws + OFF_PLE), xb, P.out, (bf16_t*)(ws + OFF_Y), rowsq + (size_t)(3 * layer + 3) * T_TOK, layer == 1};
      pg8::gemm_phase(lds, g, S, E);
    }
    }
    if (MODE == 0 && layer == 0) { __syncthreads(); prep_layer(P, lsg(1), smem); }
    if (MODE == 11) prep_layer(P, lsg(1), smem);
    GRID_BAR();
    TS(2 + 10 * layer + 9);
  }
#ifdef PROBE_A
  __threadfence(); __syncthreads();
  if (cid == 0) {
    const unsigned long long* ts = (const unsigned long long*)(lptr(P.ws) + OFF_SMALL + S_BAR + 16384);
    auto dur = [&](int k) -> float {
      if (k == 99) return (float)(ts[21] - ts[0]) * 0.01f;
      if (k <= 2) return (float)(ts[k] - ts[k - 1]) * 0.01f;
      const int j = k - 2; float d = 0.f;
      for (int L = 0; L < 2; ++L) { const int hi = 2 + 10 * L + j, lo = (j == 1) ? (L == 0 ? 2 : 11) : hi - 1; d += (float)(ts[hi] - ts[lo]) * 0.01f; }
      return d; };
    const float dA = dur(PROBE_A), dB = dur(PROBE_B);
    if (ltid() == 0) P.out[0] += dA;
    for (int i = ltid(); i < (1 << 20); i += 512) P.out[1024 + i] += 0.01f * dB;
  }
#endif
}

extern "C" void kernel_launch(void* const* d_in, const int* in_sizes, int n_in, void* d_out, int out_size, void* d_ws, size_t ws_size, hipStream_t stream) {
  static int grid_blocks = 0;
  if (ws_size < WS_NEED) { fprintf(stderr, "workspace too small: %zu < %zu\n", ws_size, (size_t)WS_NEED); return; }
  if (!grid_blocks) {
    int dev = 0, cus = 0, per_cu = 0;
    hipGetDevice(&dev);
    hipDeviceGetAttribute(&cus, hipDeviceAttributeMultiprocessorCount, dev);
    hipFuncSetAttribute((const void*)mega<0>, hipFuncAttributeMaxDynamicSharedMemorySize, LDS_BYTES);
    hipOccupancyMaxActiveBlocksPerMultiprocessor(&per_cu, mega<0>, 512, LDS_BYTES);
#ifdef PROBE_MODE
    hipFuncSetAttribute((const void*)mega<PROBE_MODE>, hipFuncAttributeMaxDynamicSharedMemorySize, LDS_BYTES);
#endif
    if (per_cu < 1) per_cu = 1;
    grid_blocks = cus * per_cu;
    if (grid_blocks > 256) grid_blocks = 256;
  }
  Params P{};
  for (int i = 0; i < 32; ++i) P.in[i] = (const float*)d_in[i];
  P.out = (float*)d_out; P.ws = (unsigned char*)d_ws;
  void* args[] = {&P};
  hipError_t e = hipLaunchCooperativeKernel((void*)mega<0>, dim3(grid_blocks), dim3(512), args, LDS_BYTES, stream);
  if (e != hipSuccess) fprintf(stderr, "cooperative launch failed: %s (grid %d)\n", hipGetErrorString(e), grid_blocks);
#ifdef PROBE_MODE
  { Params P2 = P; P2.out = (float*)d_ws; hipLaunchKernelGGL(mega<PROBE_MODE>, dim3(grid_blocks), dim3(512), LDS_BYTES, stream, P2); }
#endif
}
```
